# Optimizing an MI355X kernel written in HIP

```python
import jax, jax.numpy as jnp
from jax import lax
import numpy as np

D_MODEL = 1024
BATCH = 16
SEQ = 2048
DEPTH = 1

HEAD_DIM = 64
NA_HEADS = 8
NA_WIDTH = NA_HEADS * HEAD_DIM
GRID_W = 64
NA_ROWS_MAX = 8
NA_COLS = 16
SW_HEADS = 8
SW_KV_HEADS = 2
SW_GROUP = SW_HEADS // SW_KV_HEADS
SW_WIDTH = SW_HEADS * HEAD_DIM
SW_KV_WIDTH = SW_KV_HEADS * HEAD_DIM
SW_WINDOW = 128
SW_BLOCK = 128
MIX_WIDTH = NA_WIDTH + SW_WIDTH
IN_WIDTH = 3 * NA_WIDTH + SW_WIDTH + 2 * SW_KV_WIDTH
D_FF = 2816
CONV_W = 3
ROPE_THETA = 10000.0
EPS = 1e-6
NEG = -1e30

kernel_name = "hybrid_natten_swa_convffn_block"


def rmsnorm(x, g):
    xf = x.astype(jnp.float32)
    y = xf * lax.rsqrt(jnp.mean(xf * xf, axis=-1, keepdims=True) + EPS)
    return (y * g.astype(jnp.float32)).astype(x.dtype)


def rope(t, pos):
    half = HEAD_DIM // 2
    inv = ROPE_THETA ** (-jnp.arange(half, dtype=jnp.float32) / half)
    ang = pos.astype(jnp.float32)[:, None] * inv[None, :]
    cos = jnp.cos(ang)[None, :, None, :].astype(t.dtype)
    sin = jnp.sin(ang)[None, :, None, :].astype(t.dtype)
    t1, t2 = t[..., :half], t[..., half:]
    return jnp.concatenate([t1 * cos - t2 * sin, t2 * cos + t1 * sin], axis=-1)


def neighbourhood_attention(q, k, v, rpb):
    B, S = q.shape[0], q.shape[1]
    rows = S // GRID_W
    wr = min(NA_ROWS_MAX, rows)

    def grid(t):
        return t.reshape(B, rows, GRID_W, NA_HEADS, HEAD_DIM).transpose(0, 3, 1, 2, 4)

    r = jnp.arange(rows)
    rs = jnp.clip(r - wr // 2, 0, rows - wr)
    row_idx = rs[:, None] + jnp.arange(wr)[None, :]
    kb = jnp.take(grid(k), row_idx, axis=2).reshape(B, NA_HEADS, rows, wr * GRID_W, HEAD_DIM)
    vb = jnp.take(grid(v), row_idx, axis=2).reshape(B, NA_HEADS, rows, wr * GRID_W, HEAD_DIM)

    col = jnp.arange(GRID_W)
    cs = jnp.clip(col - NA_COLS // 2, 0, GRID_W - NA_COLS)
    col_ok = (col[None, :] >= cs[:, None]) & (col[None, :] < cs[:, None] + NA_COLS)
    dc = jnp.clip(col[None, :] - col[:, None] + NA_COLS - 1, 0, 2 * NA_COLS - 2)
    dr = row_idx - r[:, None] + NA_ROWS_MAX - 1
    bias = rpb[:, dr[:, None, :, None], dc[None, :, None, :]]
    bias = jnp.where(col_ok[None, None, :, None, :], bias.astype(jnp.float32), NEG)
    bias = bias.reshape(NA_HEADS, rows, GRID_W, wr * GRID_W)

    s = jnp.einsum('bhrqd,bhrkd->bhrqk', grid(q), kb,
                   preferred_element_type=jnp.float32) * (HEAD_DIM ** -0.5) + bias[None]
    p = jax.nn.softmax(s, axis=-1).astype(v.dtype)
    o = jnp.einsum('bhrqk,bhrkd->bhrqd', p, vb)
    return o.transpose(0, 2, 3, 1, 4).reshape(B, S, NA_WIDTH)


def window_sink_attention(q, k, v, sink):
    B, S = q.shape[0], q.shape[1]
    nb = S // SW_BLOCK
    qb = q.reshape(B, nb, SW_BLOCK, SW_KV_HEADS, SW_GROUP, HEAD_DIM)

    def band(t):
        tp = jnp.pad(t, ((0, 0), (SW_BLOCK, SW_BLOCK), (0, 0), (0, 0)))
        tp = tp.reshape(B, nb + 2, SW_BLOCK, SW_KV_HEADS, HEAD_DIM)
        return jnp.concatenate([tp[:, :-2], tp[:, 1:-1], tp[:, 2:]], axis=2)

    kw, vw = band(k), band(v)
    blk = jnp.arange(nb)[:, None] * SW_BLOCK
    qpos = blk + jnp.arange(SW_BLOCK)[None, :]
    kpos = blk - SW_BLOCK + jnp.arange(3 * SW_BLOCK)[None, :]
    ok = (jnp.abs(qpos[:, :, None] - kpos[:, None, :]) <= SW_WINDOW) \
        & ((kpos >= 0) & (kpos < S))[:, None, :]

    s = jnp.einsum('bnqhgd,bnkhd->bhgnqk', qb, kw,
                   preferred_element_type=jnp.float32) * (HEAD_DIM ** -0.5)
    s = jnp.where(ok[None, None, None], s, NEG)
    sk = sink.astype(jnp.float32).reshape(1, SW_KV_HEADS, SW_GROUP, 1, 1)
    m = jnp.maximum(jnp.max(s, axis=-1), sk)
    p = jnp.exp(s - m[..., None])
    den = jnp.sum(p, axis=-1) + jnp.exp(sk - m)
    p = (p / den[..., None]).astype(v.dtype)
    o = jnp.einsum('bhgnqk,bnkhd->bnqhgd', p, vw)
    return o.reshape(B, S, SW_WIDTH)


def setup_inputs(seed: int = 0) -> dict:
    key = jax.random.key(seed)
    ks = jax.random.split(key, 20)
    L, D = DEPTH, D_MODEL

    def nrm(k, shape, scale):
        return jax.random.normal(k, shape, jnp.float32) * scale

    return {
        "x": nrm(ks[0], (BATCH, SEQ, D), 1.0),
        "c": nrm(ks[1], (BATCH, D), 1.0),
        "w_ada": nrm(ks[2], (L, D, 6 * D), 0.5 * D ** -0.5),
        "b_ada": nrm(ks[3], (L, 6 * D), 0.02),
        "g_attn": 1.0 + nrm(ks[4], (L, D), 0.02),
        "w_in": nrm(ks[5], (L, D, IN_WIDTH), D ** -0.5),
        "na_rpb": nrm(ks[6], (L, NA_HEADS, 2 * NA_ROWS_MAX - 1, 2 * NA_COLS - 1), 0.1),
        "sw_sink": nrm(ks[7], (L, SW_HEADS), 0.5),
        "g_na_out": 1.0 + nrm(ks[8], (L, NA_WIDTH), 0.02),
        "g_sw_out": 1.0 + nrm(ks[9], (L, SW_WIDTH), 0.02),
        "w_out": nrm(ks[10], (L, MIX_WIDTH, D), MIX_WIDTH ** -0.5),
        "g_ffn": 1.0 + nrm(ks[11], (L, D), 0.02),
        "w_up": nrm(ks[12], (L, D, 2 * D_FF), D ** -0.5),
        "conv_w": nrm(ks[13], (L, CONV_W, D_FF), CONV_W ** -0.5),
        "conv_b": nrm(ks[14], (L, D_FF), 0.02),
        "w_down": nrm(ks[15], (L, D_FF, D), D_FF ** -0.5),
        "g_final": 1.0 + nrm(ks[16], (D,), 0.02),
    }


def reference(x, c, w_ada, b_ada, g_attn, w_in, na_rpb, sw_sink, g_na_out, g_sw_out,
              w_out, g_ffn, w_up, conv_w, conv_b, w_down, g_final):
    S = x.shape[1]
    pos = jnp.arange(S)
    splits = [NA_WIDTH, 2 * NA_WIDTH, 3 * NA_WIDTH, 3 * NA_WIDTH + SW_WIDTH,
              3 * NA_WIDTH + SW_WIDTH + SW_KV_WIDTH]
    for l in range(DEPTH):
        mod = jax.nn.silu(c) @ w_ada[l] + b_ada[l]
        shift_a, scale_a, gate_a, shift_f, scale_f, gate_f = [
            m[:, None, :] for m in jnp.split(mod, 6, axis=-1)]

        h = rmsnorm(x, g_attn[l]) * (1.0 + scale_a) + shift_a
        proj = h @ w_in[l]
        qa, ka, va, qb, kb, vb = jnp.split(proj, splits, axis=-1)
        Bn = x.shape[0]
        qa = qa.reshape(Bn, S, NA_HEADS, HEAD_DIM)
        ka = ka.reshape(Bn, S, NA_HEADS, HEAD_DIM)
        va = va.reshape(Bn, S, NA_HEADS, HEAD_DIM)
        qb = rope(qb.reshape(Bn, S, SW_HEADS, HEAD_DIM), pos)
        kb = rope(kb.reshape(Bn, S, SW_KV_HEADS, HEAD_DIM), pos)
        vb = vb.reshape(Bn, S, SW_KV_HEADS, HEAD_DIM)

        o_a = rmsnorm(neighbourhood_attention(qa, ka, va, na_rpb[l]), g_na_out[l])
        o_b = rmsnorm(window_sink_attention(qb, kb, vb, sw_sink[l]), g_sw_out[l])
        mix = jnp.concatenate([o_a, o_b], axis=-1) @ w_out[l]
        x = x + gate_a * mix

        h = rmsnorm(x, g_ffn[l]) * (1.0 + scale_f) + shift_f
        val, gt = jnp.split(h @ w_up[l], 2, axis=-1)
        gp = jnp.pad(gt, ((0, 0), (1, 1), (0, 0)))
        cw = conv_w[l]
        gc = gp[:, :-2] * cw[0] + gp[:, 1:-1] * cw[1] + gp[:, 2:] * cw[2] + conv_b[l]
        x = x + gate_f * ((jax.nn.silu(gc) * val) @ w_down[l])
    return rmsnorm(x, g_final)
```

```cpp
#include <hip/hip_runtime.h>
#include <hip/hip_cooperative_groups.h>
#include <cstdio>
#include <cstdint>
namespace cg = cooperative_groups;
namespace pg8 {
#define PG8_LAS __attribute__((address_space(3)))
typedef unsigned short bf16_t;
typedef short bf16x8 __attribute__((ext_vector_type(8)));
typedef float f32x4 __attribute__((ext_vector_type(4)));
typedef unsigned u32x4 __attribute__((ext_vector_type(4)));
constexpr int BM = 256, BK = 64, HALF = 128, HTB = HALF * BK * 2  , STAGE_BYTES = 8 * HTB, NXCD = 8, WGM = 4;

__host__ __device__ __forceinline__ int lds_byte(int r, int c) { const int st = (r >> 4) * 2 + (c >> 5), rr = r & 15, cc = c & 31, ob = rr * 64 + cc * 2; return st * 1024 + (ob ^ (((ob >> 9) & 1) << 5)); }
__host__ __device__ __forceinline__ void stage_rc(int b, int& R, int& C) { const int st = b / 1024, sb = b % 1024, swz = sb ^ (((sb >> 9) & 1) << 5); R = (st >> 1) * 16 + swz / 64; C = (st & 1) * 32 + (swz % 64) / 2; }
__host__ __device__ __forceinline__ int perm32(int rho) { const int n = rho >> 4, i = rho & 15; return 8 * (i >> 2) + 4 * n + (i & 3); }

struct Unit { int pm, pn; };
struct Gemm { const bf16_t* A; const bf16_t* Bt; int M, N, K; };

struct StaticOrder {
    int nM, nN, nwg, G, c;
    __host__ __device__ void init(int M, int N, int G_, int c_) { nM = M / BM; nN = N / BM; nwg = nM * nN; G = G_; c = c_; }
    __host__ __device__ bool next(int i, Unit& u) const {
        const long L = (long)i * G + c; if (L >= nwg) return false;
        int wgid = (int)L; { const int q = nwg / NXCD, r = nwg % NXCD, xcd = wgid % NXCD, off = wgid / NXCD; wgid = (xcd < r ? xcd * (q + 1) : r * (q + 1) + (xcd - r) * q) + off; }
        const int nig = WGM * nN, gid = wgid / nig, fm = gid * WGM, gsz = (nM - fm) < WGM ? (nM - fm) : WGM;
        u.pm = fm + ((wgid % nig) % gsz); u.pn = (wgid % nig) / gsz; return true;
    }
    __device__ __forceinline__ void a_ready(const Unit&) const {}
    __device__ __forceinline__ void done(const Unit&) const {}
};

__device__ __forceinline__ unsigned cvt_pk_bf16(float lo, float hi) { unsigned r; asm volatile("v_cvt_pk_bf16_f32 %0, %1, %2" : "=v"(r) : "v"(lo), "v"(hi)); return r; }
typedef float f32x2 __attribute__((ext_vector_type(2)));
template <class Epi, class Sched, bool ALIGN_EPI = false, bool SP2 = false>
__device__ __forceinline__ void gemm_phase(PG8_LAS unsigned char* lds, const Gemm g, const Sched& S, const Epi& E) {
    const int tid = threadIdx.x, wid = __builtin_amdgcn_readfirstlane(tid >> 6), lane = tid & 63, wr = wid >> 2, wc = wid & 3, fr = lane & 15, fq = lane >> 4;
    const int K = g.K, nt = K / BK;
    unsigned voffA[2], voffB[2];
#pragma unroll
    for (int i = 0; i < 2; ++i) { int R, C; stage_rc(tid * 16 + i * 8192, R, C); const int Rb = Epi::PERM ? ((R & ~31) + perm32(R & 31)) : R;
        voffA[i] = (unsigned)(R * K + C) * 2u; voffB[i] = (unsigned)(Rb * K + C) * 2u; }
    const size_t kstep = (size_t)(BK * 2);
    const size_t hstep = (size_t)HALF * K * 2;
    const size_t tstep = 2 * hstep;
    const unsigned ldsw = (unsigned)wid * 1024u;
    const int aoff = lds_byte(wr * 64 + fr, fq * 8), boff = lds_byte(wc * 32 + fr, fq * 8);
#define PG8_SA(b, h) (((b) * 2 + (h)) * HTB)
#define PG8_SB(b, h) ((4 + (b) * 2 + (h)) * HTB)
#define PG8_STAGE(bufoff, gbase, voff) do { _Pragma("unroll") for (int _i = 0; _i < 2; ++_i) \
        __builtin_amdgcn_global_load_lds((const unsigned*)((const char*)(gbase) + (voff)[_i]), (PG8_LAS unsigned*)(lds + (bufoff) + ldsw + _i * 8192), 16, 0, 0); } while (0)
#define PG8_LDA(dst, b, h) do { _Pragma("unroll") for (int m = 0; m < 4; ++m) _Pragma("unroll") for (int k = 0; k < 2; ++k) dst[m][k] = *(const PG8_LAS bf16x8*)(lds + PG8_SA(b, h) + aoff + m * 2048 + k * 1024); } while (0)
#define PG8_LDB(dst, b, h) do { _Pragma("unroll") for (int n = 0; n < 2; ++n) _Pragma("unroll") for (int k = 0; k < 2; ++k) dst[n][k] = *(const PG8_LAS bf16x8*)(lds + PG8_SB(b, h) + boff + n * 2048 + k * 1024); } while (0)
#define PG8_MMA(ai, bj, At, Bt) do { __builtin_amdgcn_s_setprio(1); _Pragma("unroll") for (int m = 0; m < 4; ++m) _Pragma("unroll") for (int n = 0; n < 2; ++n) _Pragma("unroll") for (int k = 0; k < 2; ++k) \
        acc[ai][bj][m][n] = __builtin_amdgcn_mfma_f32_16x16x32_bf16(Bt[n][k], At[m][k], acc[ai][bj][m][n], 0, 0, 0); __builtin_amdgcn_s_setprio(0); } while (0)
#define PG8_WAIT_V(n) asm volatile("s_waitcnt vmcnt(" #n ")" ::: "memory")
#define PG8_WAIT_L(n) asm volatile("s_waitcnt lgkmcnt(" #n ")" ::: "memory")
#define PG8_BAR __builtin_amdgcn_s_barrier()
#define PG8_SCHED __builtin_amdgcn_sched_barrier(0)
    Unit cur, nxt; int ui = 0;
    if (!S.next(0, cur)) return;
    f32x4 acc[2][2][4][2];
#pragma unroll
    for (int a = 0; a < 2; ++a)
#pragma unroll
        for (int b = 0; b < 2; ++b)
#pragma unroll
            for (int m = 0; m < 4; ++m)
#pragma unroll
                for (int n = 0; n < 2; ++n) acc[a][b][m][n] = (f32x4){0.f, 0.f, 0.f, 0.f};
    bf16x8 At[4][2], B0[2][2], B1[2][2];
    const char* cA = (const char*)g.A + (size_t)cur.pm * tstep; const char* cB = (const char*)g.Bt + (size_t)cur.pn * tstep;
    S.a_ready(cur);
    if constexpr (SP2) {
        PG8_STAGE(PG8_SB(0, 0), cB, voffB); PG8_STAGE(PG8_SB(0, 1), cB + hstep, voffB); PG8_STAGE(PG8_SA(0, 0), cA, voffA); PG8_STAGE(PG8_SA(0, 1), cA + hstep, voffA);
        if (wr == 1) PG8_BAR;
        PG8_WAIT_V(2); PG8_BAR;
        PG8_STAGE(PG8_SB(1, 0), cB + kstep, voffB); PG8_STAGE(PG8_SA(1, 0), cA + kstep, voffA); PG8_STAGE(PG8_SB(1, 1), cB + hstep + kstep, voffB);
        PG8_WAIT_V(6); PG8_BAR;
    } else {
        PG8_STAGE(PG8_SB(0, 0), cB, voffB); PG8_STAGE(PG8_SA(0, 0), cA, voffA); PG8_STAGE(PG8_SB(0, 1), cB + hstep, voffB); PG8_STAGE(PG8_SA(0, 1), cA + hstep, voffA);
        if (wr == 1) PG8_BAR;
        PG8_WAIT_V(4); PG8_BAR;
        PG8_STAGE(PG8_SB(1, 0), cB + kstep, voffB); PG8_STAGE(PG8_SA(1, 0), cA + kstep, voffA); PG8_STAGE(PG8_SB(1, 1), cB + hstep + kstep, voffB);
        PG8_WAIT_V(6); PG8_BAR;
    }
    for (;;) {
        const bool has_next = S.next(ui + 1, nxt);
        const char* nA = has_next ? (const char*)g.A + (size_t)nxt.pm * tstep : cA; const char* nB = has_next ? (const char*)g.Bt + (size_t)nxt.pn * tstep : cB;
        for (int t = 0; t < nt; t += 2) {
            const bool last = (t == nt - 2);
            const char* a1 = cA + (size_t)(t + 1) * kstep;
            const char* a2 = last ? nA : cA + (size_t)(t + 2) * kstep; const char* b2 = last ? nB : cB + (size_t)(t + 2) * kstep;
            const char* a3 = a2 + kstep; const char* b3 = b2 + kstep;
            if (last && has_next) S.a_ready(nxt);
            if constexpr (SP2) {
            PG8_LDB(B0, 0, 0); PG8_LDB(B1, 0, 1); PG8_SCHED; PG8_LDA(At, 0, 0); PG8_STAGE(PG8_SA(1, 1), a1 + hstep, voffA);
            PG8_WAIT_V(8); PG8_WAIT_L(0); PG8_BAR; PG8_MMA(0, 0, At, B0); PG8_MMA(0, 1, At, B1); PG8_BAR; PG8_SCHED;
            PG8_LDA(At, 0, 1); PG8_STAGE(PG8_SB(0, 0), b2, voffB); PG8_STAGE(PG8_SB(0, 1), b2 + hstep, voffB); PG8_STAGE(PG8_SA(0, 0), a2, voffA);
            PG8_WAIT_V(8); PG8_WAIT_L(0); PG8_BAR; PG8_MMA(1, 0, At, B0); PG8_MMA(1, 1, At, B1); PG8_BAR; PG8_SCHED;
            PG8_LDB(B0, 1, 0); PG8_LDB(B1, 1, 1); PG8_SCHED; PG8_LDA(At, 1, 0); PG8_STAGE(PG8_SA(0, 1), a2 + hstep, voffA);
            PG8_WAIT_V(8); PG8_WAIT_L(0); PG8_BAR; PG8_MMA(0, 0, At, B0); PG8_MMA(0, 1, At, B1); PG8_BAR; PG8_SCHED;
            PG8_LDA(At, 1, 1); PG8_STAGE(PG8_SB(1, 0), b3, voffB); PG8_STAGE(PG8_SB(1, 1), b3 + hstep, voffB); PG8_STAGE(PG8_SA(1, 0), a3, voffA);
            PG8_WAIT_V(8); PG8_WAIT_L(0); PG8_BAR; PG8_MMA(1, 0, At, B0); PG8_MMA(1, 1, At, B1); PG8_BAR; PG8_SCHED;
            } else {
            PG8_LDB(B0, 0, 0); PG8_SCHED; PG8_LDA(At, 0, 0); PG8_STAGE(PG8_SA(1, 1), a1 + hstep, voffA);
            PG8_WAIT_L(8); PG8_BAR; PG8_WAIT_L(0); PG8_MMA(0, 0, At, B0); PG8_BAR; PG8_SCHED;
            PG8_LDB(B1, 0, 1); PG8_STAGE(PG8_SB(0, 0), b2, voffB);
            PG8_BAR; PG8_WAIT_L(0); PG8_MMA(0, 1, At, B1); PG8_BAR;
            PG8_LDA(At, 0, 1); PG8_STAGE(PG8_SA(0, 0), a2, voffA);
            PG8_BAR; PG8_WAIT_L(0); PG8_MMA(1, 0, At, B0); PG8_BAR; PG8_SCHED;
            PG8_STAGE(PG8_SB(0, 1), b2 + hstep, voffB);
            PG8_WAIT_V(6); PG8_BAR; PG8_MMA(1, 1, At, B1); PG8_BAR;
            PG8_LDB(B0, 1, 0); PG8_SCHED; PG8_LDA(At, 1, 0); PG8_STAGE(PG8_SA(0, 1), a2 + hstep, voffA);
            PG8_WAIT_L(8); PG8_BAR; PG8_WAIT_L(0); PG8_MMA(0, 0, At, B0); PG8_BAR; PG8_SCHED;
            PG8_LDB(B1, 1, 1); PG8_STAGE(PG8_SB(1, 0), b3, voffB);
            PG8_BAR; PG8_WAIT_L(0); PG8_MMA(0, 1, At, B1); PG8_BAR;
            PG8_LDA(At, 1, 1); PG8_STAGE(PG8_SA(1, 0), a3, voffA);
            PG8_BAR; PG8_WAIT_L(0); PG8_MMA(1, 0, At, B0); PG8_BAR; PG8_SCHED;
            PG8_STAGE(PG8_SB(1, 1), b3 + hstep, voffB);
            PG8_WAIT_V(6); PG8_BAR; PG8_MMA(1, 1, At, B1); PG8_BAR;
            }
        }
        if constexpr (ALIGN_EPI) { if (wr == 0) PG8_BAR; }
        if constexpr (!Epi::AFTER_DRAIN) { E(acc, cur, wr, wc, fr, fq); S.done(cur); }
        if (!has_next) break;
#pragma unroll
        for (int a = 0; a < 2; ++a)
#pragma unroll
            for (int b = 0; b < 2; ++b)
#pragma unroll
                for (int m = 0; m < 4; ++m)
#pragma unroll
                    for (int n = 0; n < 2; ++n) acc[a][b][m][n] = (f32x4){0.f, 0.f, 0.f, 0.f};
        cur = nxt; cA = nA; cB = nB; ++ui;
        if constexpr (ALIGN_EPI) { if (wr == 1) PG8_BAR; }
    }
    PG8_WAIT_V(0);
    if constexpr (!ALIGN_EPI) { if (wr == 0) PG8_BAR; }
    PG8_BAR;
    if constexpr (Epi::AFTER_DRAIN) { E.fused(acc, cur, wr, wc, fr, fq, lds, wid, lane); S.done(cur); }
#undef PG8_SA
#undef PG8_SB
#undef PG8_STAGE
#undef PG8_LDA
#undef PG8_LDB
#undef PG8_MMA
#undef PG8_WAIT_V
#undef PG8_WAIT_L
#undef PG8_BAR
#undef PG8_SCHED
}
constexpr float LOG2E = 1.4426950408889634f;
constexpr float C2 = 0.125f * LOG2E;
struct EpiIn {
    static constexpr bool PERM = true, AFTER_DRAIN = false;
    bf16_t* O; const float* costab; const float* sintab;
    __device__ __forceinline__ void operator()(const f32x4 (&acc)[2][2][4][2], const Unit& u, int wr, int wc, int fr, int fq) const {
        const int pn = u.pn, row0 = u.pm * BM + wr * 64 + fr, col0 = pn * BM + wc * 32 + 8 * fq;
        const bool rope0 = (pn >= 6), rope1 = (pn == 6 || pn == 7);
        const float sc = (pn < 2 || pn == 6 || pn == 7) ? C2 : 1.f;
        const int G4 = 4 * ((wc & 1) * 4 + fq);
#pragma unroll
        for (int ai = 0; ai < 2; ++ai)
#pragma unroll
            for (int m = 0; m < 4; ++m) {
                const int row = row0 + ai * HALF + m * 16, pos = row & 2047;
                f32x4 cs = (f32x4){1.f, 1.f, 1.f, 1.f}, sn = (f32x4){0.f, 0.f, 0.f, 0.f};
                if (rope0) { cs = *(const f32x4*)(costab + pos * 32 + G4); sn = *(const f32x4*)(sintab + pos * 32 + G4); }
                bf16_t* rowp = O + (size_t)row * 2304 + col0;
#pragma unroll
                for (int bj = 0; bj < 2; ++bj) {
                    f32x4 v0 = acc[ai][bj][m][0], v1 = acc[ai][bj][m][1];
                    if (bj == 0 ? rope0 : rope1) { const f32x4 o0 = v0 * cs - v1 * sn, o1 = v1 * cs + v0 * sn; v0 = o0; v1 = o1; }
                    v0 = v0 * sc; v1 = v1 * sc;
                    u32x4 w; w.x = cvt_pk_bf16(v0[0], v0[1]); w.y = cvt_pk_bf16(v0[2], v0[3]); w.z = cvt_pk_bf16(v1[0], v1[1]); w.w = cvt_pk_bf16(v1[2], v1[3]);
                    *(u32x4*)(rowp + bj * HALF) = w;
                }
            }
    }
};
struct EpiRes {
    static constexpr bool PERM = false, AFTER_DRAIN = false;
    const float* base; float* out; const float* gate;
    __device__ __forceinline__ void operator()(const f32x4 (&acc)[2][2][4][2], const Unit& u, int wr, int wc, int fr, int fq) const {
        const int col0 = u.pn * BM + wc * 32 + 4 * fq, b = u.pm >> 3;
        f32x4 gv[2][2];
#pragma unroll
        for (int bj = 0; bj < 2; ++bj)
#pragma unroll
            for (int n = 0; n < 2; ++n) gv[bj][n] = *(const f32x4*)(gate + b * 6144 + col0 + bj * HALF + n * 16);
#pragma unroll
        for (int ai = 0; ai < 2; ++ai)
#pragma unroll
            for (int mp = 0; mp < 2; ++mp) {
                f32x4 bs[2][2][2];
#pragma unroll
                for (int mm = 0; mm < 2; ++mm) { const size_t off = (size_t)(u.pm * BM + ai * HALF + wr * 64 + (2 * mp + mm) * 16 + fr) * 1024 + col0;
#pragma unroll
                    for (int bj = 0; bj < 2; ++bj)
#pragma unroll
                        for (int n = 0; n < 2; ++n) bs[mm][bj][n] = *(const f32x4*)(base + off + bj * HALF + n * 16); }
                asm volatile("" ::: "memory");
#pragma unroll
                for (int mm = 0; mm < 2; ++mm) { const size_t off = (size_t)(u.pm * BM + ai * HALF + wr * 64 + (2 * mp + mm) * 16 + fr) * 1024 + col0;
#pragma unroll
                    for (int bj = 0; bj < 2; ++bj)
#pragma unroll
                        for (int n = 0; n < 2; ++n) *(f32x4*)(out + off + bj * HALF + n * 16) = bs[mm][bj][n] + gv[bj][n] * acc[ai][bj][2 * mp + mm][n]; }
                asm volatile("" ::: "memory");
            }
    }
};
template <bool BASE_B16> struct EpiResB {
    static constexpr bool PERM = false, AFTER_DRAIN = false;
    const void* base; bf16_t* outb; const float* gate;
    __device__ __forceinline__ void operator()(const f32x4 (&acc)[2][2][4][2], const Unit& u, int wr, int wc, int fr, int fq) const {
        typedef unsigned u32x2v __attribute__((ext_vector_type(2)));
        const int col0 = u.pn * BM + wc * 32 + 4 * fq, b = u.pm >> 3;
        f32x4 gv[2][2];
#pragma unroll
        for (int bj = 0; bj < 2; ++bj)
#pragma unroll
            for (int n = 0; n < 2; ++n) gv[bj][n] = *(const f32x4*)(gate + b * 6144 + col0 + bj * HALF + n * 16);
#pragma unroll
        for (int ai = 0; ai < 2; ++ai)
#pragma unroll
            for (int mp = 0; mp < 2; ++mp) {
                f32x4 bs[2][2][2];
#pragma unroll
                for (int mm = 0; mm < 2; ++mm) { const size_t off = (size_t)(u.pm * BM + ai * HALF + wr * 64 + (2 * mp + mm) * 16 + fr) * 1024 + col0;
#pragma unroll
                    for (int bj = 0; bj < 2; ++bj)
#pragma unroll
                        for (int n = 0; n < 2; ++n) {
                            if (BASE_B16) { const u32x2v w = *(const u32x2v*)((const bf16_t*)base + off + bj * HALF + n * 16);
                                bs[mm][bj][n] = (f32x4){__builtin_bit_cast(float, w.x << 16), __builtin_bit_cast(float, w.x & 0xffff0000u), __builtin_bit_cast(float, w.y << 16), __builtin_bit_cast(float, w.y & 0xffff0000u)}; }
                            else bs[mm][bj][n] = *(const f32x4*)((const float*)base + off + bj * HALF + n * 16); } }
                asm volatile("" ::: "memory");
#pragma unroll
                for (int mm = 0; mm < 2; ++mm) { const size_t off = (size_t)(u.pm * BM + ai * HALF + wr * 64 + (2 * mp + mm) * 16 + fr) * 1024 + col0;
#pragma unroll
                    for (int bj = 0; bj < 2; ++bj)
#pragma unroll
                        for (int n = 0; n < 2; ++n) { const f32x4 v = bs[mm][bj][n] + gv[bj][n] * acc[ai][bj][2 * mp + mm][n];
                            u32x2v w; w.x = cvt_pk_bf16(v[0], v[1]); w.y = cvt_pk_bf16(v[2], v[3]); *(u32x2v*)(outb + off + bj * HALF + n * 16) = w; } }
                asm volatile("" ::: "memory");
            }
    }
};
__device__ __forceinline__ float dpp_ror1(float v) { return __builtin_bit_cast(float, __builtin_amdgcn_update_dpp(0, __builtin_bit_cast(int, v), 0x121, 0xf, 0xf, false)); }
__device__ __forceinline__ float dpp_rol1(float v) { return __builtin_bit_cast(float, __builtin_amdgcn_update_dpp(0, __builtin_bit_cast(int, v), 0x12f, 0xf, 0xf, false)); }
struct EpiUp {
    static constexpr bool PERM = true, AFTER_DRAIN = false;
    bf16_t* ACT; float* SB; const float* cw; const float* cb;
    __device__ __forceinline__ void operator()(const f32x4 (&acc)[2][2][4][2], const Unit& u, int wr, int wc, int fr, int fq) const {
        const int ff0 = u.pn * 128 + wc * 32 + 8 * fq;
        f32x4 w0a[2], w1a[2], w2a[2], bba[2];
#pragma unroll
        for (int n = 0; n < 2; ++n) { w0a[n] = *(const f32x4*)(cw + ff0 + 4 * n); w1a[n] = *(const f32x4*)(cw + 2816 + ff0 + 4 * n); w2a[n] = *(const f32x4*)(cw + 5632 + ff0 + 4 * n); bba[n] = *(const f32x4*)(cb + ff0 + 4 * n); }
#pragma unroll
        for (int ai = 0; ai < 2; ++ai) {
            const int chunk = 4 * u.pm + 2 * ai + wr, row0 = chunk * 64;
            unsigned pk[4][4];
            float bG[8], bV[8], bC[8];
#pragma unroll
            for (int n = 0; n < 2; ++n) {
                const f32x4 w0 = w0a[n], w1 = w1a[n], w2 = w2a[n], bb = bba[n];
#pragma unroll
                for (int jp = 0; jp < 2; ++jp) {
                    float av[4][2];
#pragma unroll
                    for (int jj = 0; jj < 2; ++jj) {
                        const int j = 2 * jp + jj;
                        float R[4], L[4];
#pragma unroll
                        for (int m = 0; m < 4; ++m) { R[m] = dpp_ror1(acc[ai][1][m][n][j]); L[m] = dpp_rol1(acc[ai][1][m][n][j]); }
#pragma unroll
                        for (int m = 0; m < 4; ++m) {
                            const float cur = acc[ai][1][m][n][j], val = acc[ai][0][m][n][j];
                            const float pb = (m > 0) ? R[m > 0 ? m - 1 : 0] : 0.f, nb = (m < 3) ? L[m < 3 ? m + 1 : 3] : 0.f;
                            const float pv = (fr > 0) ? R[m] : pb, nx = (fr < 15) ? L[m] : nb;
                            const float gc = w0[j] * pv + w1[j] * cur + w2[j] * nx + bb[j];
                            av[m][jj] = gc * val * __builtin_amdgcn_rcpf(1.f + __builtin_amdgcn_exp2f(-LOG2E * gc));
                            if (m == 0) { bG[4 * n + j] = gc; bV[4 * n + j] = val; bC[4 * n + j] = cur; }
                            if (m == 3) { const bool l = (fr == 15); bG[4 * n + j] = l ? gc : bG[4 * n + j]; bV[4 * n + j] = l ? val : bV[4 * n + j]; bC[4 * n + j] = l ? cur : bC[4 * n + j]; }
                        }
                    }
#pragma unroll
                    for (int m = 0; m < 4; ++m) pk[m][2 * n + jp] = cvt_pk_bf16(av[m][0], av[m][1]);
                }
            }
#pragma unroll
            for (int m = 0; m < 4; ++m) { u32x4 w; w.x = pk[m][0]; w.y = pk[m][1]; w.z = pk[m][2]; w.w = pk[m][3]; *(u32x4*)(ACT + (size_t)(row0 + m * 16 + fr) * 2816 + ff0) = w; }
            if (fr == 0 || fr == 15) {
                float* sb = SB + ((size_t)(chunk * 2 + (fr == 15 ? 1 : 0)) * 3) * 2816 + ff0;
#pragma unroll
                for (int n = 0; n < 2; ++n) { *(f32x4*)(sb + 4 * n) = (f32x4){bG[4 * n], bG[4 * n + 1], bG[4 * n + 2], bG[4 * n + 3]}; *(f32x4*)(sb + 2816 + 4 * n) = (f32x4){bV[4 * n], bV[4 * n + 1], bV[4 * n + 2], bV[4 * n + 3]};
                    *(f32x4*)(sb + 5632 + 4 * n) = (f32x4){bC[4 * n], bC[4 * n + 1], bC[4 * n + 2], bC[4 * n + 3]}; }
            }
        }
    }
};
}
using namespace pg8;
#define LAS PG8_LAS
typedef float f32x16 __attribute__((ext_vector_type(16)));
typedef short s16x4 __attribute__((ext_vector_type(4)));
typedef short v4i16_t __attribute__((ext_vector_type(4)));
typedef unsigned u32x2 __attribute__((ext_vector_type(2)));

constexpr int NB = 16, SEQ = 2048, DM = 1024, MTOK = NB * SEQ, NIN = 2304, DFF = 2816, NUP = 5632;
constexpr float EPS = 1e-6f;
constexpr size_t MiB = 1u << 20;
constexpr size_t WS_BAR = 0, BAR_ZERO_BYTES = 16384;
constexpr size_t WS_MOD = 1 * MiB, WS_COS = 2 * MiB, WS_SIN = 2 * MiB + 512 * 1024, WS_WIN = 4 * MiB, WS_WOUT = 10 * MiB, WS_WUP = 12 * MiB, WS_WDN = 24 * MiB;
constexpr size_t WS_H = 32 * MiB, WS_PROJ = 96 * MiB, WS_AO = 240 * MiB, WS_ACT = 96 * MiB  , WS_SB = 304 * MiB, WS_X1B = 346 * MiB, WS_END = 410 * MiB;
static_assert(WS_ACT + (size_t)MTOK * DFF * 2 <= WS_SB && WS_SB + (size_t)512 * 2 * 3 * DFF * 4 <= WS_END, "ws map");
constexpr int LDS_BYTES = 147456, LDS_BARST_OFF = 131072;
constexpr int ATT_BIAS_OFF = 0, ATT_BSTR = 640, ATT_V_OFF = 20480, ATT_VROW = 192, ATT_VBUF = 32 * ATT_VROW, ATT_RED_OFF = ATT_V_OFF + 8 * 2 * ATT_VBUF;
static_assert(ATT_RED_OFF + 2 * 8 * 64 * 4 <= LDS_BYTES, "attention LDS");

__device__ __forceinline__ float wave_sum(float v) {
#pragma unroll
    for (int o = 1; o < 64; o <<= 1) v += __shfl_xor(v, o);
    return v;
}
__device__ __forceinline__ s16x4 vtr(unsigned a) { return __builtin_bit_cast(s16x4, __builtin_amdgcn_ds_read_tr16_b64_v4i16((LAS v4i16_t*)(a))); }
__device__ __forceinline__ f32x16 mfma32(bf16x8 a, bf16x8 b, f32x16 c) { return __builtin_amdgcn_mfma_f32_32x32x16_bf16(a, b, c, 0, 0, 0); }
__device__ __forceinline__ bf16x8 pack8(float a0, float a1, float a2, float a3, float a4, float a5, float a6, float a7) {
    u32x4 w; w.x = cvt_pk_bf16(a0, a1); w.y = cvt_pk_bf16(a2, a3); w.z = cvt_pk_bf16(a4, a5); w.w = cvt_pk_bf16(a6, a7); return __builtin_bit_cast(bf16x8, w);
}
struct NaXf {
    const LAS float* bt; int kc0;
    template <int QUAD> __device__ __forceinline__ void apply(f32x16& s) const {
#pragma unroll
        for (int i = 0; i < 16; ++i) { const int a = i >> 2, b = i & 3, ap = QUAD ? 0 : a, ra = QUAD ? a : 0;
            const float bias = bt[ra * 31 + 8 * ap + b]; const bool ok = (unsigned)(kc0 + 8 * ap + b) < 16u; s[i] = ok ? s[i] + bias : -1e30f; }
    }
};
struct SwXf {
    int mode, ql, h, dq;
    __device__ __forceinline__ void apply(f32x16& s) const {
        {
#pragma unroll
            for (int i = 0; i < 16; ++i) { const int kb = 8 * (i >> 2) + 4 * h + (i & 3); const int d = dq + kb - ql; const bool ok = (d >= -128) && (d <= 128); s[i] = ok ? s[i] : -1e30f; }
        }
    }
};
struct AttnSt { f32x16 o0, o1; float m, l; };
__device__ __forceinline__ void attn_softmax_pv(f32x16& s, AttnSt& st, unsigned vaddr) {
    float mx = s[0];
#pragma unroll
    for (int i = 1; i < 16; ++i) mx = fmaxf(mx, s[i]);
    mx = fmaxf(mx, __shfl_xor(mx, 32));
    const float mn = fmaxf(st.m, mx), al = __builtin_amdgcn_exp2f(st.m - mn); st.m = mn;
    float ps = 0.f;
#pragma unroll
    for (int i = 0; i < 16; ++i) { s[i] = __builtin_amdgcn_exp2f(s[i] - mn); ps += s[i]; }
    st.l = st.l * al + ps; st.o0 = st.o0 * al; st.o1 = st.o1 * al;
    const bf16x8 p0 = pack8(s[0], s[1], s[2], s[3], s[4], s[5], s[6], s[7]), p1 = pack8(s[8], s[9], s[10], s[11], s[12], s[13], s[14], s[15]);
    bf16x8 a[2][2];
#pragma unroll
    for (int db = 0; db < 2; ++db)
#pragma unroll
        for (int ks = 0; ks < 2; ++ks) { const s16x4 lo = vtr(vaddr + ks * 16 * ATT_VROW + db * 64), hi = vtr(vaddr + ks * 16 * ATT_VROW + 8 * ATT_VROW + db * 64);
            a[db][ks] = (bf16x8){lo[0], lo[1], lo[2], lo[3], hi[0], hi[1], hi[2], hi[3]}; }
    st.o0 = mfma32(a[0][0], p0, st.o0); st.o0 = mfma32(a[0][1], p1, st.o0);
    st.o1 = mfma32(a[1][0], p0, st.o1); st.o1 = mfma32(a[1][1], p1, st.o1);
}
struct BlkDesc { int base, hs; };
__device__ __forceinline__ void load_k(bf16x8 (&kf)[4], const bf16_t* proj, int koff, const BlkDesc& d, int ql, int h) {
    const bf16_t* p = proj + (size_t)(d.base + (d.hs ? (ql & 7) + (ql >> 3) * 64 : ql)) * NIN + koff + 32 * h;
#pragma unroll
    for (int kk = 0; kk < 4; ++kk) kf[kk] = *(const bf16x8*)(p + 8 * kk);
}
__device__ __forceinline__ void load_v(u32x4 (&vf)[4], const bf16_t* proj, int voff, const BlkDesc& d, int lane) {
#pragma unroll
    for (int i = 0; i < 4; ++i) { const int x = 8 * i + (lane >> 3); vf[i] = *(const u32x4*)(proj + (size_t)(d.base + (d.hs ? (x & 7) + (x >> 3) * 64 : x)) * NIN + voff + 8 * (lane & 7)); }
}
__device__ __forceinline__ void store_v(LAS unsigned char* vb, const u32x4 (&vf)[4], int lane) {
#pragma unroll
    for (int i = 0; i < 4; ++i) *(LAS u32x4*)(vb + (8 * i + (lane >> 3)) * ATT_VROW + 16 * (lane & 7)) = vf[i];
}

struct UnitId { int valid, swp, b, sub; };
__device__ __forceinline__ UnitId unit_id(int it, int G, int bid) {
    UnitId d; const int u = it * G + bid; d.valid = (u < 1536) ? 1 : 0; const int q3 = u / 3, r3 = u - 3 * q3;
    d.swp = (r3 == 2) ? 1 : 0;
    if (d.swp) { d.b = q3 >> 5; d.sub = q3 & 31; } else { const int idx = q3 * 2 + r3; d.b = idx >> 6; d.sub = idx & 63; }
    return d;
}
struct UnitPre { int valid, tokq, qoff, koff, voff; BlkDesc d0; };
__device__ __forceinline__ UnitPre unit_pre(int it, int G, int bid, int wave, int ql) {
    UnitPre p; const UnitId d = unit_id(it, G, bid); p.valid = d.valid;
    if (!d.swp) { const int r = d.sub >> 1, jp = d.sub & 1, rs = min(max(r - 4, 0), 24);
        p.tokq = d.b * SEQ + r * 64 + 32 * jp + ql; p.qoff = wave * 64; p.koff = 512 + wave * 64; p.voff = 1024 + wave * 64; p.d0.base = d.b * SEQ + rs * 64 + 32 * jp; p.d0.hs = 0; }
    else { const int q0 = 64 * d.sub, kvh = wave >> 2, tlo = max(0, (128 - q0) / 32);
        p.tokq = d.b * SEQ + q0 + ql; p.qoff = 1536 + wave * 64; p.koff = 2048 + kvh * 64; p.voff = 2176 + kvh * 64; p.d0.base = d.b * SEQ + q0 - 128 + 32 * tlo; p.d0.hs = 0; }
    return p;
}
__device__ __forceinline__ f32x16 qk_scores(const bf16x8 (&kf)[4], const bf16x8 (&qf)[4]) {
    f32x16 s;
#pragma unroll
    for (int e = 0; e < 16; ++e) s[e] = 0.f;
#pragma unroll
    for (int kk = 0; kk < 4; ++kk) s = mfma32(kf[kk], qf[kk], s);
    return s;
}
__device__ __forceinline__ float attn_norm_l(AttnSt& st) {
    const float lt = st.l + __shfl_xor(st.l, 32), inv = 1.f / lt;
    float ss = 0.f;
#pragma unroll
    for (int i = 0; i < 16; ++i) { st.o0[i] *= inv; st.o1[i] *= inv; ss += st.o0[i] * st.o0[i] + st.o1[i] * st.o1[i]; }
    return ss + __shfl_xor(ss, 32);
}
__device__ __forceinline__ void attn_store(const AttnSt& st, float rn, bf16_t* op) {
#pragma unroll
    for (int a = 0; a < 4; ++a) {
        u32x2 w0, w1;
        w0.x = cvt_pk_bf16(st.o0[4 * a] * rn, st.o0[4 * a + 1] * rn); w0.y = cvt_pk_bf16(st.o0[4 * a + 2] * rn, st.o0[4 * a + 3] * rn);
        w1.x = cvt_pk_bf16(st.o1[4 * a] * rn, st.o1[4 * a + 1] * rn); w1.y = cvt_pk_bf16(st.o1[4 * a + 2] * rn, st.o1[4 * a + 3] * rn);
        *(u32x2*)(op + 8 * a) = w0; *(u32x2*)(op + 32 + 8 * a) = w1;
    }
}
__device__ __forceinline__ void attn_phase(LAS unsigned char* lds, const bf16_t* __restrict__ proj, bf16_t* __restrict__ ao, const float* __restrict__ rpb, const float* __restrict__ sink) {
    const int tid = threadIdx.x, wave = __builtin_amdgcn_readfirstlane(tid >> 6), lane = tid & 63, ql = lane & 31, h = lane >> 5;
    const int G = gridDim.x, bid = blockIdx.x;
    LAS float* btab = (LAS float*)(lds + ATT_BIAS_OFF);
    LAS unsigned char* vbuf = lds + ATT_V_OFF + wave * 2 * ATT_VBUF;
    LAS float* red = (LAS float*)(lds + ATT_RED_OFF);
    bf16x8 qf[4], kf[4], kn[4]; u32x4 vf[4];
    { const UnitPre p = unit_pre(0, G, bid, wave, ql);
      if (p.valid) {
#pragma unroll
          for (int kk = 0; kk < 4; ++kk) qf[kk] = *(const bf16x8*)(proj + (size_t)p.tokq * NIN + p.qoff + 32 * h + 8 * kk);
          load_k(kf, proj, p.koff, p.d0, ql, h); load_v(vf, proj, p.voff, p.d0, lane); } }
#pragma unroll
    for (int i0 = 0; i0 < 8 * ATT_BSTR; i0 += 512) { const int i = i0 + tid, hh = i / ATT_BSTR, j = i % ATT_BSTR - 64; const bool okb = (j >= 0 && j < 465); const float v = rpb[okb ? hh * 465 + j : 0]; btab[i] = okb ? v * LOG2E : 0.f; }
    __syncthreads();
    const int g4 = lane >> 4, i16 = lane & 15;
    const unsigned trb = (unsigned)((4 * (g4 >> 1) + (i16 >> 2)) * ATT_VROW + (16 * (g4 & 1) + 4 * (i16 & 3)) * 2);
    const unsigned vb0 = (unsigned)(size_t)vbuf;
    for (int it = 0;; ++it) {
        const UnitId ud = unit_id(it, G, bid); if (!ud.valid) break;
        const int b = ud.b, sub = ud.sub;
        AttnSt st, stB;
#pragma unroll
        for (int i = 0; i < 16; ++i) { st.o0[i] = 0.f; st.o1[i] = 0.f; stB.o0[i] = 0.f; stB.o1[i] = 0.f; }
        stB.m = 0.f; stB.l = 1.f;
        int tokq, goff;
        store_v(vbuf, vf, lane);
        if (!ud.swp) {
            const int r = sub >> 1, jp = sub & 1, rs = min(max(r - 4, 0), 24), qcol = 32 * jp + ql, cs = min(max(qcol - 8, 0), 48), cq0 = jp ? 24 : 32;
            tokq = b * SEQ + r * 64 + qcol; goff = 0;
            const int koff = 512 + wave * 64, voff = 1024 + wave * 64;
            st.m = -1e30f; st.l = 0.f;
            const LAS float* bt0 = btab + wave * ATT_BSTR + 64;
            auto desc = [&](int i) { BlkDesc d; if (i < 8) { d.base = b * SEQ + (rs + i) * 64 + 32 * jp; d.hs = 0; } else { d.base = b * SEQ + (rs + 4 * (i - 8)) * 64 + cq0; d.hs = 1; } return d; };
            for (int i = 0; i < 10; ++i) {
                if (i + 1 < 10) { const BlkDesc d = desc(i + 1); load_k(kn, proj, koff, d, ql, h); load_v(vf, proj, voff, d, lane); }
                f32x16 s = qk_scores(kf, qf);
                if (i < 8) { const int R = rs + i, c0 = 32 * jp; NaXf xf{bt0 + (R - r + 7) * 31 + (c0 + 4 * h - qcol + 15), c0 + 4 * h - cs}; xf.apply<0>(s); }
                else { const int R = rs + 4 * (i - 8); NaXf xf{bt0 + (R - r + 7) * 31 + (cq0 + 4 * h - qcol + 15), cq0 + 4 * h - cs}; xf.apply<1>(s); }
                attn_softmax_pv(s, st, vb0 + (unsigned)((i & 1) * ATT_VBUF) + trb);
                if (i + 1 < 10) { store_v(vbuf + ((i + 1) & 1) * ATT_VBUF, vf, lane);
#pragma unroll
                    for (int kk = 0; kk < 4; ++kk) kf[kk] = kn[kk]; }
            }
        } else {
            const int q0 = 64 * sub; tokq = b * SEQ + q0 + ql; goff = 512;
            const int kvh = wave >> 2, koff = 2048 + kvh * 64, voff = 2176 + kvh * 64;
            bf16x8 qB[4];
#pragma unroll
            for (int kk = 0; kk < 4; ++kk) qB[kk] = *(const bf16x8*)(proj + (size_t)(tokq + 32) * NIN + 1536 + wave * 64 + 32 * h + 8 * kk);
            st.m = sink[wave] * LOG2E; st.l = (h == 0) ? 1.f : 0.f; stB.m = st.m; stB.l = st.l;
            const int tlo = max(0, (128 - q0) / 32), thi = min(9, (SEQ - 1 - (q0 - 128)) / 32);
            for (int t = tlo, i = 0; t <= thi; ++t, ++i) {
                if (t + 1 <= thi) { BlkDesc d; d.base = b * SEQ + q0 - 128 + 32 * (t + 1); d.hs = 0; load_k(kn, proj, koff, d, ql, h); load_v(vf, proj, voff, d, lane); }
                const unsigned va = vb0 + (unsigned)((i & 1) * ATT_VBUF) + trb;
                if (t <= 8) { f32x16 s = qk_scores(kf, qf); if (t == 0 || t == 8) { SwXf xf{0, ql, h, 32 * t - 128}; xf.apply(s); } attn_softmax_pv(s, st, va); }
                if (t >= 1) { f32x16 s = qk_scores(kf, qB); if (t == 1 || t == 9) { SwXf xf{0, ql, h, 32 * t - 160}; xf.apply(s); } attn_softmax_pv(s, stB, va); }
                if (t + 1 <= thi) { store_v(vbuf + ((i + 1) & 1) * ATT_VBUF, vf, lane);
#pragma unroll
                    for (int kk = 0; kk < 4; ++kk) kf[kk] = kn[kk]; }
            }
        }
        bf16x8 qn[4];
        const UnitPre pn = unit_pre(it + 1, G, bid, wave, ql);
        if (pn.valid) {
#pragma unroll
            for (int kk = 0; kk < 4; ++kk) qn[kk] = *(const bf16x8*)(proj + (size_t)pn.tokq * NIN + pn.qoff + 32 * h + 8 * kk);
            load_k(kn, proj, pn.koff, pn.d0, ql, h); load_v(vf, proj, pn.voff, pn.d0, lane); }
        const float ssA = attn_norm_l(st), ssB = ud.swp ? attn_norm_l(stB) : 0.f;
        LAS float* rp = red + (it & 1) * 512;
        if (h == 0) { rp[wave * 64 + ql] = ssA; rp[wave * 64 + 32 + ql] = ssB; }
        __syncthreads();
        float totA = 0.f, totB = 0.f;
#pragma unroll
        for (int w = 0; w < 8; ++w) { totA += rp[w * 64 + ql]; totB += rp[w * 64 + 32 + ql]; }
        bf16_t* op = ao + (size_t)tokq * DM + goff + wave * 64 + 4 * h;
        attn_store(st, 1.f / sqrtf(totA * (1.f / 512.f) + EPS), op);
        if (ud.swp) attn_store(stB, 1.f / sqrtf(totB * (1.f / 512.f) + EPS), op + (size_t)32 * DM);
        if (pn.valid) {
#pragma unroll
            for (int kk = 0; kk < 4; ++kk) { qf[kk] = qn[kk]; kf[kk] = kn[kk]; } }
    }
    __syncthreads();
}

#define XB_TMO      128
#define XB_XCNT(j)  (256  + 64 * (j))
#define XB_XSUB(j)  (1280 + 64 * (j))
#define XB_XGEN(j)  (2304 + 64 * (j))
#define XB_TOP      3328
#define XB_TOPGEN   3392
#define XCD_BAR_WORDS 3456
#define XB_SPIN_CAP (1u << 18)

__device__ __forceinline__ unsigned xb_ld(unsigned* p)              { return __hip_atomic_load(p, __ATOMIC_RELAXED, __HIP_MEMORY_SCOPE_AGENT); }
__device__ __forceinline__ unsigned xb_add(unsigned* p, unsigned v) { return __hip_atomic_fetch_add(p, v, __ATOMIC_RELAXED, __HIP_MEMORY_SCOPE_AGENT); }
__device__ __forceinline__ unsigned xb_xcc_id() { return (unsigned)__builtin_amdgcn_s_getreg((3 << 11) | 20) & 0xFu; }
#define XB_SPIN(cond, bar) do { unsigned _sp = 0; while (cond) { __builtin_amdgcn_s_sleep(1); \
    if ((++_sp & 255u) == 0u) { if (xb_ld(&(bar)[XB_TMO])) break; if (_sp > XB_SPIN_CAP) { atomicAdd(&(bar)[XB_TMO], 1u); break; } } } } while (0)

struct XcdBarrier {
    unsigned* bar; unsigned x;
    volatile LAS unsigned* st;
};

__device__ __forceinline__ XcdBarrier xcd_barrier_post(unsigned* bar, volatile LAS unsigned* st) {
    XcdBarrier b; b.bar = bar; b.x = xb_xcc_id(); b.st = st;
    if (threadIdx.x == 0) (void)xb_add(&bar[XB_XCNT(b.x)], 1u);
    return b;
}
__device__ __forceinline__ void xcd_barrier_complete(unsigned* bar, unsigned x, unsigned& nloc, unsigned& nx) {
    const unsigned G = gridDim.x * gridDim.y * gridDim.z;
    unsigned sum, cnt, mine, sp = 0u;
    for (;;) {
        sum = 0u; cnt = 0u; mine = 0u;
#pragma unroll
        for (unsigned j = 0; j < 16; ++j) { const unsigned c = xb_ld(&bar[XB_XCNT(j)]); sum += c; cnt += (c > 0u) ? 1u : 0u; mine = (j == x) ? c : mine; }
        if (sum == G) break;
        __builtin_amdgcn_s_sleep(1);
        if ((++sp & 255u) == 0u) { if (xb_ld(&bar[XB_TMO])) break; if (sp > XB_SPIN_CAP) { atomicAdd(&bar[XB_TMO], 1u); break; } }
    }
    nloc = mine > 0u ? mine : 1u; nx = cnt > 0u ? cnt : 1u;
}

__device__ __forceinline__ void xcd_barrier(const XcdBarrier& b) {
    asm volatile("s_waitcnt vmcnt(0)" ::: "memory");
    __syncthreads();
    if (threadIdx.x == 0) {
        unsigned* bar = b.bar;
        __builtin_amdgcn_s_waitcnt(0);
        unsigned nloc = b.st[0], nx = b.st[1];
        if (nloc == 0u) { xcd_barrier_complete(bar, b.x, nloc, nx); b.st[0] = nloc; b.st[1] = nx; }
        const unsigned old = xb_add(&bar[XB_XSUB(b.x)], 1u);
        const unsigned gen = old / nloc;
        if (old + 1u == (gen + 1u) * nloc) {
            __builtin_amdgcn_fence(__ATOMIC_RELEASE, "agent");
            asm volatile("s_waitcnt vmcnt(0)" ::: "memory");
            const unsigned og = xb_add(&bar[XB_TOP], 1u);
            const unsigned tg = og / nx;
            if (og + 1u == (tg + 1u) * nx) xb_add(&bar[XB_TOPGEN], 1u);
            else XB_SPIN(xb_ld(&bar[XB_TOPGEN]) == tg, bar);
            __builtin_amdgcn_fence(__ATOMIC_ACQUIRE, "agent");
            xb_add(&bar[XB_XGEN(b.x)], 1u);
            asm volatile("s_waitcnt vmcnt(0)" ::: "memory");
        } else {
            XB_SPIN(xb_ld(&bar[XB_XGEN(b.x)]) == gen, bar);
            __builtin_amdgcn_fence(__ATOMIC_ACQUIRE, "agent");
            asm volatile("s_waitcnt vmcnt(0)" ::: "memory");
        }
    }
    __syncthreads();
}


__device__ __forceinline__ unsigned f2bf(float f) { unsigned u = __builtin_bit_cast(unsigned, f); return (u + 0x7fffu + ((u >> 16) & 1u)) >> 16; }
__device__ __forceinline__ unsigned pk2(float lo, float hi) { return f2bf(lo) | (f2bf(hi) << 16); }
template <int MAP> __device__ __forceinline__ int rowmap(int n) {
    if (MAP == 1) { if (n < 1536 || n >= 2176) return n; const int e = n - 1536, hh = e >> 6, d = e & 63, dd = d & 31, Gq = dd >> 2, i = dd & 3; return 1536 + 64 * hh + 8 * Gq + (d >= 32 ? 4 : 0) + i; }
    if (MAP == 2) { const int g = (n >= DFF) ? 1 : 0, ff = n - g * DFF; return 256 * (ff >> 7) + 128 * g + (ff & 127); }
    return n;
}
template <int MAP> __device__ __forceinline__ void transpose_item(const float* __restrict__ W, int K, int N, bf16_t* __restrict__ WT, const float* __restrict__ kscale, LAS float* scr, int item, int lane) {
    const int nblk = N / 32, kb = item / nblk, nb = item % nblk, k0 = 64 * kb, n0 = 32 * nb;
#pragma unroll
    for (int i = 0; i < 32; ++i) { const int kk = 2 * i + (lane >> 5); float v = W[(size_t)(k0 + kk) * N + n0 + (lane & 31)]; if (kscale) v *= kscale[k0 + kk]; scr[kk * 33 + (lane & 31)] = v; }
    asm volatile("s_waitcnt lgkmcnt(0)" ::: "memory");
    const int c = lane & 7;
#pragma unroll
    for (int j = 0; j < 4; ++j) { const int n = (lane >> 3) + 8 * j; const LAS float* s = scr + (8 * c) * 33 + n;
        u32x4 o; o.x = pk2(s[0 * 33], s[1 * 33]); o.y = pk2(s[2 * 33], s[3 * 33]); o.z = pk2(s[4 * 33], s[5 * 33]); o.w = pk2(s[6 * 33], s[7 * 33]);
        *(u32x4*)(WT + (size_t)rowmap<MAP>(n0 + n) * K + k0 + 8 * c) = o; }
    asm volatile("s_waitcnt lgkmcnt(0)" ::: "memory");
}
template <int MODE> __device__ __forceinline__ void row_phase(const float* src, bf16_t* dst, float* io, const float* __restrict__ g, const float* __restrict__ mod, int shift_off, int scale_off) {
    const int lane = threadIdx.x & 63, gw = blockIdx.x * 8 + (threadIdx.x >> 6), NGW = gridDim.x * 8, rpw = MTOK / NGW, m_beg = gw * rpw, m_end = (gw == NGW - 1) ? MTOK : m_beg + rpw;
    const float* base = (MODE == 0) ? src : io;
    for (int m0 = m_beg; m0 < m_end; m0 += 4) {
        f32x4 cur[4][4];
#pragma unroll
        for (int r = 0; r < 4; ++r)
#pragma unroll
            for (int j = 0; j < 4; ++j) cur[r][j] = ((const f32x4*)(base + (size_t)min(m0 + r, MTOK - 1) * DM) + lane)[64 * j];
        const int b = m0 >> 11;
        f32x4 gv[4], sc[4], sh[4];
#pragma unroll
        for (int j = 0; j < 4; ++j) { const int c = 4 * lane + 256 * j; gv[j] = *(const f32x4*)(g + c);
            if (MODE == 0) { sc[j] = *(const f32x4*)(mod + b * 6144 + scale_off + c) + 1.f; sh[j] = *(const f32x4*)(mod + b * 6144 + shift_off + c); } }
        float ss[4];
#pragma unroll
        for (int r = 0; r < 4; ++r) { ss[r] = 0.f;
#pragma unroll
            for (int j = 0; j < 4; ++j) { const f32x4 v = cur[r][j]; ss[r] += (v.x * v.x + v.y * v.y) + (v.z * v.z + v.w * v.w); } }
#pragma unroll
        for (int o = 1; o < 64; o <<= 1) {
#pragma unroll
            for (int r = 0; r < 4; ++r) ss[r] += __shfl_xor(ss[r], o); }
#pragma unroll
        for (int r = 0; r < 4; ++r) {
            const int m = m0 + r; if (m >= m_end) break;
            const float rstd = 1.f / sqrtf(ss[r] * (1.f / DM) + EPS);
            if (MODE == 0) { unsigned long long* o8 = (unsigned long long*)(dst + (size_t)m * DM) + lane;
#pragma unroll
                for (int j = 0; j < 4; ++j) { const f32x4 y = cur[r][j] * rstd * gv[j] * sc[j] + sh[j]; o8[64 * j] = (unsigned long long)(cvt_pk_bf16(y.x, y.y)) | ((unsigned long long)cvt_pk_bf16(y.z, y.w) << 32); } }
            else { f32x4* xr = (f32x4*)(io + (size_t)m * DM) + lane;
#pragma unroll
                for (int j = 0; j < 4; ++j) xr[64 * j] = cur[r][j] * rstd * gv[j]; }
        }
    }
}
template <int MODE> __device__ __forceinline__ void row_phase_b16(const bf16_t* src, bf16_t* dst, float* outf, const float* __restrict__ g, const float* __restrict__ mod, int shift_off, int scale_off) {
    const int lane = threadIdx.x & 63, gw = blockIdx.x * 8 + (threadIdx.x >> 6), NGW = gridDim.x * 8, rpw = MTOK / NGW, m_beg = gw * rpw, m_end = (gw == NGW - 1) ? MTOK : m_beg + rpw;
    for (int m0 = m_beg; m0 < m_end; m0 += 4) {
        u32x4 raw[4][2];
#pragma unroll
        for (int r = 0; r < 4; ++r) { const bf16_t* p = src + (size_t)min(m0 + r, MTOK - 1) * DM + 8 * lane; raw[r][0] = *(const u32x4*)p; raw[r][1] = *(const u32x4*)(p + 512); }
        const int b = m0 >> 11;
        f32x4 gv[4], sc[4], sh[4];
#pragma unroll
        for (int j = 0; j < 4; ++j) { const int c = (j >> 1) * 512 + 8 * lane + 4 * (j & 1); gv[j] = *(const f32x4*)(g + c);
            if (MODE == 0) { sc[j] = *(const f32x4*)(mod + b * 6144 + scale_off + c) + 1.f; sh[j] = *(const f32x4*)(mod + b * 6144 + shift_off + c); } }
        f32x4 cur[4][4]; float ss[4];
#pragma unroll
        for (int r = 0; r < 4; ++r) { ss[r] = 0.f;
#pragma unroll
            for (int j = 0; j < 4; ++j) { const unsigned w0 = raw[r][j >> 1][2 * (j & 1)], w1 = raw[r][j >> 1][2 * (j & 1) + 1];
                const f32x4 v = (f32x4){__builtin_bit_cast(float, w0 << 16), __builtin_bit_cast(float, w0 & 0xffff0000u), __builtin_bit_cast(float, w1 << 16), __builtin_bit_cast(float, w1 & 0xffff0000u)};
                cur[r][j] = v; ss[r] += (v.x * v.x + v.y * v.y) + (v.z * v.z + v.w * v.w); } }
#pragma unroll
        for (int o = 1; o < 64; o <<= 1) {
#pragma unroll
            for (int r = 0; r < 4; ++r) ss[r] += __shfl_xor(ss[r], o); }
#pragma unroll
        for (int r = 0; r < 4; ++r) {
            const int m = m0 + r; if (m >= m_end) break;
            const float rstd = 1.f / sqrtf(ss[r] * (1.f / DM) + EPS);
            if (MODE == 0) {
#pragma unroll
                for (int hf = 0; hf < 2; ++hf) { const f32x4 y0 = cur[r][2 * hf] * rstd * gv[2 * hf] * sc[2 * hf] + sh[2 * hf], y1 = cur[r][2 * hf + 1] * rstd * gv[2 * hf + 1] * sc[2 * hf + 1] + sh[2 * hf + 1];
                    u32x4 w; w.x = cvt_pk_bf16(y0.x, y0.y); w.y = cvt_pk_bf16(y0.z, y0.w); w.z = cvt_pk_bf16(y1.x, y1.y); w.w = cvt_pk_bf16(y1.z, y1.w);
                    *(u32x4*)(dst + (size_t)m * DM + hf * 512 + 8 * lane) = w; } }
            else {
#pragma unroll
                for (int j = 0; j < 4; ++j) *(f32x4*)(outf + (size_t)m * DM + (j >> 1) * 512 + 8 * lane + 4 * (j & 1)) = cur[r][j] * rstd * gv[j]; }
        }
    }
}
__device__ __forceinline__ void fixup_panel(int pm, const float* __restrict__ SB, bf16_t* ACT, const float* __restrict__ cw) {
    constexpr int NITEM = 8 * (DFF / 4);
#pragma unroll 1
    for (int e0 = threadIdx.x; e0 < NITEM; e0 += 4 * 512) {
        f32x4 gc[4], val[4], nbr[4], wv[4];
#pragma unroll
        for (int q = 0; q < 4; ++q) {
            const int e = min(e0 + q * 512, NITEM - 1), rr = e / (DFF / 4), c4 = (e % (DFF / 4)) * 4, chunk = 4 * pm + (rr >> 1), which = rr & 1;
            const float* sb = SB + ((size_t)(chunk * 2 + which) * 3) * DFF + c4;
            gc[q] = *(const f32x4*)sb; val[q] = *(const f32x4*)(sb + DFF);
            const bool has = which == 0 ? ((chunk & 31) != 0) : ((chunk & 31) != 31);
            const int nchunk = has ? (which == 0 ? chunk - 1 : chunk + 1) : chunk;
            nbr[q] = *(const f32x4*)(SB + ((size_t)(nchunk * 2 + (which ^ 1)) * 3 + 2) * DFF + c4);
            wv[q] = *(const f32x4*)(cw + (which == 0 ? 0 : 2 * DFF) + c4);
            if (!has) wv[q] = (f32x4){0.f, 0.f, 0.f, 0.f};
        }
#pragma unroll
        for (int q = 0; q < 4; ++q) {
            const int e = e0 + q * 512; if (e >= NITEM) break;
            const int rr = e / (DFF / 4), c4 = (e % (DFF / 4)) * 4, chunk = 4 * pm + (rr >> 1), which = rr & 1;
            const f32x4 g2 = gc[q] + wv[q] * nbr[q];
            float a[4];
#pragma unroll
            for (int j = 0; j < 4; ++j) a[j] = g2[j] * val[q][j] * __builtin_amdgcn_rcpf(1.f + __builtin_amdgcn_exp2f(-LOG2E * g2[j]));
            u32x2 w; w.x = cvt_pk_bf16(a[0], a[1]); w.y = cvt_pk_bf16(a[2], a[3]);
            *(u32x2*)(ACT + (size_t)(chunk * 64 + which * 63) * DFF + c4) = w;
        }
    }
}

struct Args { const float* in[17]; float* out; unsigned char* ws; int ph_lo, ph_hi; };
static_assert(sizeof(Args) == 17 * 8 + 8 + 8 + 8, "Args has no padding");

__global__ void __launch_bounds__(512, 2) fwd_megakernel(Args args) {
    extern __shared__ __attribute__((aligned(16))) unsigned char lds_raw[];
    LAS unsigned char* lds = (LAS unsigned char*)lds_raw;
    cg::grid_group grid = cg::this_grid();
    const int tid = threadIdx.x, wave = __builtin_amdgcn_readfirstlane(tid >> 6), lane = tid & 63, G = gridDim.x, bid = blockIdx.x;
    const float* x = args.in[0]; const float* cvec = args.in[1]; const float* w_ada = args.in[2]; const float* b_ada = args.in[3]; const float* g_attn = args.in[4];
    const float* w_in = args.in[5]; const float* rpb = args.in[6]; const float* sink = args.in[7]; const float* g_na = args.in[8]; const float* g_sw = args.in[9];
    const float* w_out = args.in[10]; const float* g_ffn = args.in[11]; const float* w_up = args.in[12]; const float* conv_w = args.in[13]; const float* conv_b = args.in[14];
    const float* w_down = args.in[15]; const float* g_final = args.in[16];
    unsigned char* ws = args.ws; float* out = args.out;
    float* mod = (float*)(ws + WS_MOD); float* costab = (float*)(ws + WS_COS); float* sintab = (float*)(ws + WS_SIN);
    bf16_t* Win = (bf16_t*)(ws + WS_WIN); bf16_t* Wout = (bf16_t*)(ws + WS_WOUT); bf16_t* Wup = (bf16_t*)(ws + WS_WUP); bf16_t* Wdn = (bf16_t*)(ws + WS_WDN);
    bf16_t* H = (bf16_t*)(ws + WS_H); bf16_t* PROJ = (bf16_t*)(ws + WS_PROJ); bf16_t* AO = (bf16_t*)(ws + WS_AO); bf16_t* ACT = (bf16_t*)(ws + WS_ACT); float* SB = (float*)(ws + WS_SB); bf16_t* X1B = (bf16_t*)(ws + WS_X1B);
    const int lo = args.ph_lo, hi = args.ph_hi;
    volatile LAS unsigned* barst = (volatile LAS unsigned*)(lds + LDS_BARST_OFF);
    if (tid < 2) barst[tid] = 0u;
    __syncthreads();
    XcdBarrier xbar = xcd_barrier_post((unsigned*)(ws + WS_BAR), barst);
#define IN(k) (lo <= (k) && (k) < hi)
#define SEAM(k) do { if (IN(k) && IN((k) + 1)) { if (args.ph_hi > 1000) grid.sync(); else xcd_barrier(xbar); } } while (0)

    if (IN(0)) {
        {
            const int gi = bid * 512 + tid;
            for (int e = gi; e < SEQ * 32; e += G * 512) { const int pos = e >> 5, f = e & 31;
                const float inv = powf(10000.f, -(float)f / 32.f); const float ang = (float)pos * inv;
                costab[e] = cosf(ang); sintab[e] = sinf(ang); }
        }
        if (bid < 192) {
            LAS float* sc = (LAS float*)lds; LAS float* red = (LAS float*)(lds + 65536);
#pragma unroll 8
            for (int i = tid; i < NB * DM; i += 512) { const float v = cvec[i]; sc[i] = v / (1.f + __expf(-v)); }
            __syncthreads();
            const int n0 = 32 * bid, col = lane & 31, par = lane >> 5;
            float acc[16];
#pragma unroll
            for (int b = 0; b < 16; ++b) acc[b] = 0.f;
            const float* wp = w_ada + n0 + col;
#pragma unroll 8
            for (int kk = 0; kk < 64; ++kk) { const int k = wave * 128 + kk * 2 + par; const float w = wp[(size_t)k * 6144];
#pragma unroll
                for (int b = 0; b < 16; ++b) acc[b] += sc[b * DM + k] * w; }
#pragma unroll
            for (int b = 0; b < 16; ++b) red[((wave * 2 + par) * 16 + b) * 32 + col] = acc[b];
            __syncthreads();
            { const int b = tid >> 5, cc = tid & 31; float s = b_ada[n0 + cc];
#pragma unroll
              for (int g = 0; g < 16; ++g) s += red[(g * 16 + b) * 32 + cc];
              mod[b * 6144 + n0 + cc] = s; }
            __syncthreads();
        }
        {
            LAS float* scr = (LAS float*)(lds + wave * 16384);
            const int gw = bid * 8 + wave, NGW = G * 8;
            constexpr int I_IN = (DM / 64) * (NIN / 32), I_OUT = (DM / 64) * (DM / 32), I_UP = (DM / 64) * (NUP / 32), I_DN = (DFF / 64) * (DM / 32);
            for (int it = gw; it < I_IN + I_OUT + I_UP + I_DN; it += NGW) {
                int r = it;
                if (r < I_IN) { transpose_item<1>(w_in, DM, NIN, Win, nullptr, scr, r, lane); continue; } r -= I_IN;
                if (r < I_OUT) { const int kb = r / (DM / 32); transpose_item<0>(w_out, DM, DM, Wout, (kb < 8) ? g_na : (g_sw - 512), scr, r, lane); continue; } r -= I_OUT;
                if (r < I_UP) { transpose_item<2>(w_up, DM, NUP, Wup, nullptr, scr, r, lane); continue; } r -= I_UP;
                transpose_item<0>(w_down, DFF, DM, Wdn, nullptr, scr, r, lane);
            }
        }
    }
    SEAM(0);
    if (IN(1)) row_phase<0>(x, H, nullptr, g_attn, mod, 0, 1024);
    SEAM(1);
    if (IN(2)) {
        Gemm g{H, Win, MTOK, NIN, DM}; StaticOrder S; S.init(MTOK, NIN, G, bid);
        EpiIn E{PROJ, costab, sintab};
        gemm_phase<EpiIn, StaticOrder, true, true>(lds, g, S, E);
    }
    SEAM(2);
    if (IN(3)) attn_phase(lds, PROJ, AO, rpb, sink);
    SEAM(3);
    if (IN(4)) {
        Gemm g{AO, Wout, MTOK, DM, DM}; StaticOrder S; S.init(MTOK, DM, G, bid);
        EpiResB<false> E{x, X1B, mod + 2048};
        gemm_phase<EpiResB<false>, StaticOrder, true, true>(lds, g, S, E);
    }
    SEAM(4);
    if (IN(5)) row_phase_b16<0>(X1B, H, nullptr, g_ffn, mod, 3072, 4096);
    SEAM(5);
    if (IN(6)) {
        Gemm g{H, Wup, MTOK, NUP, DM}; StaticOrder S; S.init(MTOK, NUP, G, bid);
        EpiUp E{ACT, SB, conv_w, conv_b};
        gemm_phase<EpiUp, StaticOrder, true, true>(lds, g, S, E);
    }
    SEAM(6);
    if (IN(7)) {
        StaticOrder S; S.init(MTOK, DM, G, bid);
        { Unit u; for (int i = 0; S.next(i, u); ++i) fixup_panel(u.pm, SB, ACT, conv_w); }
        __threadfence(); __syncthreads();
        Gemm g{ACT, Wdn, MTOK, DM, DFF};
        EpiResB<true> E{X1B, X1B, mod + 5120};
        gemm_phase<EpiResB<true>, StaticOrder, true, true>(lds, g, S, E);
    }
    SEAM(7);
    if (IN(8)) row_phase_b16<1>(X1B, nullptr, out, g_final, nullptr, 0, 0);
#undef IN
#undef SEAM
}

#ifndef N_LAUNCH_SPLIT
#define N_LAUNCH_SPLIT 0
#endif
extern "C" void kernel_launch(void* const* d_in, const int* in_sizes, int n_in, void* d_out, int out_size, void* d_ws, size_t ws_size, hipStream_t stream) {
    static int grid_blocks = 0;
    if (grid_blocks == 0) {
        if (n_in != 17 || out_size != MTOK * DM || ws_size < WS_END) { fprintf(stderr, "kernel_launch: unexpected shapes (n_in %d out %d ws %zu)\n", n_in, out_size, ws_size); grid_blocks = -1; return; }
        int dev = 0, cus = 0, per_cu = 0;
        hipGetDevice(&dev); hipDeviceGetAttribute(&cus, hipDeviceAttributeMultiprocessorCount, dev);
        if (hipFuncSetAttribute((const void*)fwd_megakernel, hipFuncAttributeMaxDynamicSharedMemorySize, LDS_BYTES) != hipSuccess) { fprintf(stderr, "kernel_launch: hipFuncSetAttribute failed\n"); grid_blocks = -1; return; }
        if (hipOccupancyMaxActiveBlocksPerMultiprocessor(&per_cu, (const void*)fwd_megakernel, 512, LDS_BYTES) != hipSuccess || per_cu < 1) { fprintf(stderr, "kernel_launch: occupancy query failed (%d)\n", per_cu); per_cu = 1; (void)hipGetLastError(); }
        grid_blocks = cus * per_cu; if (grid_blocks > 256) grid_blocks = 256;
        fprintf(stderr, "kernel_launch: %d CUs x %d blocks -> grid %d\n", cus, per_cu, grid_blocks);
    }
    if (grid_blocks < 0) return;
    if (hipMemsetAsync((char*)d_ws + WS_BAR, 0, BAR_ZERO_BYTES, stream) != hipSuccess) { fprintf(stderr, "kernel_launch: memset failed\n"); return; }
    Args a{};
    for (int i = 0; i < 17; ++i) a.in[i] = (const float*)d_in[i];
    a.out = (float*)d_out; a.ws = (unsigned char*)d_ws;
#if N_LAUNCH_SPLIT
    for (int p = 0; p < 9; ++p) { a.ph_lo = p; a.ph_hi = p + 1; void* kargs[] = {&a};
        hipError_t e = hipLaunchCooperativeKernel((const void*)fwd_megakernel, dim3(grid_blocks), dim3(512), kargs, LDS_BYTES, stream);
        if (e != hipSuccess) { fprintf(stderr, "cooperative launch (phase %d) failed: %s\n", p, hipGetErrorString(e)); return; } }
#else
    a.ph_lo = 0; a.ph_hi = 9; void* kargs[] = {&a};
    hipError_t e = hipLaunchCooperativeKernel((const void*)fwd_megakernel, dim3(grid_blocks), dim3(512), kargs, LDS_BYTES, stream);
    if (e != hipSuccess) fprintf(stderr, "cooperative launch failed: %s (grid %d)\n", hipGetErrorString(e), grid_blocks);
#endif
}
```

```cpp
#include <hip/hip_runtime.h>
#include <hip/hip_cooperative_groups.h>
#include <cstdio>
#include <cstdint>
namespace cg = cooperative_groups;
namespace pg8 {
#define PG8_LAS __attribute__((address_space(3)))
typedef unsigned short bf16_t;
typedef short bf16x8 __attribute__((ext_vector_type(8)));
typedef float f32x4 __attribute__((ext_vector_type(4)));
typedef unsigned u32x4 __attribute__((ext_vector_type(4)));
constexpr int BM = 256, BK = 64, HALF = 128, HTB = HALF * BK * 2  , STAGE_BYTES = 8 * HTB, NXCD = 8, WGM = 8;

__host__ __device__ __forceinline__ int lds_byte(int r, int c) { const int st = (r >> 4) * 2 + (c >> 5), rr = r & 15, cc = c & 31, ob = rr * 64 + cc * 2; return st * 1024 + (ob ^ (((ob >> 9) & 1) << 5)); }
__host__ __device__ __forceinline__ void stage_rc(int b, int& R, int& C) { const int st = b / 1024, sb = b % 1024, swz = sb ^ (((sb >> 9) & 1) << 5); R = (st >> 1) * 16 + swz / 64; C = (st & 1) * 32 + (swz % 64) / 2; }
__host__ __device__ __forceinline__ int perm32(int rho) { const int n = rho >> 4, i = rho & 15; return 8 * (i >> 2) + 4 * n + (i & 3); }

struct Unit { int pm, pn; };
struct Gemm { const bf16_t* A; const bf16_t* Bt; int M, N, K; };

struct StaticOrder {
    int nM, nN, nwg, G, c;
    __host__ __device__ void init(int M, int N, int G_, int c_) { nM = M / BM; nN = N / BM; nwg = nM * nN; G = G_; c = c_; }
    __host__ __device__ bool next(int i, Unit& u) const {
        const long L = (long)i * G + c; if (L >= nwg) return false;
        int wgid = (int)L; { const int q = nwg / NXCD, r = nwg % NXCD, xcd = wgid % NXCD, off = wgid / NXCD; wgid = (xcd < r ? xcd * (q + 1) : r * (q + 1) + (xcd - r) * q) + off; }
        const int nig = WGM * nN, gid = wgid / nig, fm = gid * WGM, gsz = (nM - fm) < WGM ? (nM - fm) : WGM;
        u.pm = fm + ((wgid % nig) % gsz); u.pn = (wgid % nig) / gsz; return true;
    }
    __device__ __forceinline__ void a_ready(const Unit&) const {}
    __device__ __forceinline__ void done(const Unit&) const {}
};

__device__ __forceinline__ unsigned cvt_pk_bf16(float lo, float hi) { unsigned r; asm volatile("v_cvt_pk_bf16_f32 %0, %1, %2" : "=v"(r) : "v"(lo), "v"(hi)); return r; }
typedef float f32x2 __attribute__((ext_vector_type(2)));
template <class Epi, class Sched, bool ALIGN_EPI = false, bool SP2 = false, bool ROWPERM = false>
__device__ __forceinline__ void gemm_phase(PG8_LAS unsigned char* lds, const Gemm g, const Sched& S, const Epi& E) {
    const int tid = threadIdx.x, wid = __builtin_amdgcn_readfirstlane(tid >> 6), lane = tid & 63, wr = wid >> 2, wc = wid & 3, fr = lane & 15, fq = lane >> 4;
    const int K = g.K, nt = K / BK;
    unsigned voffA[2], voffB[2];
#pragma unroll
    for (int i = 0; i < 2; ++i) { int R, C; stage_rc(tid * 16 + i * 8192, R, C); const int Rb = Epi::PERM ? ((R & ~31) + perm32(R & 31)) : R;
        const int Ra = ROWPERM ? ((R & ~63) + 4 * (R & 15) + ((R >> 4) & 3)) : R;
        voffA[i] = (unsigned)(Ra * K + C) * 2u; voffB[i] = (unsigned)(Rb * K + C) * 2u; }
    const size_t kstep = (size_t)(BK * 2);
    const size_t hstep = (size_t)HALF * K * 2;
    const size_t tstep = 2 * hstep;
    const unsigned ldsw = (unsigned)wid * 1024u;
    const int aoff = lds_byte(wr * 64 + fr, fq * 8), boff = lds_byte(wc * 32 + fr, fq * 8);
#define PG8_SA(b, h) (((b) * 2 + (h)) * HTB)
#define PG8_SB(b, h) ((4 + (b) * 2 + (h)) * HTB)
#define PG8_STAGE(bufoff, gbase, voff) do { _Pragma("unroll") for (int _i = 0; _i < 2; ++_i) \
        __builtin_amdgcn_global_load_lds((const unsigned*)((const char*)(gbase) + (voff)[_i]), (PG8_LAS unsigned*)(lds + (bufoff) + ldsw + _i * 8192), 16, 0, 0); } while (0)
#define PG8_LDA(dst, b, h) do { _Pragma("unroll") for (int m = 0; m < 4; ++m) _Pragma("unroll") for (int k = 0; k < 2; ++k) dst[m][k] = *(const PG8_LAS bf16x8*)(lds + PG8_SA(b, h) + aoff + m * 2048 + k * 1024); } while (0)
#define PG8_LDB(dst, b, h) do { _Pragma("unroll") for (int n = 0; n < 2; ++n) _Pragma("unroll") for (int k = 0; k < 2; ++k) dst[n][k] = *(const PG8_LAS bf16x8*)(lds + PG8_SB(b, h) + boff + n * 2048 + k * 1024); } while (0)
#define PG8_MMA(ai, bj, At, Bt) do { __builtin_amdgcn_s_setprio(1); _Pragma("unroll") for (int m = 0; m < 4; ++m) _Pragma("unroll") for (int n = 0; n < 2; ++n) _Pragma("unroll") for (int k = 0; k < 2; ++k) \
        acc[ai][bj][m][n] = __builtin_amdgcn_mfma_f32_16x16x32_bf16(Bt[n][k], At[m][k], acc[ai][bj][m][n], 0, 0, 0); __builtin_amdgcn_s_setprio(0); } while (0)
#define PG8_WAIT_V(n) asm volatile("s_waitcnt vmcnt(" #n ")" ::: "memory")
#define PG8_WAIT_L(n) asm volatile("s_waitcnt lgkmcnt(" #n ")" ::: "memory")
#define PG8_BAR __builtin_amdgcn_s_barrier()
#define PG8_SCHED __builtin_amdgcn_sched_barrier(0)
    Unit cur, nxt; int ui = 0;
    if (!S.next(0, cur)) return;
    f32x4 acc[2][2][4][2];
#pragma unroll
    for (int a = 0; a < 2; ++a)
#pragma unroll
        for (int b = 0; b < 2; ++b)
#pragma unroll
            for (int m = 0; m < 4; ++m)
#pragma unroll
                for (int n = 0; n < 2; ++n) acc[a][b][m][n] = (f32x4){0.f, 0.f, 0.f, 0.f};
    bf16x8 At[4][2], B0[2][2], B1[2][2];
    const char* cA = (const char*)g.A + (size_t)cur.pm * tstep; const char* cB = (const char*)g.Bt + (size_t)cur.pn * tstep;
    S.a_ready(cur);
    if constexpr (SP2) {
        PG8_STAGE(PG8_SB(0, 0), cB, voffB); PG8_STAGE(PG8_SB(0, 1), cB + hstep, voffB); PG8_STAGE(PG8_SA(0, 0), cA, voffA); PG8_STAGE(PG8_SA(0, 1), cA + hstep, voffA);
        if (wr == 1) PG8_BAR;
        PG8_WAIT_V(2); PG8_BAR;
        PG8_STAGE(PG8_SB(1, 0), cB + kstep, voffB); PG8_STAGE(PG8_SA(1, 0), cA + kstep, voffA); PG8_STAGE(PG8_SB(1, 1), cB + hstep + kstep, voffB);
        PG8_WAIT_V(6); PG8_BAR;
    } else {
        PG8_STAGE(PG8_SB(0, 0), cB, voffB); PG8_STAGE(PG8_SA(0, 0), cA, voffA); PG8_STAGE(PG8_SB(0, 1), cB + hstep, voffB); PG8_STAGE(PG8_SA(0, 1), cA + hstep, voffA);
        if (wr == 1) PG8_BAR;
        PG8_WAIT_V(4); PG8_BAR;
        PG8_STAGE(PG8_SB(1, 0), cB + kstep, voffB); PG8_STAGE(PG8_SA(1, 0), cA + kstep, voffA); PG8_STAGE(PG8_SB(1, 1), cB + hstep + kstep, voffB);
        PG8_WAIT_V(6); PG8_BAR;
    }
    for (;;) {
        const bool has_next = S.next(ui + 1, nxt);
        const char* nA = has_next ? (const char*)g.A + (size_t)nxt.pm * tstep : cA; const char* nB = has_next ? (const char*)g.Bt + (size_t)nxt.pn * tstep : cB;
        for (int t = 0; t < nt; t += 2) {
            const bool last = (t == nt - 2);
            const char* a1 = cA + (size_t)(t + 1) * kstep;
            const char* a2 = last ? nA : cA + (size_t)(t + 2) * kstep; const char* b2 = last ? nB : cB + (size_t)(t + 2) * kstep;
            const char* a3 = a2 + kstep; const char* b3 = b2 + kstep;
            if (last && has_next) S.a_ready(nxt);
            if constexpr (SP2) {
            PG8_LDB(B0, 0, 0); PG8_LDB(B1, 0, 1); PG8_SCHED; PG8_LDA(At, 0, 0); PG8_STAGE(PG8_SA(1, 1), a1 + hstep, voffA);
            PG8_WAIT_V(8); PG8_WAIT_L(0); PG8_BAR; PG8_MMA(0, 0, At, B0); PG8_MMA(0, 1, At, B1); PG8_BAR; PG8_SCHED;
            PG8_LDA(At, 0, 1); PG8_STAGE(PG8_SB(0, 0), b2, voffB); PG8_STAGE(PG8_SB(0, 1), b2 + hstep, voffB); PG8_STAGE(PG8_SA(0, 0), a2, voffA);
            PG8_WAIT_V(8); PG8_WAIT_L(0); PG8_BAR; PG8_MMA(1, 0, At, B0); PG8_MMA(1, 1, At, B1); PG8_BAR; PG8_SCHED;
            PG8_LDB(B0, 1, 0); PG8_LDB(B1, 1, 1); PG8_SCHED; PG8_LDA(At, 1, 0); PG8_STAGE(PG8_SA(0, 1), a2 + hstep, voffA);
            PG8_WAIT_V(8); PG8_WAIT_L(0); PG8_BAR; PG8_MMA(0, 0, At, B0); PG8_MMA(0, 1, At, B1); PG8_BAR; PG8_SCHED;
            PG8_LDA(At, 1, 1); PG8_STAGE(PG8_SB(1, 0), b3, voffB); PG8_STAGE(PG8_SB(1, 1), b3 + hstep, voffB); PG8_STAGE(PG8_SA(1, 0), a3, voffA);
            PG8_WAIT_V(8); PG8_WAIT_L(0); PG8_BAR; PG8_MMA(1, 0, At, B0); PG8_MMA(1, 1, At, B1); PG8_BAR; PG8_SCHED;
            } else {
            PG8_LDB(B0, 0, 0); PG8_SCHED; PG8_LDA(At, 0, 0); PG8_STAGE(PG8_SA(1, 1), a1 + hstep, voffA);
            PG8_WAIT_L(8); PG8_BAR; PG8_WAIT_L(0); PG8_MMA(0, 0, At, B0); PG8_BAR; PG8_SCHED;
            PG8_LDB(B1, 0, 1); PG8_STAGE(PG8_SB(0, 0), b2, voffB);
            PG8_BAR; PG8_WAIT_L(0); PG8_MMA(0, 1, At, B1); PG8_BAR;
            PG8_LDA(At, 0, 1); PG8_STAGE(PG8_SA(0, 0), a2, voffA);
            PG8_BAR; PG8_WAIT_L(0); PG8_MMA(1, 0, At, B0); PG8_BAR; PG8_SCHED;
            PG8_STAGE(PG8_SB(0, 1), b2 + hstep, voffB);
            PG8_WAIT_V(6); PG8_BAR; PG8_MMA(1, 1, At, B1); PG8_BAR;
            PG8_LDB(B0, 1, 0); PG8_SCHED; PG8_LDA(At, 1, 0); PG8_STAGE(PG8_SA(0, 1), a2 + hstep, voffA);
            PG8_WAIT_L(8); PG8_BAR; PG8_WAIT_L(0); PG8_MMA(0, 0, At, B0); PG8_BAR; PG8_SCHED;
            PG8_LDB(B1, 1, 1); PG8_STAGE(PG8_SB(1, 0), b3, voffB);
            PG8_BAR; PG8_WAIT_L(0); PG8_MMA(0, 1, At, B1); PG8_BAR;
            PG8_LDA(At, 1, 1); PG8_STAGE(PG8_SA(1, 0), a3, voffA);
            PG8_BAR; PG8_WAIT_L(0); PG8_MMA(1, 0, At, B0); PG8_BAR; PG8_SCHED;
            PG8_STAGE(PG8_SB(1, 1), b3 + hstep, voffB);
            PG8_WAIT_V(6); PG8_BAR; PG8_MMA(1, 1, At, B1); PG8_BAR;
            }
        }
        if constexpr (ALIGN_EPI) { if (wr == 0) PG8_BAR; }
        if constexpr (!Epi::AFTER_DRAIN) { E(acc, cur, wr, wc, fr, fq); S.done(cur); }
        if (!has_next) break;
#pragma unroll
        for (int a = 0; a < 2; ++a)
#pragma unroll
            for (int b = 0; b < 2; ++b)
#pragma unroll
                for (int m = 0; m < 4; ++m)
#pragma unroll
                    for (int n = 0; n < 2; ++n) acc[a][b][m][n] = (f32x4){0.f, 0.f, 0.f, 0.f};
        cur = nxt; cA = nA; cB = nB; ++ui;
        if constexpr (ALIGN_EPI) { if (wr == 1) PG8_BAR; }
    }
    PG8_WAIT_V(0);
    if constexpr (!ALIGN_EPI) { if (wr == 0) PG8_BAR; }
    PG8_BAR;
    if constexpr (Epi::AFTER_DRAIN) { E.fused(acc, cur, wr, wc, fr, fq, lds, wid, lane); S.done(cur); }
#undef PG8_SA
#undef PG8_SB
#undef PG8_STAGE
#undef PG8_LDA
#undef PG8_LDB
#undef PG8_MMA
#undef PG8_WAIT_V
#undef PG8_WAIT_L
#undef PG8_BAR
#undef PG8_SCHED
}
constexpr float LOG2E = 1.4426950408889634f;
constexpr float C2 = 0.125f * LOG2E;
struct EpiIn {
    static constexpr bool PERM = true, AFTER_DRAIN = false;
    bf16_t* O; const float* costab; const float* sintab;
    __device__ __forceinline__ void operator()(const f32x4 (&acc)[2][2][4][2], const Unit& u, int wr, int wc, int fr, int fq) const {
        const int pn = u.pn, row0 = u.pm * BM + wr * 64 + fr, col0 = pn * BM + wc * 32 + 8 * fq;
        const bool rope0 = (pn >= 6), rope1 = (pn == 6 || pn == 7);
        const float sc = (pn < 2 || pn == 6 || pn == 7) ? C2 : 1.f;
        const int G4 = 4 * ((wc & 1) * 4 + fq);
#pragma unroll
        for (int ai = 0; ai < 2; ++ai)
#pragma unroll
            for (int m = 0; m < 4; ++m) {
                const int row = row0 + ai * HALF + m * 16, pos = row & 2047;
                f32x4 cs = (f32x4){1.f, 1.f, 1.f, 1.f}, sn = (f32x4){0.f, 0.f, 0.f, 0.f};
                if (rope0) { cs = *(const f32x4*)(costab + pos * 32 + G4); sn = *(const f32x4*)(sintab + pos * 32 + G4); }
                bf16_t* rowp = O + (size_t)row * 2304 + col0;
#pragma unroll
                for (int bj = 0; bj < 2; ++bj) {
                    f32x4 v0 = acc[ai][bj][m][0], v1 = acc[ai][bj][m][1];
                    if (bj == 0 ? rope0 : rope1) { const f32x4 o0 = v0 * cs - v1 * sn, o1 = v1 * cs + v0 * sn; v0 = o0; v1 = o1; }
                    v0 = v0 * sc; v1 = v1 * sc;
                    u32x4 w; w.x = cvt_pk_bf16(v0[0], v0[1]); w.y = cvt_pk_bf16(v0[2], v0[3]); w.z = cvt_pk_bf16(v1[0], v1[1]); w.w = cvt_pk_bf16(v1[2], v1[3]);
                    *(u32x4*)(rowp + bj * HALF) = w;
                }
            }
    }
};
struct EpiRes {
    static constexpr bool PERM = false, AFTER_DRAIN = false;
    const float* base; float* out; const float* gate;
    __device__ __forceinline__ void operator()(const f32x4 (&acc)[2][2][4][2], const Unit& u, int wr, int wc, int fr, int fq) const {
        const int col0 = u.pn * BM + wc * 32 + 4 * fq, b = u.pm >> 3;
        f32x4 gv[2][2];
#pragma unroll
        for (int bj = 0; bj < 2; ++bj)
#pragma unroll
            for (int n = 0; n < 2; ++n) gv[bj][n] = *(const f32x4*)(gate + b * 6144 + col0 + bj * HALF + n * 16);
#pragma unroll
        for (int ai = 0; ai < 2; ++ai)
#pragma unroll
            for (int mp = 0; mp < 2; ++mp) {
                f32x4 bs[2][2][2];
#pragma unroll
                for (int mm = 0; mm < 2; ++mm) { const size_t off = (size_t)(u.pm * BM + ai * HALF + wr * 64 + (2 * mp + mm) * 16 + fr) * 1024 + col0;
#pragma unroll
                    for (int bj = 0; bj < 2; ++bj)
#pragma unroll
                        for (int n = 0; n < 2; ++n) bs[mm][bj][n] = *(const f32x4*)(base + off + bj * HALF + n * 16); }
                asm volatile("" ::: "memory");
#pragma unroll
                for (int mm = 0; mm < 2; ++mm) { const size_t off = (size_t)(u.pm * BM + ai * HALF + wr * 64 + (2 * mp + mm) * 16 + fr) * 1024 + col0;
#pragma unroll
                    for (int bj = 0; bj < 2; ++bj)
#pragma unroll
                        for (int n = 0; n < 2; ++n) *(f32x4*)(out + off + bj * HALF + n * 16) = bs[mm][bj][n] + gv[bj][n] * acc[ai][bj][2 * mp + mm][n]; }
                asm volatile("" ::: "memory");
            }
    }
};
template <bool BASE_B16> struct EpiResB {
    static constexpr bool PERM = false, AFTER_DRAIN = false;
    const void* base; bf16_t* outb; const float* gate;
    __device__ __forceinline__ void operator()(const f32x4 (&acc)[2][2][4][2], const Unit& u, int wr, int wc, int fr, int fq) const {
        typedef unsigned u32x2v __attribute__((ext_vector_type(2)));
        const int col0 = u.pn * BM + wc * 32 + 4 * fq, b = u.pm >> 3;
        f32x4 gv[2][2];
#pragma unroll
        for (int bj = 0; bj < 2; ++bj)
#pragma unroll
            for (int n = 0; n < 2; ++n) gv[bj][n] = *(const f32x4*)(gate + b * 6144 + col0 + bj * HALF + n * 16);
#pragma unroll
        for (int ai = 0; ai < 2; ++ai)
#pragma unroll
            for (int mp = 0; mp < 2; ++mp) {
                f32x4 bs[2][2][2];
#pragma unroll
                for (int mm = 0; mm < 2; ++mm) { const size_t off = (size_t)(u.pm * BM + ai * HALF + wr * 64 + (2 * mp + mm) * 16 + fr) * 1024 + col0;
#pragma unroll
                    for (int bj = 0; bj < 2; ++bj)
#pragma unroll
                        for (int n = 0; n < 2; ++n) {
                            if (BASE_B16) { const u32x2v w = *(const u32x2v*)((const bf16_t*)base + off + bj * HALF + n * 16);
                                bs[mm][bj][n] = (f32x4){__builtin_bit_cast(float, w.x << 16), __builtin_bit_cast(float, w.x & 0xffff0000u), __builtin_bit_cast(float, w.y << 16), __builtin_bit_cast(float, w.y & 0xffff0000u)}; }
                            else bs[mm][bj][n] = *(const f32x4*)((const float*)base + off + bj * HALF + n * 16); } }
                asm volatile("" ::: "memory");
#pragma unroll
                for (int mm = 0; mm < 2; ++mm) { const size_t off = (size_t)(u.pm * BM + ai * HALF + wr * 64 + (2 * mp + mm) * 16 + fr) * 1024 + col0;
#pragma unroll
                    for (int bj = 0; bj < 2; ++bj)
#pragma unroll
                        for (int n = 0; n < 2; ++n) { const f32x4 v = bs[mm][bj][n] + gv[bj][n] * acc[ai][bj][2 * mp + mm][n];
                            u32x2v w; w.x = cvt_pk_bf16(v[0], v[1]); w.y = cvt_pk_bf16(v[2], v[3]); *(u32x2v*)(outb + off + bj * HALF + n * 16) = w; } }
                asm volatile("" ::: "memory");
            }
    }
};
__device__ __forceinline__ float dpp_ror1(float v) { return __builtin_bit_cast(float, __builtin_amdgcn_update_dpp(0, __builtin_bit_cast(int, v), 0x121, 0xf, 0xf, false)); }
__device__ __forceinline__ float dpp_shr1z(float v) { return __builtin_bit_cast(float, __builtin_amdgcn_update_dpp(0, __builtin_bit_cast(int, v), 0x111, 0xf, 0xf, true)); }
__device__ __forceinline__ float dpp_shl1z(float v) { return __builtin_bit_cast(float, __builtin_amdgcn_update_dpp(0, __builtin_bit_cast(int, v), 0x101, 0xf, 0xf, true)); }
__device__ __forceinline__ float dpp_rol1(float v) { return __builtin_bit_cast(float, __builtin_amdgcn_update_dpp(0, __builtin_bit_cast(int, v), 0x12f, 0xf, 0xf, false)); }
struct EpiUp {
    static constexpr bool PERM = true, AFTER_DRAIN = false;
    bf16_t* ACT; float* SB; const float* cw; const float* cb;
    __device__ __forceinline__ void operator()(const f32x4 (&acc)[2][2][4][2], const Unit& u, int wr, int wc, int fr, int fq) const {
        const int ff0 = u.pn * 128 + wc * 32 + 8 * fq;
        f32x4 w0a[2], w1a[2], w2a[2], bba[2];
#pragma unroll
        for (int n = 0; n < 2; ++n) { w0a[n] = *(const f32x4*)(cw + ff0 + 4 * n); w1a[n] = *(const f32x4*)(cw + 2816 + ff0 + 4 * n); w2a[n] = *(const f32x4*)(cw + 5632 + ff0 + 4 * n); bba[n] = *(const f32x4*)(cb + ff0 + 4 * n); }
#pragma unroll
        for (int ai = 0; ai < 2; ++ai) {
            const int chunk = 4 * u.pm + 2 * ai + wr, row0 = chunk * 64;
            unsigned pk[4][4];
            float bG[8], bV[8], bC[8];
#pragma unroll
            for (int n = 0; n < 2; ++n) {
                const f32x4 w0 = w0a[n], w1 = w1a[n], w2 = w2a[n], bb = bba[n];
#pragma unroll
                for (int jp = 0; jp < 2; ++jp) {
                    float av[4][2];
#pragma unroll
                    for (int jj = 0; jj < 2; ++jj) {
                        const int j = 2 * jp + jj;
                        const float pm0 = dpp_shr1z(acc[ai][1][3][n][j]), nm3 = dpp_shl1z(acc[ai][1][0][n][j]);
#pragma unroll
                        for (int m = 0; m < 4; ++m) {
                            const float cur = acc[ai][1][m][n][j], val = acc[ai][0][m][n][j];
                            const float pv = (m > 0) ? acc[ai][1][m > 0 ? m - 1 : 0][n][j] : pm0, nx = (m < 3) ? acc[ai][1][m < 3 ? m + 1 : 3][n][j] : nm3;
                            const float gc = w0[j] * pv + w1[j] * cur + w2[j] * nx + bb[j];
                            av[m][jj] = gc * val * __builtin_amdgcn_rcpf(1.f + __builtin_amdgcn_exp2f(-LOG2E * gc));
                            if (m == 0) { bG[4 * n + j] = gc; bV[4 * n + j] = val; bC[4 * n + j] = cur; }
                            if (m == 3) { const bool l = (fr == 15); bG[4 * n + j] = l ? gc : bG[4 * n + j]; bV[4 * n + j] = l ? val : bV[4 * n + j]; bC[4 * n + j] = l ? cur : bC[4 * n + j]; }
                        }
                    }
#pragma unroll
                    for (int m = 0; m < 4; ++m) pk[m][2 * n + jp] = cvt_pk_bf16(av[m][0], av[m][1]);
                }
            }
#pragma unroll
            for (int m = 0; m < 4; ++m) { u32x4 w; w.x = pk[m][0]; w.y = pk[m][1]; w.z = pk[m][2]; w.w = pk[m][3]; *(u32x4*)(ACT + (size_t)(row0 + 4 * fr + m) * 2816 + ff0) = w; }
            if (fr == 0 || fr == 15) {
                float* sb = SB + ((size_t)(chunk * 2 + (fr == 15 ? 1 : 0)) * 3) * 2816 + ff0;
#pragma unroll
                for (int n = 0; n < 2; ++n) { *(f32x4*)(sb + 4 * n) = (f32x4){bG[4 * n], bG[4 * n + 1], bG[4 * n + 2], bG[4 * n + 3]}; *(f32x4*)(sb + 2816 + 4 * n) = (f32x4){bV[4 * n], bV[4 * n + 1], bV[4 * n + 2], bV[4 * n + 3]};
                    *(f32x4*)(sb + 5632 + 4 * n) = (f32x4){bC[4 * n], bC[4 * n + 1], bC[4 * n + 2], bC[4 * n + 3]}; }
            }
        }
    }
};
}
using namespace pg8;
#define LAS PG8_LAS
typedef float f32x16 __attribute__((ext_vector_type(16)));
typedef short s16x4 __attribute__((ext_vector_type(4)));
typedef short v4i16_t __attribute__((ext_vector_type(4)));
typedef unsigned u32x2 __attribute__((ext_vector_type(2)));

constexpr int NB = 16, SEQ = 2048, DM = 1024, MTOK = NB * SEQ, NIN = 2304, DFF = 2816, NUP = 5632;
constexpr float EPS = 1e-6f;
constexpr size_t MiB = 1u << 20;
constexpr size_t WS_BAR = 0, BAR_ZERO_BYTES = 16384;
constexpr size_t WS_MOD = 1 * MiB, WS_COS = 2 * MiB, WS_SIN = 2 * MiB + 512 * 1024, WS_WIN = 4 * MiB, WS_WOUT = 10 * MiB, WS_WUP = 12 * MiB, WS_WDN = 24 * MiB;
constexpr size_t WS_H = 32 * MiB, WS_PROJ = 96 * MiB, WS_AO = 240 * MiB, WS_ACT = 96 * MiB  , WS_SB = 304 * MiB, WS_X1B = 346 * MiB, WS_END = 410 * MiB;
static_assert(WS_ACT + (size_t)MTOK * DFF * 2 <= WS_SB && WS_SB + (size_t)512 * 2 * 3 * DFF * 4 <= WS_END, "ws map");
constexpr int LDS_BYTES = 147456, LDS_BARST_OFF = 131072;
constexpr int ATT_BIAS_OFF = 0, ATT_BSTR = 640, ATT_V_OFF = 20480, ATT_VROW = 192, ATT_VBUF = 32 * ATT_VROW, ATT_RED_OFF = ATT_V_OFF + 8 * 2 * ATT_VBUF;
static_assert(ATT_RED_OFF + 2 * 8 * 64 * 4 <= LDS_BYTES, "attention LDS");

__device__ __forceinline__ float wave_sum(float v) {
#pragma unroll
    for (int o = 1; o < 64; o <<= 1) v += __shfl_xor(v, o);
    return v;
}
__device__ __forceinline__ s16x4 vtr(unsigned a) { return __builtin_bit_cast(s16x4, __builtin_amdgcn_ds_read_tr16_b64_v4i16((LAS v4i16_t*)(a))); }
__device__ __forceinline__ f32x16 mfma32(bf16x8 a, bf16x8 b, f32x16 c) { return __builtin_amdgcn_mfma_f32_32x32x16_bf16(a, b, c, 0, 0, 0); }
__device__ __forceinline__ bf16x8 pack8(float a0, float a1, float a2, float a3, float a4, float a5, float a6, float a7) {
    u32x4 w; w.x = cvt_pk_bf16(a0, a1); w.y = cvt_pk_bf16(a2, a3); w.z = cvt_pk_bf16(a4, a5); w.w = cvt_pk_bf16(a6, a7); return __builtin_bit_cast(bf16x8, w);
}
struct NaXf {
    const LAS float* bt; int kc0;
    template <int QUAD> __device__ __forceinline__ void apply(f32x16& s) const {
#pragma unroll
        for (int i = 0; i < 16; ++i) { const int a = i >> 2, b = i & 3, ap = QUAD ? 0 : a, ra = QUAD ? a : 0;
            const float bias = bt[ra * 31 + 8 * ap + b]; const bool ok = (unsigned)(kc0 + 8 * ap + b) < 16u; s[i] = ok ? s[i] + bias : -1e30f; }
    }
};
struct SwXf {
    int mode, ql, h, dq;
    __device__ __forceinline__ void apply(f32x16& s) const {
        {
#pragma unroll
            for (int i = 0; i < 16; ++i) { const int kb = 8 * (i >> 2) + 4 * h + (i & 3); const int d = dq + kb - ql; const bool ok = (d >= -128) && (d <= 128); s[i] = ok ? s[i] : -1e30f; }
        }
    }
};
struct AttnSt { f32x16 o0, o1; float m, l; };
__device__ __forceinline__ void attn_softmax_pv(f32x16& s, AttnSt& st, unsigned vaddr) {
    float mx = s[0];
#pragma unroll
    for (int i = 1; i < 16; ++i) mx = fmaxf(mx, s[i]);
    mx = fmaxf(mx, __shfl_xor(mx, 32));
    const float mn = fmaxf(st.m, mx), al = __builtin_amdgcn_exp2f(st.m - mn); st.m = mn;
    float ps = 0.f;
#pragma unroll
    for (int i = 0; i < 16; ++i) { s[i] = __builtin_amdgcn_exp2f(s[i] - mn); ps += s[i]; }
    st.l = st.l * al + ps; st.o0 = st.o0 * al; st.o1 = st.o1 * al;
    const bf16x8 p0 = pack8(s[0], s[1], s[2], s[3], s[4], s[5], s[6], s[7]), p1 = pack8(s[8], s[9], s[10], s[11], s[12], s[13], s[14], s[15]);
    bf16x8 a[2][2];
#pragma unroll
    for (int db = 0; db < 2; ++db)
#pragma unroll
        for (int ks = 0; ks < 2; ++ks) { const s16x4 lo = vtr(vaddr + ks * 16 * ATT_VROW + db * 64), hi = vtr(vaddr + ks * 16 * ATT_VROW + 8 * ATT_VROW + db * 64);
            a[db][ks] = (bf16x8){lo[0], lo[1], lo[2], lo[3], hi[0], hi[1], hi[2], hi[3]}; }
    st.o0 = mfma32(a[0][0], p0, st.o0); st.o0 = mfma32(a[0][1], p1, st.o0);
    st.o1 = mfma32(a[1][0], p0, st.o1); st.o1 = mfma32(a[1][1], p1, st.o1);
}
struct BlkDesc { int base, hs; };
__device__ __forceinline__ void load_k(bf16x8 (&kf)[4], const bf16_t* proj, int koff, const BlkDesc& d, int ql, int h) {
    const bf16_t* p = proj + (size_t)(d.base + (d.hs ? (ql & 7) + (ql >> 3) * 64 : ql)) * NIN + koff + 32 * h;
#pragma unroll
    for (int kk = 0; kk < 4; ++kk) kf[kk] = *(const bf16x8*)(p + 8 * kk);
}
__device__ __forceinline__ void load_v(u32x4 (&vf)[4], const bf16_t* proj, int voff, const BlkDesc& d, int lane) {
#pragma unroll
    for (int i = 0; i < 4; ++i) { const int x = 8 * i + (lane >> 3); vf[i] = *(const u32x4*)(proj + (size_t)(d.base + (d.hs ? (x & 7) + (x >> 3) * 64 : x)) * NIN + voff + 8 * (lane & 7)); }
}
__device__ __forceinline__ void store_v(LAS unsigned char* vb, const u32x4 (&vf)[4], int lane) {
#pragma unroll
    for (int i = 0; i < 4; ++i) *(LAS u32x4*)(vb + (8 * i + (lane >> 3)) * ATT_VROW + 16 * (lane & 7)) = vf[i];
}

struct UnitId { int valid, swp, b, sub; };
__device__ __forceinline__ UnitId unit_id(int it, int G, int bid) {
    UnitId d; const int u = it * G + bid; d.valid = (u < 1536) ? 1 : 0; const int q3 = u / 3, r3 = u - 3 * q3;
    d.swp = (r3 == 2) ? 1 : 0;
    if (d.swp) { d.b = q3 >> 5; d.sub = q3 & 31; } else { const int idx = q3 * 2 + r3; d.b = idx >> 6; d.sub = idx & 63; }
    return d;
}
struct UnitPre { int valid, tokq, qoff, koff, voff; BlkDesc d0; };
__device__ __forceinline__ UnitPre unit_pre(int it, int G, int bid, int wave, int ql) {
    UnitPre p; const UnitId d = unit_id(it, G, bid); p.valid = d.valid;
    if (!d.swp) { const int r = d.sub >> 1, jp = d.sub & 1, rs = min(max(r - 4, 0), 24);
        p.tokq = d.b * SEQ + r * 64 + 32 * jp + ql; p.qoff = wave * 64; p.koff = 512 + wave * 64; p.voff = 1024 + wave * 64; p.d0.base = d.b * SEQ + rs * 64 + 32 * jp; p.d0.hs = 0; }
    else { const int q0 = 64 * d.sub, kvh = wave >> 2, tlo = max(0, (128 - q0) / 32);
        p.tokq = d.b * SEQ + q0 + ql; p.qoff = 1536 + wave * 64; p.koff = 2048 + kvh * 64; p.voff = 2176 + kvh * 64; p.d0.base = d.b * SEQ + q0 - 128 + 32 * tlo; p.d0.hs = 0; }
    return p;
}
__device__ __forceinline__ f32x16 qk_scores(const bf16x8 (&kf)[4], const bf16x8 (&qf)[4]) {
    f32x16 s;
#pragma unroll
    for (int e = 0; e < 16; ++e) s[e] = 0.f;
#pragma unroll
    for (int kk = 0; kk < 4; ++kk) s = mfma32(kf[kk], qf[kk], s);
    return s;
}
__device__ __forceinline__ float attn_norm_l(AttnSt& st) {
    const float lt = st.l + __shfl_xor(st.l, 32), inv = 1.f / lt;
    float ss = 0.f;
#pragma unroll
    for (int i = 0; i < 16; ++i) { st.o0[i] *= inv; st.o1[i] *= inv; ss += st.o0[i] * st.o0[i] + st.o1[i] * st.o1[i]; }
    return ss + __shfl_xor(ss, 32);
}
__device__ __forceinline__ void attn_store(const AttnSt& st, float rn, bf16_t* op) {
#pragma unroll
    for (int a = 0; a < 4; ++a) {
        u32x2 w0, w1;
        w0.x = cvt_pk_bf16(st.o0[4 * a] * rn, st.o0[4 * a + 1] * rn); w0.y = cvt_pk_bf16(st.o0[4 * a + 2] * rn, st.o0[4 * a + 3] * rn);
        w1.x = cvt_pk_bf16(st.o1[4 * a] * rn, st.o1[4 * a + 1] * rn); w1.y = cvt_pk_bf16(st.o1[4 * a + 2] * rn, st.o1[4 * a + 3] * rn);
        *(u32x2*)(op + 8 * a) = w0; *(u32x2*)(op + 32 + 8 * a) = w1;
    }
}
__device__ __forceinline__ void attn_phase(LAS unsigned char* lds, const bf16_t* __restrict__ proj, bf16_t* __restrict__ ao, const float* __restrict__ rpb, const float* __restrict__ sink) {
    const int tid = threadIdx.x, wave = __builtin_amdgcn_readfirstlane(tid >> 6), lane = tid & 63, ql = lane & 31, h = lane >> 5;
    const int G = gridDim.x, bid = blockIdx.x;
    LAS float* btab = (LAS float*)(lds + ATT_BIAS_OFF);
    LAS unsigned char* vbuf = lds + ATT_V_OFF + wave * 2 * ATT_VBUF;
    LAS float* red = (LAS float*)(lds + ATT_RED_OFF);
    bf16x8 qf[4], kf[4], kn[4]; u32x4 vf[4];
    { const UnitPre p = unit_pre(0, G, bid, wave, ql);
      if (p.valid) {
#pragma unroll
          for (int kk = 0; kk < 4; ++kk) qf[kk] = *(const bf16x8*)(proj + (size_t)p.tokq * NIN + p.qoff + 32 * h + 8 * kk);
          load_k(kf, proj, p.koff, p.d0, ql, h); load_v(vf, proj, p.voff, p.d0, lane); } }
#pragma unroll
    for (int i0 = 0; i0 < 8 * ATT_BSTR; i0 += 512) { const int i = i0 + tid, hh = i / ATT_BSTR, j = i % ATT_BSTR - 64; const bool okb = (j >= 0 && j < 465); const float v = rpb[okb ? hh * 465 + j : 0]; btab[i] = okb ? v * LOG2E : 0.f; }
    __syncthreads();
    const int g4 = lane >> 4, i16 = lane & 15;
    const unsigned trb = (unsigned)((4 * (g4 >> 1) + (i16 >> 2)) * ATT_VROW + (16 * (g4 & 1) + 4 * (i16 & 3)) * 2);
    const unsigned vb0 = (unsigned)(size_t)vbuf;
    for (int it = 0;; ++it) {
        const UnitId ud = unit_id(it, G, bid); if (!ud.valid) break;
        const int b = ud.b, sub = ud.sub;
        AttnSt st, stB;
#pragma unroll
        for (int i = 0; i < 16; ++i) { st.o0[i] = 0.f; st.o1[i] = 0.f; stB.o0[i] = 0.f; stB.o1[i] = 0.f; }
        stB.m = 0.f; stB.l = 1.f;
        int tokq, goff;
        store_v(vbuf, vf, lane);
        if (!ud.swp) {
            const int r = sub >> 1, jp = sub & 1, rs = min(max(r - 4, 0), 24), qcol = 32 * jp + ql, cs = min(max(qcol - 8, 0), 48), cq0 = jp ? 24 : 32;
            tokq = b * SEQ + r * 64 + qcol; goff = 0;
            const int koff = 512 + wave * 64, voff = 1024 + wave * 64;
            st.m = -1e30f; st.l = 0.f;
            const LAS float* bt0 = btab + wave * ATT_BSTR + 64;
            auto desc = [&](int i) { BlkDesc d; if (i < 8) { d.base = b * SEQ + (rs + i) * 64 + 32 * jp; d.hs = 0; } else { d.base = b * SEQ + (rs + 4 * (i - 8)) * 64 + cq0; d.hs = 1; } return d; };
            for (int i = 0; i < 10; ++i) {
                if (i + 1 < 10) { const BlkDesc d = desc(i + 1); load_k(kn, proj, koff, d, ql, h); load_v(vf, proj, voff, d, lane); }
                f32x16 s = qk_scores(kf, qf);
                if (i < 8) { const int R = rs + i, c0 = 32 * jp; NaXf xf{bt0 + (R - r + 7) * 31 + (c0 + 4 * h - qcol + 15), c0 + 4 * h - cs}; xf.apply<0>(s); }
                else { const int R = rs + 4 * (i - 8); NaXf xf{bt0 + (R - r + 7) * 31 + (cq0 + 4 * h - qcol + 15), cq0 + 4 * h - cs}; xf.apply<1>(s); }
                attn_softmax_pv(s, st, vb0 + (unsigned)((i & 1) * ATT_VBUF) + trb);
                if (i + 1 < 10) { store_v(vbuf + ((i + 1) & 1) * ATT_VBUF, vf, lane);
#pragma unroll
                    for (int kk = 0; kk < 4; ++kk) kf[kk] = kn[kk]; }
            }
        } else {
            const int q0 = 64 * sub; tokq = b * SEQ + q0 + ql; goff = 512;
            const int kvh = wave >> 2, koff = 2048 + kvh * 64, voff = 2176 + kvh * 64;
            bf16x8 qB[4];
#pragma unroll
            for (int kk = 0; kk < 4; ++kk) qB[kk] = *(const bf16x8*)(proj + (size_t)(tokq + 32) * NIN + 1536 + wave * 64 + 32 * h + 8 * kk);
            st.m = sink[wave] * LOG2E; st.l = (h == 0) ? 1.f : 0.f; stB.m = st.m; stB.l = st.l;
            const int tlo = max(0, (128 - q0) / 32), thi = min(9, (SEQ - 1 - (q0 - 128)) / 32);
            for (int t = tlo, i = 0; t <= thi; ++t, ++i) {
                if (t + 1 <= thi) { BlkDesc d; d.base = b * SEQ + q0 - 128 + 32 * (t + 1); d.hs = 0; load_k(kn, proj, koff, d, ql, h); load_v(vf, proj, voff, d, lane); }
                const unsigned va = vb0 + (unsigned)((i & 1) * ATT_VBUF) + trb;
                if (t <= 8) { f32x16 s = qk_scores(kf, qf); if (t == 0 || t == 8) { SwXf xf{0, ql, h, 32 * t - 128}; xf.apply(s); } attn_softmax_pv(s, st, va); }
                if (t >= 1) { f32x16 s = qk_scores(kf, qB); if (t == 1 || t == 9) { SwXf xf{0, ql, h, 32 * t - 160}; xf.apply(s); } attn_softmax_pv(s, stB, va); }
                if (t + 1 <= thi) { store_v(vbuf + ((i + 1) & 1) * ATT_VBUF, vf, lane);
#pragma unroll
                    for (int kk = 0; kk < 4; ++kk) kf[kk] = kn[kk]; }
            }
        }
        bf16x8 qn[4];
        const UnitPre pn = unit_pre(it + 1, G, bid, wave, ql);
        if (pn.valid) {
#pragma unroll
            for (int kk = 0; kk < 4; ++kk) qn[kk] = *(const bf16x8*)(proj + (size_t)pn.tokq * NIN + pn.qoff + 32 * h + 8 * kk);
            load_k(kn, proj, pn.koff, pn.d0, ql, h); load_v(vf, proj, pn.voff, pn.d0, lane); }
        const float ssA = attn_norm_l(st), ssB = ud.swp ? attn_norm_l(stB) : 0.f;
        LAS float* rp = red + (it & 1) * 512;
        if (h == 0) { rp[wave * 64 + ql] = ssA; rp[wave * 64 + 32 + ql] = ssB; }
        __syncthreads();
        float totA = 0.f, totB = 0.f;
#pragma unroll
        for (int w = 0; w < 8; ++w) { totA += rp[w * 64 + ql]; totB += rp[w * 64 + 32 + ql]; }
        bf16_t* op = ao + (size_t)tokq * DM + goff + wave * 64 + 4 * h;
        attn_store(st, 1.f / sqrtf(totA * (1.f / 512.f) + EPS), op);
        if (ud.swp) attn_store(stB, 1.f / sqrtf(totB * (1.f / 512.f) + EPS), op + (size_t)32 * DM);
        if (pn.valid) {
#pragma unroll
            for (int kk = 0; kk < 4; ++kk) { qf[kk] = qn[kk]; kf[kk] = kn[kk]; } }
    }
    __syncthreads();
}

#define XB_TMO      128
#define XB_XCNT(j)  (256  + 64 * (j))
#define XB_XSUB(j)  (1280 + 64 * (j))
#define XB_XGEN(j)  (2304 + 64 * (j))
#define XB_TOP      3328
#define XB_TOPGEN   3392
#define XCD_BAR_WORDS 3456
#define XB_SPIN_CAP (1u << 18)

__device__ __forceinline__ unsigned xb_ld(unsigned* p)              { return __hip_atomic_load(p, __ATOMIC_RELAXED, __HIP_MEMORY_SCOPE_AGENT); }
__device__ __forceinline__ unsigned xb_add(unsigned* p, unsigned v) { return __hip_atomic_fetch_add(p, v, __ATOMIC_RELAXED, __HIP_MEMORY_SCOPE_AGENT); }
__device__ __forceinline__ unsigned xb_xcc_id() { return (unsigned)__builtin_amdgcn_s_getreg((3 << 11) | 20) & 0xFu; }
#define XB_SPIN(cond, bar) do { unsigned _sp = 0; while (cond) { __builtin_amdgcn_s_sleep(1); \
    if ((++_sp & 255u) == 0u) { if (xb_ld(&(bar)[XB_TMO])) break; if (_sp > XB_SPIN_CAP) { atomicAdd(&(bar)[XB_TMO], 1u); break; } } } } while (0)

struct XcdBarrier {
    unsigned* bar; unsigned x;
    volatile LAS unsigned* st;
};

__device__ __forceinline__ XcdBarrier xcd_barrier_post(unsigned* bar, volatile LAS unsigned* st) {
    XcdBarrier b; b.bar = bar; b.x = xb_xcc_id(); b.st = st;
    if (threadIdx.x == 0) (void)xb_add(&bar[XB_XCNT(b.x)], 1u);
    return b;
}
__device__ __forceinline__ void xcd_barrier_complete(unsigned* bar, unsigned x, unsigned& nloc, unsigned& nx) {
    const unsigned G = gridDim.x * gridDim.y * gridDim.z;
    unsigned sum, cnt, mine, sp = 0u;
    for (;;) {
        sum = 0u; cnt = 0u; mine = 0u;
#pragma unroll
        for (unsigned j = 0; j < 16; ++j) { const unsigned c = xb_ld(&bar[XB_XCNT(j)]); sum += c; cnt += (c > 0u) ? 1u : 0u; mine = (j == x) ? c : mine; }
        if (sum == G) break;
        __builtin_amdgcn_s_sleep(1);
        if ((++sp & 255u) == 0u) { if (xb_ld(&bar[XB_TMO])) break; if (sp > XB_SPIN_CAP) { atomicAdd(&bar[XB_TMO], 1u); break; } }
    }
    nloc = mine > 0u ? mine : 1u; nx = cnt > 0u ? cnt : 1u;
}

__device__ __forceinline__ void xcd_barrier(const XcdBarrier& b) {
    asm volatile("s_waitcnt vmcnt(0)" ::: "memory");
    __syncthreads();
    if (threadIdx.x == 0) {
        unsigned* bar = b.bar;
        __builtin_amdgcn_s_waitcnt(0);
        unsigned nloc = b.st[0], nx = b.st[1];
        if (nloc == 0u) { xcd_barrier_complete(bar, b.x, nloc, nx); b.st[0] = nloc; b.st[1] = nx; }
        const unsigned old = xb_add(&bar[XB_XSUB(b.x)], 1u);
        const unsigned gen = old / nloc;
        if (old + 1u == (gen + 1u) * nloc) {
            __builtin_amdgcn_fence(__ATOMIC_RELEASE, "agent");
            asm volatile("s_waitcnt vmcnt(0)" ::: "memory");
            const unsigned og = xb_add(&bar[XB_TOP], 1u);
            const unsigned tg = og / nx;
            if (og + 1u == (tg + 1u) * nx) xb_add(&bar[XB_TOPGEN], 1u);
            else XB_SPIN(xb_ld(&bar[XB_TOPGEN]) == tg, bar);
            __builtin_amdgcn_fence(__ATOMIC_ACQUIRE, "agent");
            xb_add(&bar[XB_XGEN(b.x)], 1u);
            asm volatile("s_waitcnt vmcnt(0)" ::: "memory");
        } else {
            XB_SPIN(xb_ld(&bar[XB_XGEN(b.x)]) == gen, bar);
            __builtin_amdgcn_fence(__ATOMIC_ACQUIRE, "agent");
            asm volatile("s_waitcnt vmcnt(0)" ::: "memory");
        }
    }
    __syncthreads();
}


__device__ __forceinline__ unsigned f2bf(float f) { unsigned u = __builtin_bit_cast(unsigned, f); return (u + 0x7fffu + ((u >> 16) & 1u)) >> 16; }
__device__ __forceinline__ unsigned pk2(float lo, float hi) { return f2bf(lo) | (f2bf(hi) << 16); }
template <int MAP> __device__ __forceinline__ int rowmap(int n) {
    if (MAP == 1) { if (n < 1536 || n >= 2176) return n; const int e = n - 1536, hh = e >> 6, d = e & 63, dd = d & 31, Gq = dd >> 2, i = dd & 3; return 1536 + 64 * hh + 8 * Gq + (d >= 32 ? 4 : 0) + i; }
    if (MAP == 2) { const int g = (n >= DFF) ? 1 : 0, ff = n - g * DFF; return 256 * (ff >> 7) + 128 * g + (ff & 127); }
    return n;
}
template <int MAP> __device__ __forceinline__ void transpose_item(const float* __restrict__ W, int K, int N, bf16_t* __restrict__ WT, const float* __restrict__ kscale, LAS float* scr, int item, int lane) {
    const int nblk = N / 32, kb = item / nblk, nb = item % nblk, k0 = 64 * kb, n0 = 32 * nb;
#pragma unroll
    for (int i = 0; i < 32; ++i) { const int kk = 2 * i + (lane >> 5); float v = W[(size_t)(k0 + kk) * N + n0 + (lane & 31)]; if (kscale) v *= kscale[k0 + kk]; scr[kk * 33 + (lane & 31)] = v; }
    asm volatile("s_waitcnt lgkmcnt(0)" ::: "memory");
    const int c = lane & 7;
#pragma unroll
    for (int j = 0; j < 4; ++j) { const int n = (lane >> 3) + 8 * j; const LAS float* s = scr + (8 * c) * 33 + n;
        u32x4 o; o.x = pk2(s[0 * 33], s[1 * 33]); o.y = pk2(s[2 * 33], s[3 * 33]); o.z = pk2(s[4 * 33], s[5 * 33]); o.w = pk2(s[6 * 33], s[7 * 33]);
        *(u32x4*)(WT + (size_t)rowmap<MAP>(n0 + n) * K + k0 + 8 * c) = o; }
    asm volatile("s_waitcnt lgkmcnt(0)" ::: "memory");
}
template <int MODE> __device__ __forceinline__ void row_phase(const float* src, bf16_t* dst, float* io, const float* __restrict__ g, const float* __restrict__ mod, int shift_off, int scale_off) {
    const int lane = threadIdx.x & 63, gw = blockIdx.x * 8 + (threadIdx.x >> 6), NGW = gridDim.x * 8, rpw = MTOK / NGW, m_beg = gw * rpw, m_end = (gw == NGW - 1) ? MTOK : m_beg + rpw;
    const float* base = (MODE == 0) ? src : io;
    for (int m0 = m_beg; m0 < m_end; m0 += 4) {
        f32x4 cur[4][4];
#pragma unroll
        for (int r = 0; r < 4; ++r)
#pragma unroll
            for (int j = 0; j < 4; ++j) cur[r][j] = ((const f32x4*)(base + (size_t)min(m0 + r, MTOK - 1) * DM) + lane)[64 * j];
        const int b = m0 >> 11;
        f32x4 gv[4], sc[4], sh[4];
#pragma unroll
        for (int j = 0; j < 4; ++j) { const int c = 4 * lane + 256 * j; gv[j] = *(const f32x4*)(g + c);
            if (MODE == 0) { sc[j] = *(const f32x4*)(mod + b * 6144 + scale_off + c) + 1.f; sh[j] = *(const f32x4*)(mod + b * 6144 + shift_off + c); } }
        float ss[4];
#pragma unroll
        for (int r = 0; r < 4; ++r) { ss[r] = 0.f;
#pragma unroll
            for (int j = 0; j < 4; ++j) { const f32x4 v = cur[r][j]; ss[r] += (v.x * v.x + v.y * v.y) + (v.z * v.z + v.w * v.w); } }
#pragma unroll
        for (int o = 1; o < 64; o <<= 1) {
#pragma unroll
            for (int r = 0; r < 4; ++r) ss[r] += __shfl_xor(ss[r], o); }
#pragma unroll
        for (int r = 0; r < 4; ++r) {
            const int m = m0 + r; if (m >= m_end) break;
            const float rstd = 1.f / sqrtf(ss[r] * (1.f / DM) + EPS);
            if (MODE == 0) { unsigned long long* o8 = (unsigned long long*)(dst + (size_t)m * DM) + lane;
#pragma unroll
                for (int j = 0; j < 4; ++j) { const f32x4 y = cur[r][j] * rstd * gv[j] * sc[j] + sh[j]; o8[64 * j] = (unsigned long long)(cvt_pk_bf16(y.x, y.y)) | ((unsigned long long)cvt_pk_bf16(y.z, y.w) << 32); } }
            else { f32x4* xr = (f32x4*)(io + (size_t)m * DM) + lane;
#pragma unroll
                for (int j = 0; j < 4; ++j) xr[64 * j] = cur[r][j] * rstd * gv[j]; }
        }
    }
}
template <int MODE> __device__ __forceinline__ void row_phase_b16(const bf16_t* src, bf16_t* dst, float* outf, const float* __restrict__ g, const float* __restrict__ mod, int shift_off, int scale_off) {
    const int lane = threadIdx.x & 63, gw = blockIdx.x * 8 + (threadIdx.x >> 6), NGW = gridDim.x * 8, rpw = MTOK / NGW, m_beg = gw * rpw, m_end = (gw == NGW - 1) ? MTOK : m_beg + rpw;
    for (int m0 = m_beg; m0 < m_end; m0 += 4) {
        u32x4 raw[4][2];
#pragma unroll
        for (int r = 0; r < 4; ++r) { const bf16_t* p = src + (size_t)min(m0 + r, MTOK - 1) * DM + 8 * lane; raw[r][0] = *(const u32x4*)p; raw[r][1] = *(const u32x4*)(p + 512); }
        const int b = m0 >> 11;
        f32x4 gv[4], sc[4], sh[4];
#pragma unroll
        for (int j = 0; j < 4; ++j) { const int c = (j >> 1) * 512 + 8 * lane + 4 * (j & 1); gv[j] = *(const f32x4*)(g + c);
            if (MODE == 0) { sc[j] = *(const f32x4*)(mod + b * 6144 + scale_off + c) + 1.f; sh[j] = *(const f32x4*)(mod + b * 6144 + shift_off + c); } }
        f32x4 cur[4][4]; float ss[4];
#pragma unroll
        for (int r = 0; r < 4; ++r) { ss[r] = 0.f;
#pragma unroll
            for (int j = 0; j < 4; ++j) { const unsigned w0 = raw[r][j >> 1][2 * (j & 1)], w1 = raw[r][j >> 1][2 * (j & 1) + 1];
                const f32x4 v = (f32x4){__builtin_bit_cast(float, w0 << 16), __builtin_bit_cast(float, w0 & 0xffff0000u), __builtin_bit_cast(float, w1 << 16), __builtin_bit_cast(float, w1 & 0xffff0000u)};
                cur[r][j] = v; ss[r] += (v.x * v.x + v.y * v.y) + (v.z * v.z + v.w * v.w); } }
#pragma unroll
        for (int o = 1; o < 64; o <<= 1) {
#pragma unroll
            for (int r = 0; r < 4; ++r) ss[r] += __shfl_xor(ss[r], o); }
#pragma unroll
        for (int r = 0; r < 4; ++r) {
            const int m = m0 + r; if (m >= m_end) break;
            const float rstd = 1.f / sqrtf(ss[r] * (1.f / DM) + EPS);
            if (MODE == 0) {
#pragma unroll
                for (int hf = 0; hf < 2; ++hf) { const f32x4 y0 = cur[r][2 * hf] * rstd * gv[2 * hf] * sc[2 * hf] + sh[2 * hf], y1 = cur[r][2 * hf + 1] * rstd * gv[2 * hf + 1] * sc[2 * hf + 1] + sh[2 * hf + 1];
                    u32x4 w; w.x = cvt_pk_bf16(y0.x, y0.y); w.y = cvt_pk_bf16(y0.z, y0.w); w.z = cvt_pk_bf16(y1.x, y1.y); w.w = cvt_pk_bf16(y1.z, y1.w);
                    *(u32x4*)(dst + (size_t)m * DM + hf * 512 + 8 * lane) = w; } }
            else {
#pragma unroll
                for (int j = 0; j < 4; ++j) *(f32x4*)(outf + (size_t)m * DM + (j >> 1) * 512 + 8 * lane + 4 * (j & 1)) = cur[r][j] * rstd * gv[j]; }
        }
    }
}
__device__ __forceinline__ void fixup_panel(int pm, const float* __restrict__ SB, bf16_t* ACT, const float* __restrict__ cw) {
    constexpr int NITEM = 8 * (DFF / 4);
#pragma unroll 1
    for (int e0 = threadIdx.x; e0 < NITEM; e0 += 4 * 512) {
        f32x4 gc[4], val[4], nbr[4], wv[4];
#pragma unroll
        for (int q = 0; q < 4; ++q) {
            const int e = min(e0 + q * 512, NITEM - 1), rr = e / (DFF / 4), c4 = (e % (DFF / 4)) * 4, chunk = 4 * pm + (rr >> 1), which = rr & 1;
            const float* sb = SB + ((size_t)(chunk * 2 + which) * 3) * DFF + c4;
            gc[q] = *(const f32x4*)sb; val[q] = *(const f32x4*)(sb + DFF);
            const bool has = which == 0 ? ((chunk & 31) != 0) : ((chunk & 31) != 31);
            const int nchunk = has ? (which == 0 ? chunk - 1 : chunk + 1) : chunk;
            nbr[q] = *(const f32x4*)(SB + ((size_t)(nchunk * 2 + (which ^ 1)) * 3 + 2) * DFF + c4);
            wv[q] = *(const f32x4*)(cw + (which == 0 ? 0 : 2 * DFF) + c4);
            if (!has) wv[q] = (f32x4){0.f, 0.f, 0.f, 0.f};
        }
#pragma unroll
        for (int q = 0; q < 4; ++q) {
            const int e = e0 + q * 512; if (e >= NITEM) break;
            const int rr = e / (DFF / 4), c4 = (e % (DFF / 4)) * 4, chunk = 4 * pm + (rr >> 1), which = rr & 1;
            const f32x4 g2 = gc[q] + wv[q] * nbr[q];
            float a[4];
#pragma unroll
            for (int j = 0; j < 4; ++j) a[j] = g2[j] * val[q][j] * __builtin_amdgcn_rcpf(1.f + __builtin_amdgcn_exp2f(-LOG2E * g2[j]));
            u32x2 w; w.x = cvt_pk_bf16(a[0], a[1]); w.y = cvt_pk_bf16(a[2], a[3]);
            *(u32x2*)(ACT + (size_t)(chunk * 64 + which * 63) * DFF + c4) = w;
        }
    }
}

struct Args { const float* in[17]; float* out; unsigned char* ws; int ph_lo, ph_hi; };
static_assert(sizeof(Args) == 17 * 8 + 8 + 8 + 8, "Args has no padding");

__global__ void __launch_bounds__(512, 2) fwd_megakernel(Args args) {
    extern __shared__ __attribute__((aligned(16))) unsigned char lds_raw[];
    LAS unsigned char* lds = (LAS unsigned char*)lds_raw;
    cg::grid_group grid = cg::this_grid();
    const int tid = threadIdx.x, wave = __builtin_amdgcn_readfirstlane(tid >> 6), lane = tid & 63, G = gridDim.x, bid = blockIdx.x;
    const float* x = args.in[0]; const float* cvec = args.in[1]; const float* w_ada = args.in[2]; const float* b_ada = args.in[3]; const float* g_attn = args.in[4];
    const float* w_in = args.in[5]; const float* rpb = args.in[6]; const float* sink = args.in[7]; const float* g_na = args.in[8]; const float* g_sw = args.in[9];
    const float* w_out = args.in[10]; const float* g_ffn = args.in[11]; const float* w_up = args.in[12]; const float* conv_w = args.in[13]; const float* conv_b = args.in[14];
    const float* w_down = args.in[15]; const float* g_final = args.in[16];
    unsigned char* ws = args.ws; float* out = args.out;
    float* mod = (float*)(ws + WS_MOD); float* costab = (float*)(ws + WS_COS); float* sintab = (float*)(ws + WS_SIN);
    bf16_t* Win = (bf16_t*)(ws + WS_WIN); bf16_t* Wout = (bf16_t*)(ws + WS_WOUT); bf16_t* Wup = (bf16_t*)(ws + WS_WUP); bf16_t* Wdn = (bf16_t*)(ws + WS_WDN);
    bf16_t* H = (bf16_t*)(ws + WS_H); bf16_t* PROJ = (bf16_t*)(ws + WS_PROJ); bf16_t* AO = (bf16_t*)(ws + WS_AO); bf16_t* ACT = (bf16_t*)(ws + WS_ACT); float* SB = (float*)(ws + WS_SB); bf16_t* X1B = (bf16_t*)(ws + WS_X1B);
    const int lo = args.ph_lo, hi = args.ph_hi;
    volatile LAS unsigned* barst = (volatile LAS unsigned*)(lds + LDS_BARST_OFF);
    if (tid < 2) barst[tid] = 0u;
    __syncthreads();
    XcdBarrier xbar = xcd_barrier_post((unsigned*)(ws + WS_BAR), barst);
#define IN(k) (lo <= (k) && (k) < hi)
#define SEAM(k) do { if (IN(k) && IN((k) + 1)) { if (args.ph_hi > 1000) grid.sync(); else xcd_barrier(xbar); } } while (0)

    if (IN(0)) {
        {
            const int gi = bid * 512 + tid;
            for (int e = gi; e < SEQ * 32; e += G * 512) { const int pos = e >> 5, f = e & 31;
                const float inv = powf(10000.f, -(float)f / 32.f); const float ang = (float)pos * inv;
                costab[e] = cosf(ang); sintab[e] = sinf(ang); }
        }
        if (bid < 192) {
            LAS float* sc = (LAS float*)lds; LAS float* red = (LAS float*)(lds + 65536);
#pragma unroll 8
            for (int i = tid; i < NB * DM; i += 512) { const float v = cvec[i]; sc[i] = v / (1.f + __expf(-v)); }
            __syncthreads();
            const int n0 = 32 * bid, col = lane & 31, par = lane >> 5;
            float acc[16];
#pragma unroll
            for (int b = 0; b < 16; ++b) acc[b] = 0.f;
            const float* wp = w_ada + n0 + col;
#pragma unroll 8
            for (int kk = 0; kk < 64; ++kk) { const int k = wave * 128 + kk * 2 + par; const float w = wp[(size_t)k * 6144];
#pragma unroll
                for (int b = 0; b < 16; ++b) acc[b] += sc[b * DM + k] * w; }
#pragma unroll
            for (int b = 0; b < 16; ++b) red[((wave * 2 + par) * 16 + b) * 32 + col] = acc[b];
            __syncthreads();
            { const int b = tid >> 5, cc = tid & 31; float s = b_ada[n0 + cc];
#pragma unroll
              for (int g = 0; g < 16; ++g) s += red[(g * 16 + b) * 32 + cc];
              mod[b * 6144 + n0 + cc] = s; }
            __syncthreads();
        }
        {
            LAS float* scr = (LAS float*)(lds + wave * 16384);
            const int gw = bid * 8 + wave, NGW = G * 8;
            constexpr int I_IN = (DM / 64) * (NIN / 32), I_OUT = (DM / 64) * (DM / 32), I_UP = (DM / 64) * (NUP / 32), I_DN = (DFF / 64) * (DM / 32);
            for (int it = gw; it < I_IN + I_OUT + I_UP + I_DN; it += NGW) {
                int r = it;
                if (r < I_IN) { transpose_item<1>(w_in, DM, NIN, Win, nullptr, scr, r, lane); continue; } r -= I_IN;
                if (r < I_OUT) { const int kb = r / (DM / 32); transpose_item<0>(w_out, DM, DM, Wout, (kb < 8) ? g_na : (g_sw - 512), scr, r, lane); continue; } r -= I_OUT;
                if (r < I_UP) { transpose_item<2>(w_up, DM, NUP, Wup, nullptr, scr, r, lane); continue; } r -= I_UP;
                transpose_item<0>(w_down, DFF, DM, Wdn, nullptr, scr, r, lane);
            }
        }
    }
    SEAM(0);
    if (IN(1)) row_phase<0>(x, H, nullptr, g_attn, mod, 0, 1024);
    SEAM(1);
    if (IN(2)) {
        Gemm g{H, Win, MTOK, NIN, DM}; StaticOrder S; S.init(MTOK, NIN, G, bid);
        EpiIn E{PROJ, costab, sintab};
        gemm_phase<EpiIn, StaticOrder, true, true>(lds, g, S, E);
    }
    SEAM(2);
    if (IN(3)) attn_phase(lds, PROJ, AO, rpb, sink);
    SEAM(3);
    if (IN(4)) {
        Gemm g{AO, Wout, MTOK, DM, DM}; StaticOrder S; S.init(MTOK, DM, G, bid);
        EpiResB<false> E{x, X1B, mod + 2048};
        gemm_phase<EpiResB<false>, StaticOrder, true, true>(lds, g, S, E);
    }
    SEAM(4);
    if (IN(5)) row_phase_b16<0>(X1B, H, nullptr, g_ffn, mod, 3072, 4096);
    SEAM(5);
    if (IN(6)) {
        Gemm g{H, Wup, MTOK, NUP, DM}; StaticOrder S; S.init(MTOK, NUP, G, bid);
        EpiUp E{ACT, SB, conv_w, conv_b};
        gemm_phase<EpiUp, StaticOrder, true, true, true>(lds, g, S, E);
    }
    SEAM(6);
    if (IN(7)) {
        StaticOrder S; S.init(MTOK, DM, G, bid);
        { Unit u; for (int i = 0; S.next(i, u); ++i) fixup_panel(u.pm, SB, ACT, conv_w); }
        __threadfence(); __syncthreads();
        Gemm g{ACT, Wdn, MTOK, DM, DFF};
        EpiResB<true> E{X1B, X1B, mod + 5120};
        gemm_phase<EpiResB<true>, StaticOrder, true, true>(lds, g, S, E);
    }
    SEAM(7);
    if (IN(8)) row_phase_b16<1>(X1B, nullptr, out, g_final, nullptr, 0, 0);
#undef IN
#undef SEAM
}

#ifndef N_LAUNCH_SPLIT
#define N_LAUNCH_SPLIT 0
#endif
extern "C" void kernel_launch(void* const* d_in, const int* in_sizes, int n_in, void* d_out, int out_size, void* d_ws, size_t ws_size, hipStream_t stream) {
    static int grid_blocks = 0;
    if (grid_blocks == 0) {
        if (n_in != 17 || out_size != MTOK * DM || ws_size < WS_END) { fprintf(stderr, "kernel_launch: unexpected shapes (n_in %d out %d ws %zu)\n", n_in, out_size, ws_size); grid_blocks = -1; return; }
        int dev = 0, cus = 0, per_cu = 0;
        hipGetDevice(&dev); hipDeviceGetAttribute(&cus, hipDeviceAttributeMultiprocessorCount, dev);
        if (hipFuncSetAttribute((const void*)fwd_megakernel, hipFuncAttributeMaxDynamicSharedMemorySize, LDS_BYTES) != hipSuccess) { fprintf(stderr, "kernel_launch: hipFuncSetAttribute failed\n"); grid_blocks = -1; return; }
        if (hipOccupancyMaxActiveBlocksPerMultiprocessor(&per_cu, (const void*)fwd_megakernel, 512, LDS_BYTES) != hipSuccess || per_cu < 1) { fprintf(stderr, "kernel_launch: occupancy query failed (%d)\n", per_cu); per_cu = 1; (void)hipGetLastError(); }
        grid_blocks = cus * per_cu; if (grid_blocks > 256) grid_blocks = 256;
        fprintf(stderr, "kernel_launch: %d CUs x %d blocks -> grid %d\n", cus, per_cu, grid_blocks);
    }
    if (grid_blocks < 0) return;
    if (hipMemsetAsync((char*)d_ws + WS_BAR, 0, BAR_ZERO_BYTES, stream) != hipSuccess) { fprintf(stderr, "kernel_launch: memset failed\n"); return; }
    Args a{};
    for (int i = 0; i < 17; ++i) a.in[i] = (const float*)d_in[i];
    a.out = (float*)d_out; a.ws = (unsigned char*)d_ws;
#if N_LAUNCH_SPLIT
    for (int p = 0; p < 9; ++p) { a.ph_lo = p; a.ph_hi = p + 1; void* kargs[] = {&a};
        hipError_t e = hipLaunchCooperativeKernel((const void*)fwd_megakernel, dim3(grid_blocks), dim3(512), kargs, LDS_BYTES, stream);
        if (e != hipSuccess) { fprintf(stderr, "cooperative launch (phase %d) failed: %s\n", p, hipGetErrorString(e)); return; } }
#else
    a.ph_lo = 0; a.ph_hi = 9; void* kargs[] = {&a};
    hipError_t e = hipLaunchCooperativeKernel((const void*)fwd_megakernel, dim3(grid_blocks), dim3(512), kargs, LDS_BYTES, stream);
    if (e != hipSuccess) fprintf(stderr, "cooperative launch failed: %s (grid %d)\n", hipGetErrorString(e), grid_blocks);
#endif
}
```

```cpp
#include <hip/hip_runtime.h>
#include <hip/hip_cooperative_groups.h>
#include <cstdio>
#include <cstdint>
namespace cg = cooperative_groups;
namespace pg8 {
#define PG8_LAS __attribute__((address_space(3)))
typedef unsigned short bf16_t;
typedef short bf16x8 __attribute__((ext_vector_type(8)));
typedef float f32x4 __attribute__((ext_vector_type(4)));
typedef unsigned u32x4 __attribute__((ext_vector_type(4)));
constexpr int BM = 256, BK = 64, HALF = 128, HTB = HALF * BK * 2  , STAGE_BYTES = 8 * HTB, NXCD = 8, WGM = 8;

__host__ __device__ __forceinline__ int lds_byte(int r, int c) { const int st = (r >> 4) * 2 + (c >> 5), rr = r & 15, cc = c & 31, ob = rr * 64 + cc * 2; return st * 1024 + (ob ^ (((ob >> 9) & 1) << 5)); }
__host__ __device__ __forceinline__ void stage_rc(int b, int& R, int& C) { const int st = b / 1024, sb = b % 1024, swz = sb ^ (((sb >> 9) & 1) << 5); R = (st >> 1) * 16 + swz / 64; C = (st & 1) * 32 + (swz % 64) / 2; }
__host__ __device__ __forceinline__ int perm32(int rho) { const int n = rho >> 4, i = rho & 15; return 8 * (i >> 2) + 4 * n + (i & 3); }

struct Unit { int pm, pn; };
struct Gemm { const bf16_t* A; const bf16_t* Bt; int M, N, K; };

struct StaticOrder {
    int nM, nN, nwg, G, c;
    __host__ __device__ void init(int M, int N, int G_, int c_) { nM = M / BM; nN = N / BM; nwg = nM * nN; G = G_; c = c_; }
    __host__ __device__ bool next(int i, Unit& u) const {
        const long L = (long)i * G + c; if (L >= nwg) return false;
        int wgid = (int)L; { const int q = nwg / NXCD, r = nwg % NXCD, xcd = wgid % NXCD, off = wgid / NXCD; wgid = (xcd < r ? xcd * (q + 1) : r * (q + 1) + (xcd - r) * q) + off; }
        const int nig = WGM * nN, gid = wgid / nig, fm = gid * WGM, gsz = (nM - fm) < WGM ? (nM - fm) : WGM;
        u.pm = fm + ((wgid % nig) % gsz); u.pn = (wgid % nig) / gsz; return true;
    }
    __device__ __forceinline__ void a_ready(const Unit&) const {}
    __device__ __forceinline__ void done(const Unit&) const {}
};

__device__ __forceinline__ unsigned cvt_pk_bf16(float lo, float hi) { unsigned r; asm volatile("v_cvt_pk_bf16_f32 %0, %1, %2" : "=v"(r) : "v"(lo), "v"(hi)); return r; }
typedef float f32x2 __attribute__((ext_vector_type(2)));
template <class Epi, class Sched, bool ALIGN_EPI = false, bool SP2 = false, bool ROWPERM = false>
__device__ __forceinline__ void gemm_phase(PG8_LAS unsigned char* lds, const Gemm g, const Sched& S, const Epi& E) {
    const int tid = threadIdx.x, wid = __builtin_amdgcn_readfirstlane(tid >> 6), lane = tid & 63, wr = wid >> 2, wc = wid & 3, fr = lane & 15, fq = lane >> 4;
    const int K = g.K, nt = K / BK;
    unsigned voffA[2], voffB[2];
#pragma unroll
    for (int i = 0; i < 2; ++i) { int R, C; stage_rc(tid * 16 + i * 8192, R, C); const int Rb = Epi::PERM ? ((R & ~31) + perm32(R & 31)) : R;
        const int Ra = ROWPERM ? ((R & ~63) + 4 * (R & 15) + ((R >> 4) & 3)) : R;
        voffA[i] = (unsigned)(Ra * K + C) * 2u; voffB[i] = (unsigned)(Rb * K + C) * 2u; }
    const size_t kstep = (size_t)(BK * 2);
    const size_t hstep = (size_t)HALF * K * 2;
    const size_t tstep = 2 * hstep;
    const unsigned ldsw = (unsigned)wid * 1024u;
    const int aoff = lds_byte(wr * 64 + fr, fq * 8), boff = lds_byte(wc * 32 + fr, fq * 8);
#define PG8_SA(b, h) (((b) * 2 + (h)) * HTB)
#define PG8_SB(b, h) ((4 + (b) * 2 + (h)) * HTB)
#define PG8_STAGE(bufoff, gbase, voff) do { _Pragma("unroll") for (int _i = 0; _i < 2; ++_i) \
        __builtin_amdgcn_global_load_lds((const unsigned*)((const char*)(gbase) + (voff)[_i]), (PG8_LAS unsigned*)(lds + (bufoff) + ldsw + _i * 8192), 16, 0, 0); } while (0)
#define PG8_LDA(dst, b, h) do { _Pragma("unroll") for (int m = 0; m < 4; ++m) _Pragma("unroll") for (int k = 0; k < 2; ++k) dst[m][k] = *(const PG8_LAS bf16x8*)(lds + PG8_SA(b, h) + aoff + m * 2048 + k * 1024); } while (0)
#define PG8_LDB(dst, b, h) do { _Pragma("unroll") for (int n = 0; n < 2; ++n) _Pragma("unroll") for (int k = 0; k < 2; ++k) dst[n][k] = *(const PG8_LAS bf16x8*)(lds + PG8_SB(b, h) + boff + n * 2048 + k * 1024); } while (0)
#define PG8_MMA(ai, bj, At, Bt) do { __builtin_amdgcn_s_setprio(1); _Pragma("unroll") for (int m = 0; m < 4; ++m) _Pragma("unroll") for (int n = 0; n < 2; ++n) _Pragma("unroll") for (int k = 0; k < 2; ++k) \
        acc[ai][bj][m][n] = __builtin_amdgcn_mfma_f32_16x16x32_bf16(Bt[n][k], At[m][k], acc[ai][bj][m][n], 0, 0, 0); __builtin_amdgcn_s_setprio(0); } while (0)
#define PG8_WAIT_V(n) asm volatile("s_waitcnt vmcnt(" #n ")" ::: "memory")
#define PG8_WAIT_L(n) asm volatile("s_waitcnt lgkmcnt(" #n ")" ::: "memory")
#define PG8_BAR __builtin_amdgcn_s_barrier()
#define PG8_SCHED __builtin_amdgcn_sched_barrier(0)
    Unit cur, nxt; int ui = 0;
    if (!S.next(0, cur)) return;
    f32x4 acc[2][2][4][2];
#pragma unroll
    for (int a = 0; a < 2; ++a)
#pragma unroll
        for (int b = 0; b < 2; ++b)
#pragma unroll
            for (int m = 0; m < 4; ++m)
#pragma unroll
                for (int n = 0; n < 2; ++n) acc[a][b][m][n] = (f32x4){0.f, 0.f, 0.f, 0.f};
    bf16x8 At[4][2], B0[2][2], B1[2][2];
    const char* cA = (const char*)g.A + (size_t)cur.pm * tstep; const char* cB = (const char*)g.Bt + (size_t)cur.pn * tstep;
    S.a_ready(cur);
    if constexpr (SP2) {
        PG8_STAGE(PG8_SB(0, 0), cB, voffB); PG8_STAGE(PG8_SB(0, 1), cB + hstep, voffB); PG8_STAGE(PG8_SA(0, 0), cA, voffA); PG8_STAGE(PG8_SA(0, 1), cA + hstep, voffA);
        if (wr == 1) PG8_BAR;
        PG8_WAIT_V(2); PG8_BAR;
        PG8_STAGE(PG8_SB(1, 0), cB + kstep, voffB); PG8_STAGE(PG8_SA(1, 0), cA + kstep, voffA); PG8_STAGE(PG8_SB(1, 1), cB + hstep + kstep, voffB);
        PG8_WAIT_V(6); PG8_BAR;
    } else {
        PG8_STAGE(PG8_SB(0, 0), cB, voffB); PG8_STAGE(PG8_SA(0, 0), cA, voffA); PG8_STAGE(PG8_SB(0, 1), cB + hstep, voffB); PG8_STAGE(PG8_SA(0, 1), cA + hstep, voffA);
        if (wr == 1) PG8_BAR;
        PG8_WAIT_V(4); PG8_BAR;
        PG8_STAGE(PG8_SB(1, 0), cB + kstep, voffB); PG8_STAGE(PG8_SA(1, 0), cA + kstep, voffA); PG8_STAGE(PG8_SB(1, 1), cB + hstep + kstep, voffB);
        PG8_WAIT_V(6); PG8_BAR;
    }
    for (;;) {
        const bool has_next = S.next(ui + 1, nxt);
        const char* nA = has_next ? (const char*)g.A + (size_t)nxt.pm * tstep : cA; const char* nB = has_next ? (const char*)g.Bt + (size_t)nxt.pn * tstep : cB;
        for (int t = 0; t < nt; t += 2) {
            const bool last = (t == nt - 2);
            const char* a1 = cA + (size_t)(t + 1) * kstep;
            const char* a2 = last ? nA : cA + (size_t)(t + 2) * kstep; const char* b2 = last ? nB : cB + (size_t)(t + 2) * kstep;
            const char* a3 = a2 + kstep; const char* b3 = b2 + kstep;
            if (last && has_next) S.a_ready(nxt);
            if constexpr (SP2) {
            PG8_LDB(B0, 0, 0); PG8_LDB(B1, 0, 1); PG8_SCHED; PG8_LDA(At, 0, 0); PG8_STAGE(PG8_SA(1, 1), a1 + hstep, voffA);
            PG8_WAIT_V(8); PG8_WAIT_L(0); PG8_BAR; PG8_MMA(0, 0, At, B0); PG8_MMA(0, 1, At, B1); PG8_BAR; PG8_SCHED;
            PG8_LDA(At, 0, 1); PG8_STAGE(PG8_SB(0, 0), b2, voffB); PG8_STAGE(PG8_SB(0, 1), b2 + hstep, voffB); PG8_STAGE(PG8_SA(0, 0), a2, voffA);
            PG8_WAIT_V(8); PG8_WAIT_L(0); PG8_BAR; PG8_MMA(1, 0, At, B0); PG8_MMA(1, 1, At, B1); PG8_BAR; PG8_SCHED;
            PG8_LDB(B0, 1, 0); PG8_LDB(B1, 1, 1); PG8_SCHED; PG8_LDA(At, 1, 0); PG8_STAGE(PG8_SA(0, 1), a2 + hstep, voffA);
            PG8_WAIT_V(8); PG8_WAIT_L(0); PG8_BAR; PG8_MMA(0, 0, At, B0); PG8_MMA(0, 1, At, B1); PG8_BAR; PG8_SCHED;
            PG8_LDA(At, 1, 1); PG8_STAGE(PG8_SB(1, 0), b3, voffB); PG8_STAGE(PG8_SB(1, 1), b3 + hstep, voffB); PG8_STAGE(PG8_SA(1, 0), a3, voffA);
            PG8_WAIT_V(8); PG8_WAIT_L(0); PG8_BAR; PG8_MMA(1, 0, At, B0); PG8_MMA(1, 1, At, B1); PG8_BAR; PG8_SCHED;
            } else {
            PG8_LDB(B0, 0, 0); PG8_SCHED; PG8_LDA(At, 0, 0); PG8_STAGE(PG8_SA(1, 1), a1 + hstep, voffA);
            PG8_WAIT_L(8); PG8_BAR; PG8_WAIT_L(0); PG8_MMA(0, 0, At, B0); PG8_BAR; PG8_SCHED;
            PG8_LDB(B1, 0, 1); PG8_STAGE(PG8_SB(0, 0), b2, voffB);
            PG8_BAR; PG8_WAIT_L(0); PG8_MMA(0, 1, At, B1); PG8_BAR;
            PG8_LDA(At, 0, 1); PG8_STAGE(PG8_SA(0, 0), a2, voffA);
            PG8_BAR; PG8_WAIT_L(0); PG8_MMA(1, 0, At, B0); PG8_BAR; PG8_SCHED;
            PG8_STAGE(PG8_SB(0, 1), b2 + hstep, voffB);
            PG8_WAIT_V(6); PG8_BAR; PG8_MMA(1, 1, At, B1); PG8_BAR;
            PG8_LDB(B0, 1, 0); PG8_SCHED; PG8_LDA(At, 1, 0); PG8_STAGE(PG8_SA(0, 1), a2 + hstep, voffA);
            PG8_WAIT_L(8); PG8_BAR; PG8_WAIT_L(0); PG8_MMA(0, 0, At, B0); PG8_BAR; PG8_SCHED;
            PG8_LDB(B1, 1, 1); PG8_STAGE(PG8_SB(1, 0), b3, voffB);
            PG8_BAR; PG8_WAIT_L(0); PG8_MMA(0, 1, At, B1); PG8_BAR;
            PG8_LDA(At, 1, 1); PG8_STAGE(PG8_SA(1, 0), a3, voffA);
            PG8_BAR; PG8_WAIT_L(0); PG8_MMA(1, 0, At, B0); PG8_BAR; PG8_SCHED;
            PG8_STAGE(PG8_SB(1, 1), b3 + hstep, voffB);
            PG8_WAIT_V(6); PG8_BAR; PG8_MMA(1, 1, At, B1); PG8_BAR;
            }
        }
        if constexpr (ALIGN_EPI) { if (wr == 0) PG8_BAR; }
        if constexpr (!Epi::AFTER_DRAIN) { E(acc, cur, wr, wc, fr, fq); S.done(cur); }
        if (!has_next) break;
#pragma unroll
        for (int a = 0; a < 2; ++a)
#pragma unroll
            for (int b = 0; b < 2; ++b)
#pragma unroll
                for (int m = 0; m < 4; ++m)
#pragma unroll
                    for (int n = 0; n < 2; ++n) acc[a][b][m][n] = (f32x4){0.f, 0.f, 0.f, 0.f};
        cur = nxt; cA = nA; cB = nB; ++ui;
        if constexpr (ALIGN_EPI) { if (wr == 1) PG8_BAR; }
    }
    PG8_WAIT_V(0);
    if constexpr (!ALIGN_EPI) { if (wr == 0) PG8_BAR; }
    PG8_BAR;
    if constexpr (Epi::AFTER_DRAIN) { E.fused(acc, cur, wr, wc, fr, fq, lds, wid, lane); S.done(cur); }
#undef PG8_SA
#undef PG8_SB
#undef PG8_STAGE
#undef PG8_LDA
#undef PG8_LDB
#undef PG8_MMA
#undef PG8_WAIT_V
#undef PG8_WAIT_L
#undef PG8_BAR
#undef PG8_SCHED
}
constexpr float LOG2E = 1.4426950408889634f;
constexpr float C2 = 0.125f * LOG2E;
struct EpiIn {
    static constexpr bool PERM = true, AFTER_DRAIN = false;
    bf16_t* O; const float* costab; const float* sintab;
    __device__ __forceinline__ void operator()(const f32x4 (&acc)[2][2][4][2], const Unit& u, int wr, int wc, int fr, int fq) const {
        const int pn = u.pn, row0 = u.pm * BM + wr * 64 + fr, col0 = pn * BM + wc * 32 + 8 * fq;
        const bool rope0 = (pn >= 6), rope1 = (pn == 6 || pn == 7);
        const float sc = (pn < 2 || pn == 6 || pn == 7) ? C2 : 1.f;
        const int G4 = 4 * ((wc & 1) * 4 + fq);
#pragma unroll
        for (int ai = 0; ai < 2; ++ai)
#pragma unroll
            for (int m = 0; m < 4; ++m) {
                const int row = row0 + ai * HALF + m * 16, pos = row & 2047;
                f32x4 cs = (f32x4){1.f, 1.f, 1.f, 1.f}, sn = (f32x4){0.f, 0.f, 0.f, 0.f};
                if (rope0) { cs = *(const f32x4*)(costab + pos * 32 + G4); sn = *(const f32x4*)(sintab + pos * 32 + G4); }
                bf16_t* rowp = O + (size_t)row * 2304 + col0;
#pragma unroll
                for (int bj = 0; bj < 2; ++bj) {
                    f32x4 v0 = acc[ai][bj][m][0], v1 = acc[ai][bj][m][1];
                    if (bj == 0 ? rope0 : rope1) { const f32x4 o0 = v0 * cs - v1 * sn, o1 = v1 * cs + v0 * sn; v0 = o0; v1 = o1; }
                    v0 = v0 * sc; v1 = v1 * sc;
                    u32x4 w; w.x = cvt_pk_bf16(v0[0], v0[1]); w.y = cvt_pk_bf16(v0[2], v0[3]); w.z = cvt_pk_bf16(v1[0], v1[1]); w.w = cvt_pk_bf16(v1[2], v1[3]);
                    *(u32x4*)(rowp + bj * HALF) = w;
                }
            }
    }
};
struct EpiRes {
    static constexpr bool PERM = false, AFTER_DRAIN = false;
    const float* base; float* out; const float* gate;
    __device__ __forceinline__ void operator()(const f32x4 (&acc)[2][2][4][2], const Unit& u, int wr, int wc, int fr, int fq) const {
        const int col0 = u.pn * BM + wc * 32 + 4 * fq, b = u.pm >> 3;
        f32x4 gv[2][2];
#pragma unroll
        for (int bj = 0; bj < 2; ++bj)
#pragma unroll
            for (int n = 0; n < 2; ++n) gv[bj][n] = *(const f32x4*)(gate + b * 6144 + col0 + bj * HALF + n * 16);
#pragma unroll
        for (int ai = 0; ai < 2; ++ai)
#pragma unroll
            for (int mp = 0; mp < 2; ++mp) {
                f32x4 bs[2][2][2];
#pragma unroll
                for (int mm = 0; mm < 2; ++mm) { const size_t off = (size_t)(u.pm * BM + ai * HALF + wr * 64 + (2 * mp + mm) * 16 + fr) * 1024 + col0;
#pragma unroll
                    for (int bj = 0; bj < 2; ++bj)
#pragma unroll
                        for (int n = 0; n < 2; ++n) bs[mm][bj][n] = *(const f32x4*)(base + off + bj * HALF + n * 16); }
                asm volatile("" ::: "memory");
#pragma unroll
                for (int mm = 0; mm < 2; ++mm) { const size_t off = (size_t)(u.pm * BM + ai * HALF + wr * 64 + (2 * mp + mm) * 16 + fr) * 1024 + col0;
#pragma unroll
                    for (int bj = 0; bj < 2; ++bj)
#pragma unroll
                        for (int n = 0; n < 2; ++n) *(f32x4*)(out + off + bj * HALF + n * 16) = bs[mm][bj][n] + gv[bj][n] * acc[ai][bj][2 * mp + mm][n]; }
                asm volatile("" ::: "memory");
            }
    }
};
template <bool BASE_B16> struct EpiResB {
    static constexpr bool PERM = false, AFTER_DRAIN = false;
    const void* base; bf16_t* outb; const float* gate;
    __device__ __forceinline__ void operator()(const f32x4 (&acc)[2][2][4][2], const Unit& u, int wr, int wc, int fr, int fq) const {
        typedef unsigned u32x2v __attribute__((ext_vector_type(2)));
        const int col0 = u.pn * BM + wc * 32 + 4 * fq, b = u.pm >> 3;
        f32x4 gv[2][2];
#pragma unroll
        for (int bj = 0; bj < 2; ++bj)
#pragma unroll
            for (int n = 0; n < 2; ++n) gv[bj][n] = *(const f32x4*)(gate + b * 6144 + col0 + bj * HALF + n * 16);
#pragma unroll
        for (int ai = 0; ai < 2; ++ai)
#pragma unroll
            for (int mp = 0; mp < 2; ++mp) {
                f32x4 bs[2][2][2];
#pragma unroll
                for (int mm = 0; mm < 2; ++mm) { const size_t off = (size_t)(u.pm * BM + ai * HALF + wr * 64 + (2 * mp + mm) * 16 + fr) * 1024 + col0;
#pragma unroll
                    for (int bj = 0; bj < 2; ++bj)
#pragma unroll
                        for (int n = 0; n < 2; ++n) {
                            if (BASE_B16) { const u32x2v w = *(const u32x2v*)((const bf16_t*)base + off + bj * HALF + n * 16);
                                bs[mm][bj][n] = (f32x4){__builtin_bit_cast(float, w.x << 16), __builtin_bit_cast(float, w.x & 0xffff0000u), __builtin_bit_cast(float, w.y << 16), __builtin_bit_cast(float, w.y & 0xffff0000u)}; }
                            else bs[mm][bj][n] = *(const f32x4*)((const float*)base + off + bj * HALF + n * 16); } }
                asm volatile("" ::: "memory");
#pragma unroll
                for (int mm = 0; mm < 2; ++mm) { const size_t off = (size_t)(u.pm * BM + ai * HALF + wr * 64 + (2 * mp + mm) * 16 + fr) * 1024 + col0;
#pragma unroll
                    for (int bj = 0; bj < 2; ++bj)
#pragma unroll
                        for (int n = 0; n < 2; ++n) { const f32x4 v = bs[mm][bj][n] + gv[bj][n] * acc[ai][bj][2 * mp + mm][n];
                            u32x2v w; w.x = cvt_pk_bf16(v[0], v[1]); w.y = cvt_pk_bf16(v[2], v[3]); *(u32x2v*)(outb + off + bj * HALF + n * 16) = w; } }
                asm volatile("" ::: "memory");
            }
    }
};
__device__ __forceinline__ float dpp_ror1(float v) { return __builtin_bit_cast(float, __builtin_amdgcn_update_dpp(0, __builtin_bit_cast(int, v), 0x121, 0xf, 0xf, false)); }
__device__ __forceinline__ float dpp_shr1z(float v) { return __builtin_bit_cast(float, __builtin_amdgcn_update_dpp(0, __builtin_bit_cast(int, v), 0x111, 0xf, 0xf, true)); }
__device__ __forceinline__ float dpp_shl1z(float v) { return __builtin_bit_cast(float, __builtin_amdgcn_update_dpp(0, __builtin_bit_cast(int, v), 0x101, 0xf, 0xf, true)); }
__device__ __forceinline__ float dpp_rol1(float v) { return __builtin_bit_cast(float, __builtin_amdgcn_update_dpp(0, __builtin_bit_cast(int, v), 0x12f, 0xf, 0xf, false)); }
struct EpiUp {
    static constexpr bool PERM = true, AFTER_DRAIN = false;
    bf16_t* ACT; float* SB; const float* cw; const float* cb;
    __device__ __forceinline__ void operator()(const f32x4 (&acc)[2][2][4][2], const Unit& u, int wr, int wc, int fr, int fq) const {
        const int ff0 = u.pn * 128 + wc * 32 + 8 * fq;
        f32x4 w0a[2], w1a[2], w2a[2], bba[2];
#pragma unroll
        for (int n = 0; n < 2; ++n) { w0a[n] = *(const f32x4*)(cw + ff0 + 4 * n); w1a[n] = *(const f32x4*)(cw + 2816 + ff0 + 4 * n); w2a[n] = *(const f32x4*)(cw + 5632 + ff0 + 4 * n); bba[n] = *(const f32x4*)(cb + ff0 + 4 * n); }
#pragma unroll
        for (int ai = 0; ai < 2; ++ai) {
            const int chunk = 4 * u.pm + 2 * ai + wr, row0 = chunk * 64;
            unsigned pk[4][4];
            float bG[8], bV[8], bC[8];
#pragma unroll
            for (int n = 0; n < 2; ++n) {
                const f32x4 w0 = w0a[n], w1 = w1a[n], w2 = w2a[n], bb = bba[n];
#pragma unroll
                for (int jp = 0; jp < 2; ++jp) {
                    float av[4][2];
#pragma unroll
                    for (int jj = 0; jj < 2; ++jj) {
                        const int j = 2 * jp + jj;
                        const float pm0 = dpp_shr1z(acc[ai][1][3][n][j]), nm3 = dpp_shl1z(acc[ai][1][0][n][j]);
#pragma unroll
                        for (int m = 0; m < 4; ++m) {
                            const float cur = acc[ai][1][m][n][j], val = acc[ai][0][m][n][j];
                            const float pv = (m > 0) ? acc[ai][1][m > 0 ? m - 1 : 0][n][j] : pm0, nx = (m < 3) ? acc[ai][1][m < 3 ? m + 1 : 3][n][j] : nm3;
                            const float gc = w0[j] * pv + w1[j] * cur + w2[j] * nx + bb[j];
                            av[m][jj] = gc * val * __builtin_amdgcn_rcpf(1.f + __builtin_amdgcn_exp2f(-LOG2E * gc));
                            if (m == 0) { bG[4 * n + j] = gc; bV[4 * n + j] = val; bC[4 * n + j] = cur; }
                            if (m == 3) { const bool l = (fr == 15); bG[4 * n + j] = l ? gc : bG[4 * n + j]; bV[4 * n + j] = l ? val : bV[4 * n + j]; bC[4 * n + j] = l ? cur : bC[4 * n + j]; }
                        }
                    }
#pragma unroll
                    for (int m = 0; m < 4; ++m) pk[m][2 * n + jp] = cvt_pk_bf16(av[m][0], av[m][1]);
                }
            }
#pragma unroll
            for (int m = 0; m < 4; ++m) { u32x4 w; w.x = pk[m][0]; w.y = pk[m][1]; w.z = pk[m][2]; w.w = pk[m][3]; *(u32x4*)(ACT + (size_t)(row0 + 4 * fr + m) * 2816 + ff0) = w; }
            if (fr == 0 || fr == 15) {
                float* sb = SB + ((size_t)(chunk * 2 + (fr == 15 ? 1 : 0)) * 3) * 2816 + ff0;
#pragma unroll
                for (int n = 0; n < 2; ++n) { *(f32x4*)(sb + 4 * n) = (f32x4){bG[4 * n], bG[4 * n + 1], bG[4 * n + 2], bG[4 * n + 3]}; *(f32x4*)(sb + 2816 + 4 * n) = (f32x4){bV[4 * n], bV[4 * n + 1], bV[4 * n + 2], bV[4 * n + 3]};
                    *(f32x4*)(sb + 5632 + 4 * n) = (f32x4){bC[4 * n], bC[4 * n + 1], bC[4 * n + 2], bC[4 * n + 3]}; }
            }
        }
    }
};
}
using namespace pg8;
#define LAS PG8_LAS
typedef float f32x16 __attribute__((ext_vector_type(16)));
typedef short s16x4 __attribute__((ext_vector_type(4)));
typedef short v4i16_t __attribute__((ext_vector_type(4)));
typedef unsigned u32x2 __attribute__((ext_vector_type(2)));

constexpr int NB = 16, SEQ = 2048, DM = 1024, MTOK = NB * SEQ, NIN = 2304, DFF = 2816, NUP = 5632;
constexpr float EPS = 1e-6f;
constexpr size_t MiB = 1u << 20;
constexpr size_t WS_BAR = 0, BAR_ZERO_BYTES = 16384;
constexpr size_t WS_MOD = 1 * MiB, WS_COS = 2 * MiB, WS_SIN = 2 * MiB + 512 * 1024, WS_WIN = 4 * MiB, WS_WOUT = 10 * MiB, WS_WUP = 12 * MiB, WS_WDN = 24 * MiB;
constexpr size_t WS_H = 32 * MiB, WS_PROJ = 96 * MiB, WS_AO = 240 * MiB, WS_ACT = 96 * MiB  , WS_SB = 304 * MiB, WS_X1B = 346 * MiB, WS_END = 410 * MiB;
static_assert(WS_ACT + (size_t)MTOK * DFF * 2 <= WS_SB && WS_SB + (size_t)512 * 2 * 3 * DFF * 4 <= WS_END, "ws map");
constexpr int LDS_BYTES = 147456, LDS_BARST_OFF = 131072;
constexpr int ATT_BIAS_OFF = 0, ATT_BSTR = 640, ATT_V_OFF = 20480, ATT_VROW = 192, ATT_VBUF = 32 * ATT_VROW, ATT_RED_OFF = ATT_V_OFF + 8 * 2 * ATT_VBUF;
static_assert(ATT_RED_OFF + 2 * 8 * 64 * 4 <= LDS_BYTES, "attention LDS");

__device__ __forceinline__ float wave_sum(float v) {
#pragma unroll
    for (int o = 1; o < 64; o <<= 1) v += __shfl_xor(v, o);
    return v;
}
__device__ __forceinline__ s16x4 vtr(unsigned a) { return __builtin_bit_cast(s16x4, __builtin_amdgcn_ds_read_tr16_b64_v4i16((LAS v4i16_t*)(a))); }
__device__ __forceinline__ f32x16 mfma32(bf16x8 a, bf16x8 b, f32x16 c) { return __builtin_amdgcn_mfma_f32_32x32x16_bf16(a, b, c, 0, 0, 0); }
__device__ __forceinline__ bf16x8 pack8(float a0, float a1, float a2, float a3, float a4, float a5, float a6, float a7) {
    u32x4 w; w.x = cvt_pk_bf16(a0, a1); w.y = cvt_pk_bf16(a2, a3); w.z = cvt_pk_bf16(a4, a5); w.w = cvt_pk_bf16(a6, a7); return __builtin_bit_cast(bf16x8, w);
}
struct NaXf {
    const LAS float* bt; int kc0;
    template <int QUAD> __device__ __forceinline__ void apply(f32x16& s) const {
#pragma unroll
        for (int i = 0; i < 16; ++i) { const int a = i >> 2, b = i & 3, ap = QUAD ? 0 : a, ra = QUAD ? a : 0;
            const float bias = bt[ra * 31 + 8 * ap + b]; const bool ok = (unsigned)(kc0 + 8 * ap + b) < 16u; s[i] = ok ? s[i] + bias : -1e30f; }
    }
};
struct SwXf {
    int mode, ql, h, dq;
    __device__ __forceinline__ void apply(f32x16& s) const {
        {
#pragma unroll
            for (int i = 0; i < 16; ++i) { const int kb = 8 * (i >> 2) + 4 * h + (i & 3); const int d = dq + kb - ql; const bool ok = (d >= -128) && (d <= 128); s[i] = ok ? s[i] : -1e30f; }
        }
    }
};
struct AttnSt { f32x16 o0, o1; float m, l; };
__device__ __forceinline__ void attn_softmax_pv(f32x16& s, AttnSt& st, unsigned vaddr) {
    float mx = s[0];
#pragma unroll
    for (int i = 1; i < 16; ++i) mx = fmaxf(mx, s[i]);
    mx = fmaxf(mx, __shfl_xor(mx, 32));
    const float mn = fmaxf(st.m, mx), al = __builtin_amdgcn_exp2f(st.m - mn); st.m = mn;
    float ps = 0.f;
#pragma unroll
    for (int i = 0; i < 16; ++i) { s[i] = __builtin_amdgcn_exp2f(s[i] - mn); ps += s[i]; }
    st.l = st.l * al + ps; st.o0 = st.o0 * al; st.o1 = st.o1 * al;
    const bf16x8 p0 = pack8(s[0], s[1], s[2], s[3], s[4], s[5], s[6], s[7]), p1 = pack8(s[8], s[9], s[10], s[11], s[12], s[13], s[14], s[15]);
    bf16x8 a[2][2];
#pragma unroll
    for (int db = 0; db < 2; ++db)
#pragma unroll
        for (int ks = 0; ks < 2; ++ks) { const s16x4 lo = vtr(vaddr + ks * 16 * ATT_VROW + db * 64), hi = vtr(vaddr + ks * 16 * ATT_VROW + 8 * ATT_VROW + db * 64);
            a[db][ks] = (bf16x8){lo[0], lo[1], lo[2], lo[3], hi[0], hi[1], hi[2], hi[3]}; }
    st.o0 = mfma32(a[0][0], p0, st.o0); st.o0 = mfma32(a[0][1], p1, st.o0);
    st.o1 = mfma32(a[1][0], p0, st.o1); st.o1 = mfma32(a[1][1], p1, st.o1);
}
struct BlkDesc { int base, hs; };
__device__ __forceinline__ void load_k(bf16x8 (&kf)[4], const bf16_t* proj, int koff, const BlkDesc& d, int ql, int h) {
    const bf16_t* p = proj + (size_t)(d.base + (d.hs ? (ql & 7) + (ql >> 3) * 64 : ql)) * NIN + koff + 32 * h;
#pragma unroll
    for (int kk = 0; kk < 4; ++kk) kf[kk] = *(const bf16x8*)(p + 8 * kk);
}
__device__ __forceinline__ void load_v(u32x4 (&vf)[4], const bf16_t* proj, int voff, const BlkDesc& d, int lane) {
#pragma unroll
    for (int i = 0; i < 4; ++i) { const int x = 8 * i + (lane >> 3); vf[i] = *(const u32x4*)(proj + (size_t)(d.base + (d.hs ? (x & 7) + (x >> 3) * 64 : x)) * NIN + voff + 8 * (lane & 7)); }
}
__device__ __forceinline__ void store_v(LAS unsigned char* vb, const u32x4 (&vf)[4], int lane) {
#pragma unroll
    for (int i = 0; i < 4; ++i) *(LAS u32x4*)(vb + (8 * i + (lane >> 3)) * ATT_VROW + 16 * (lane & 7)) = vf[i];
}

struct UnitId { int valid, swp, b, sub; };
__device__ __forceinline__ UnitId unit_id(int it, int G, int bid) {
    UnitId d; const int u = it * G + bid; d.valid = (u < 1536) ? 1 : 0; const int q3 = u / 3, r3 = u - 3 * q3;
    d.swp = (r3 == 2) ? 1 : 0;
    if (d.swp) { d.b = q3 >> 5; d.sub = q3 & 31; } else { const int idx = q3 * 2 + r3; d.b = idx >> 6; d.sub = idx & 63; }
    return d;
}
struct UnitPre { int valid, tokq, qoff, koff, voff; BlkDesc d0; };
__device__ __forceinline__ UnitPre unit_pre(int it, int G, int bid, int wave, int ql) {
    UnitPre p; const UnitId d = unit_id(it, G, bid); p.valid = d.valid;
    if (!d.swp) { const int r = d.sub >> 1, jp = d.sub & 1, rs = min(max(r - 4, 0), 24);
        p.tokq = d.b * SEQ + r * 64 + 32 * jp + ql; p.qoff = wave * 64; p.koff = 512 + wave * 64; p.voff = 1024 + wave * 64; p.d0.base = d.b * SEQ + rs * 64 + 32 * jp; p.d0.hs = 0; }
    else { const int q0 = 64 * d.sub, kvh = wave >> 2, tlo = max(0, (128 - q0) / 32);
        p.tokq = d.b * SEQ + q0 + ql; p.qoff = 1536 + wave * 64; p.koff = 2048 + kvh * 64; p.voff = 2176 + kvh * 64; p.d0.base = d.b * SEQ + q0 - 128 + 32 * tlo; p.d0.hs = 0; }
    return p;
}
__device__ __forceinline__ f32x16 qk_scores(const bf16x8 (&kf)[4], const bf16x8 (&qf)[4]) {
    f32x16 s;
#pragma unroll
    for (int e = 0; e < 16; ++e) s[e] = 0.f;
#pragma unroll
    for (int kk = 0; kk < 4; ++kk) s = mfma32(kf[kk], qf[kk], s);
    return s;
}
__device__ __forceinline__ float attn_norm_l(AttnSt& st) {
    const float lt = st.l + __shfl_xor(st.l, 32), inv = 1.f / lt;
    float ss = 0.f;
#pragma unroll
    for (int i = 0; i < 16; ++i) { st.o0[i] *= inv; st.o1[i] *= inv; ss += st.o0[i] * st.o0[i] + st.o1[i] * st.o1[i]; }
    return ss + __shfl_xor(ss, 32);
}
__device__ __forceinline__ void attn_store(const AttnSt& st, float rn, bf16_t* op) {
#pragma unroll
    for (int a = 0; a < 4; ++a) {
        u32x2 w0, w1;
        w0.x = cvt_pk_bf16(st.o0[4 * a] * rn, st.o0[4 * a + 1] * rn); w0.y = cvt_pk_bf16(st.o0[4 * a + 2] * rn, st.o0[4 * a + 3] * rn);
        w1.x = cvt_pk_bf16(st.o1[4 * a] * rn, st.o1[4 * a + 1] * rn); w1.y = cvt_pk_bf16(st.o1[4 * a + 2] * rn, st.o1[4 * a + 3] * rn);
        *(u32x2*)(op + 8 * a) = w0; *(u32x2*)(op + 32 + 8 * a) = w1;
    }
}
__device__ __forceinline__ void attn_phase(LAS unsigned char* lds, const bf16_t* __restrict__ proj, bf16_t* __restrict__ ao, const float* __restrict__ rpb, const float* __restrict__ sink) {
    const int tid = threadIdx.x, wave = __builtin_amdgcn_readfirstlane(tid >> 6), lane = tid & 63, ql = lane & 31, h = lane >> 5;
    const int G = gridDim.x, bid = blockIdx.x;
    LAS float* btab = (LAS float*)(lds + ATT_BIAS_OFF);
    LAS unsigned char* vbuf = lds + ATT_V_OFF + wave * 2 * ATT_VBUF;
    LAS float* red = (LAS float*)(lds + ATT_RED_OFF);
    bf16x8 qf[4], kf[4], kn[4]; u32x4 vf[4];
    { const UnitPre p = unit_pre(0, G, bid, wave, ql);
      if (p.valid) {
#pragma unroll
          for (int kk = 0; kk < 4; ++kk) qf[kk] = *(const bf16x8*)(proj + (size_t)p.tokq * NIN + p.qoff + 32 * h + 8 * kk);
          load_k(kf, proj, p.koff, p.d0, ql, h); load_v(vf, proj, p.voff, p.d0, lane); } }
#pragma unroll
    for (int i0 = 0; i0 < 8 * ATT_BSTR; i0 += 512) { const int i = i0 + tid, hh = i / ATT_BSTR, j = i % ATT_BSTR - 64; const bool okb = (j >= 0 && j < 465); const float v = rpb[okb ? hh * 465 + j : 0]; btab[i] = okb ? v * LOG2E : 0.f; }
    __syncthreads();
    const int g4 = lane >> 4, i16 = lane & 15;
    const unsigned trb = (unsigned)((4 * (g4 >> 1) + (i16 >> 2)) * ATT_VROW + (16 * (g4 & 1) + 4 * (i16 & 3)) * 2);
    const unsigned vb0 = (unsigned)(size_t)vbuf;
    for (int it = 0;; ++it) {
        const UnitId ud = unit_id(it, G, bid); if (!ud.valid) break;
        const int b = ud.b, sub = ud.sub;
        AttnSt st, stB;
#pragma unroll
        for (int i = 0; i < 16; ++i) { st.o0[i] = 0.f; st.o1[i] = 0.f; stB.o0[i] = 0.f; stB.o1[i] = 0.f; }
        stB.m = 0.f; stB.l = 1.f;
        int tokq, goff;
        store_v(vbuf, vf, lane);
        if (!ud.swp) {
            const int r = sub >> 1, jp = sub & 1, rs = min(max(r - 4, 0), 24), qcol = 32 * jp + ql, cs = min(max(qcol - 8, 0), 48), cq0 = jp ? 24 : 32;
            tokq = b * SEQ + r * 64 + qcol; goff = 0;
            const int koff = 512 + wave * 64, voff = 1024 + wave * 64;
            st.m = -1e30f; st.l = 0.f;
            const LAS float* bt0 = btab + wave * ATT_BSTR + 64;
            auto desc = [&](int i) { BlkDesc d; if (i < 8) { d.base = b * SEQ + (rs + i) * 64 + 32 * jp; d.hs = 0; } else { d.base = b * SEQ + (rs + 4 * (i - 8)) * 64 + cq0; d.hs = 1; } return d; };
            for (int i = 0; i < 10; ++i) {
                if (i + 1 < 10) { const BlkDesc d = desc(i + 1); load_k(kn, proj, koff, d, ql, h); load_v(vf, proj, voff, d, lane); }
                f32x16 s = qk_scores(kf, qf);
                if (i < 8) { const int R = rs + i, c0 = 32 * jp; NaXf xf{bt0 + (R - r + 7) * 31 + (c0 + 4 * h - qcol + 15), c0 + 4 * h - cs}; xf.apply<0>(s); }
                else { const int R = rs + 4 * (i - 8); NaXf xf{bt0 + (R - r + 7) * 31 + (cq0 + 4 * h - qcol + 15), cq0 + 4 * h - cs}; xf.apply<1>(s); }
                attn_softmax_pv(s, st, vb0 + (unsigned)((i & 1) * ATT_VBUF) + trb);
                if (i + 1 < 10) { store_v(vbuf + ((i + 1) & 1) * ATT_VBUF, vf, lane);
#pragma unroll
                    for (int kk = 0; kk < 4; ++kk) kf[kk] = kn[kk]; }
            }
        } else {
            const int q0 = 64 * sub; tokq = b * SEQ + q0 + ql; goff = 512;
            const int kvh = wave >> 2, koff = 2048 + kvh * 64, voff = 2176 + kvh * 64;
            bf16x8 qB[4];
#pragma unroll
            for (int kk = 0; kk < 4; ++kk) qB[kk] = *(const bf16x8*)(proj + (size_t)(tokq + 32) * NIN + 1536 + wave * 64 + 32 * h + 8 * kk);
            st.m = sink[wave] * LOG2E; st.l = (h == 0) ? 1.f : 0.f; stB.m = st.m; stB.l = st.l;
            const int tlo = max(0, (128 - q0) / 32), thi = min(9, (SEQ - 1 - (q0 - 128)) / 32);
            for (int t = tlo, i = 0; t <= thi; ++t, ++i) {
                if (t + 1 <= thi) { BlkDesc d; d.base = b * SEQ + q0 - 128 + 32 * (t + 1); d.hs = 0; load_k(kn, proj, koff, d, ql, h); load_v(vf, proj, voff, d, lane); }
                const unsigned va = vb0 + (unsigned)((i & 1) * ATT_VBUF) + trb;
                if (t <= 8) { f32x16 s = qk_scores(kf, qf); if (t == 0 || t == 8) { SwXf xf{0, ql, h, 32 * t - 128}; xf.apply(s); } attn_softmax_pv(s, st, va); }
                if (t >= 1) { f32x16 s = qk_scores(kf, qB); if (t == 1 || t == 9) { SwXf xf{0, ql, h, 32 * t - 160}; xf.apply(s); } attn_softmax_pv(s, stB, va); }
                if (t + 1 <= thi) { store_v(vbuf + ((i + 1) & 1) * ATT_VBUF, vf, lane);
#pragma unroll
                    for (int kk = 0; kk < 4; ++kk) kf[kk] = kn[kk]; }
            }
        }
        bf16x8 qn[4];
        const UnitPre pn = unit_pre(it + 1, G, bid, wave, ql);
        if (pn.valid) {
#pragma unroll
            for (int kk = 0; kk < 4; ++kk) qn[kk] = *(const bf16x8*)(proj + (size_t)pn.tokq * NIN + pn.qoff + 32 * h + 8 * kk);
            load_k(kn, proj, pn.koff, pn.d0, ql, h); load_v(vf, proj, pn.voff, pn.d0, lane); }
        const float ssA = attn_norm_l(st), ssB = ud.swp ? attn_norm_l(stB) : 0.f;
        LAS float* rp = red + (it & 1) * 512;
        if (h == 0) { rp[wave * 64 + ql] = ssA; rp[wave * 64 + 32 + ql] = ssB; }
        __syncthreads();
        float totA = 0.f, totB = 0.f;
#pragma unroll
        for (int w = 0; w < 8; ++w) { totA += rp[w * 64 + ql]; totB += rp[w * 64 + 32 + ql]; }
        bf16_t* op = ao + (size_t)tokq * DM + goff + wave * 64 + 4 * h;
        attn_store(st, 1.f / sqrtf(totA * (1.f / 512.f) + EPS), op);
        if (ud.swp) attn_store(stB, 1.f / sqrtf(totB * (1.f / 512.f) + EPS), op + (size_t)32 * DM);
        if (pn.valid) {
#pragma unroll
            for (int kk = 0; kk < 4; ++kk) { qf[kk] = qn[kk]; kf[kk] = kn[kk]; } }
    }
    __syncthreads();
}

#define XB_TMO      128
#define XB_XCNT(j)  (256  + 64 * (j))
#define XB_XSUB(j)  (1280 + 64 * (j))
#define XB_XGEN(j)  (2304 + 64 * (j))
#define XB_TOP      3328
#define XB_TOPGEN   3392
#define XCD_BAR_WORDS 3456
#define XB_SPIN_CAP (1u << 18)

__device__ __forceinline__ unsigned xb_ld(unsigned* p)              { return __hip_atomic_load(p, __ATOMIC_RELAXED, __HIP_MEMORY_SCOPE_AGENT); }
__device__ __forceinline__ unsigned xb_add(unsigned* p, unsigned v) { return __hip_atomic_fetch_add(p, v, __ATOMIC_RELAXED, __HIP_MEMORY_SCOPE_AGENT); }
__device__ __forceinline__ unsigned xb_xcc_id() { return (unsigned)__builtin_amdgcn_s_getreg((3 << 11) | 20) & 0xFu; }
#define XB_SPIN(cond, bar) do { unsigned _sp = 0; while (cond) { __builtin_amdgcn_s_sleep(1); \
    if ((++_sp & 255u) == 0u) { if (xb_ld(&(bar)[XB_TMO])) break; if (_sp > XB_SPIN_CAP) { atomicAdd(&(bar)[XB_TMO], 1u); break; } } } } while (0)

struct XcdBarrier {
    unsigned* bar; unsigned x;
    volatile LAS unsigned* st;
};

__device__ __forceinline__ XcdBarrier xcd_barrier_post(unsigned* bar, volatile LAS unsigned* st) {
    XcdBarrier b; b.bar = bar; b.x = xb_xcc_id(); b.st = st;
    if (threadIdx.x == 0) (void)xb_add(&bar[XB_XCNT(b.x)], 1u);
    return b;
}
__device__ __forceinline__ void xcd_barrier_complete(unsigned* bar, unsigned x, unsigned& nloc, unsigned& nx) {
    const unsigned G = gridDim.x * gridDim.y * gridDim.z;
    unsigned sum, cnt, mine, sp = 0u;
    for (;;) {
        sum = 0u; cnt = 0u; mine = 0u;
#pragma unroll
        for (unsigned j = 0; j < 16; ++j) { const unsigned c = xb_ld(&bar[XB_XCNT(j)]); sum += c; cnt += (c > 0u) ? 1u : 0u; mine = (j == x) ? c : mine; }
        if (sum == G) break;
        __builtin_amdgcn_s_sleep(1);
        if ((++sp & 255u) == 0u) { if (xb_ld(&bar[XB_TMO])) break; if (sp > XB_SPIN_CAP) { atomicAdd(&bar[XB_TMO], 1u); break; } }
    }
    nloc = mine > 0u ? mine : 1u; nx = cnt > 0u ? cnt : 1u;
}

__device__ __forceinline__ void xcd_barrier(const XcdBarrier& b) {
    asm volatile("s_waitcnt vmcnt(0)" ::: "memory");
    __syncthreads();
    if (threadIdx.x == 0) {
        unsigned* bar = b.bar;
        __builtin_amdgcn_s_waitcnt(0);
        unsigned nloc = b.st[0], nx = b.st[1];
        if (nloc == 0u) { xcd_barrier_complete(bar, b.x, nloc, nx); b.st[0] = nloc; b.st[1] = nx; }
        const unsigned old = xb_add(&bar[XB_XSUB(b.x)], 1u);
        const unsigned gen = old / nloc;
        if (old + 1u == (gen + 1u) * nloc) {
            __builtin_amdgcn_fence(__ATOMIC_RELEASE, "agent");
            asm volatile("s_waitcnt vmcnt(0)" ::: "memory");
            const unsigned og = xb_add(&bar[XB_TOP], 1u);
            const unsigned tg = og / nx;
            if (og + 1u == (tg + 1u) * nx) xb_add(&bar[XB_TOPGEN], 1u);
            else XB_SPIN(xb_ld(&bar[XB_TOPGEN]) == tg, bar);
            __builtin_amdgcn_fence(__ATOMIC_ACQUIRE, "agent");
            xb_add(&bar[XB_XGEN(b.x)], 1u);
            asm volatile("s_waitcnt vmcnt(0)" ::: "memory");
        } else {
            XB_SPIN(xb_ld(&bar[XB_XGEN(b.x)]) == gen, bar);
            __builtin_amdgcn_fence(__ATOMIC_ACQUIRE, "agent");
            asm volatile("s_waitcnt vmcnt(0)" ::: "memory");
        }
    }
    __syncthreads();
}


__device__ __forceinline__ unsigned f2bf(float f) { unsigned u = __builtin_bit_cast(unsigned, f); return (u + 0x7fffu + ((u >> 16) & 1u)) >> 16; }
__device__ __forceinline__ unsigned pk2(float lo, float hi) { return f2bf(lo) | (f2bf(hi) << 16); }
template <int MAP> __device__ __forceinline__ int rowmap(int n) {
    if (MAP == 1) { if (n < 1536 || n >= 2176) return n; const int e = n - 1536, hh = e >> 6, d = e & 63, dd = d & 31, Gq = dd >> 2, i = dd & 3; return 1536 + 64 * hh + 8 * Gq + (d >= 32 ? 4 : 0) + i; }
    if (MAP == 2) { const int g = (n >= DFF) ? 1 : 0, ff = n - g * DFF; return 256 * (ff >> 7) + 128 * g + (ff & 127); }
    return n;
}
template <int MAP> __device__ __forceinline__ void transpose_item(const float* __restrict__ W, int K, int N, bf16_t* __restrict__ WT, const float* __restrict__ kscale, LAS float* scr, int item, int lane) {
    const int nblk = N / 32, kb = item / nblk, nb = item % nblk, k0 = 64 * kb, n0 = 32 * nb;
#pragma unroll
    for (int i = 0; i < 32; ++i) { const int kk = 2 * i + (lane >> 5); float v = W[(size_t)(k0 + kk) * N + n0 + (lane & 31)]; if (kscale) v *= kscale[k0 + kk]; scr[kk * 33 + (lane & 31)] = v; }
    asm volatile("s_waitcnt lgkmcnt(0)" ::: "memory");
    const int c = lane & 7;
#pragma unroll
    for (int j = 0; j < 4; ++j) { const int n = (lane >> 3) + 8 * j; const LAS float* s = scr + (8 * c) * 33 + n;
        u32x4 o; o.x = pk2(s[0 * 33], s[1 * 33]); o.y = pk2(s[2 * 33], s[3 * 33]); o.z = pk2(s[4 * 33], s[5 * 33]); o.w = pk2(s[6 * 33], s[7 * 33]);
        *(u32x4*)(WT + (size_t)rowmap<MAP>(n0 + n) * K + k0 + 8 * c) = o; }
    asm volatile("s_waitcnt lgkmcnt(0)" ::: "memory");
}
template <int MODE> __device__ __forceinline__ void row_phase(const float* src, bf16_t* dst, float* io, const float* __restrict__ g, const float* __restrict__ mod, int shift_off, int scale_off) {
    const int lane = threadIdx.x & 63, gw = blockIdx.x * 8 + (threadIdx.x >> 6), NGW = gridDim.x * 8, rpw = MTOK / NGW, m_beg = gw * rpw, m_end = (gw == NGW - 1) ? MTOK : m_beg + rpw;
    const float* base = (MODE == 0) ? src : io;
    for (int m0 = m_beg; m0 < m_end; m0 += 4) {
        f32x4 cur[4][4];
#pragma unroll
        for (int r = 0; r < 4; ++r)
#pragma unroll
            for (int j = 0; j < 4; ++j) cur[r][j] = ((const f32x4*)(base + (size_t)min(m0 + r, MTOK - 1) * DM) + lane)[64 * j];
        const int b = m0 >> 11;
        f32x4 gv[4], sc[4], sh[4];
#pragma unroll
        for (int j = 0; j < 4; ++j) { const int c = 4 * lane + 256 * j; gv[j] = *(const f32x4*)(g + c);
            if (MODE == 0) { sc[j] = *(const f32x4*)(mod + b * 6144 + scale_off + c) + 1.f; sh[j] = *(const f32x4*)(mod + b * 6144 + shift_off + c); } }
        float ss[4];
#pragma unroll
        for (int r = 0; r < 4; ++r) { ss[r] = 0.f;
#pragma unroll
            for (int j = 0; j < 4; ++j) { const f32x4 v = cur[r][j]; ss[r] += (v.x * v.x + v.y * v.y) + (v.z * v.z + v.w * v.w); } }
#pragma unroll
        for (int o = 1; o < 64; o <<= 1) {
#pragma unroll
            for (int r = 0; r < 4; ++r) ss[r] += __shfl_xor(ss[r], o); }
#pragma unroll
        for (int r = 0; r < 4; ++r) {
            const int m = m0 + r; if (m >= m_end) break;
            const float rstd = 1.f / sqrtf(ss[r] * (1.f / DM) + EPS);
            if (MODE == 0) { unsigned long long* o8 = (unsigned long long*)(dst + (size_t)m * DM) + lane;
#pragma unroll
                for (int j = 0; j < 4; ++j) { const f32x4 y = cur[r][j] * rstd * gv[j] * sc[j] + sh[j]; o8[64 * j] = (unsigned long long)(cvt_pk_bf16(y.x, y.y)) | ((unsigned long long)cvt_pk_bf16(y.z, y.w) << 32); } }
            else { f32x4* xr = (f32x4*)(io + (size_t)m * DM) + lane;
#pragma unroll
                for (int j = 0; j < 4; ++j) xr[64 * j] = cur[r][j] * rstd * gv[j]; }
        }
    }
}
template <int MODE> __device__ __forceinline__ void row_phase_b16(const bf16_t* src, bf16_t* dst, float* outf, const float* __restrict__ g, const float* __restrict__ mod, int shift_off, int scale_off) {
    const int lane = threadIdx.x & 63, gw = blockIdx.x * 8 + (threadIdx.x >> 6), NGW = gridDim.x * 8, rpw = MTOK / NGW, m_beg = gw * rpw, m_end = (gw == NGW - 1) ? MTOK : m_beg + rpw;
    for (int m0 = m_beg; m0 < m_end; m0 += 4) {
        u32x4 raw[4][2];
#pragma unroll
        for (int r = 0; r < 4; ++r) { const bf16_t* p = src + (size_t)min(m0 + r, MTOK - 1) * DM + 8 * lane; raw[r][0] = *(const u32x4*)p; raw[r][1] = *(const u32x4*)(p + 512); }
        const int b = m0 >> 11;
        f32x4 gv[4], sc[4], sh[4];
#pragma unroll
        for (int j = 0; j < 4; ++j) { const int c = (j >> 1) * 512 + 8 * lane + 4 * (j & 1); gv[j] = *(const f32x4*)(g + c);
            if (MODE == 0) { sc[j] = *(const f32x4*)(mod + b * 6144 + scale_off + c) + 1.f; sh[j] = *(const f32x4*)(mod + b * 6144 + shift_off + c); } }
        f32x4 cur[4][4]; float ss[4];
#pragma unroll
        for (int r = 0; r < 4; ++r) { ss[r] = 0.f;
#pragma unroll
            for (int j = 0; j < 4; ++j) { const unsigned w0 = raw[r][j >> 1][2 * (j & 1)], w1 = raw[r][j >> 1][2 * (j & 1) + 1];
                const f32x4 v = (f32x4){__builtin_bit_cast(float, w0 << 16), __builtin_bit_cast(float, w0 & 0xffff0000u), __builtin_bit_cast(float, w1 << 16), __builtin_bit_cast(float, w1 & 0xffff0000u)};
                cur[r][j] = v; ss[r] += (v.x * v.x + v.y * v.y) + (v.z * v.z + v.w * v.w); } }
#pragma unroll
        for (int o = 1; o < 64; o <<= 1) {
#pragma unroll
            for (int r = 0; r < 4; ++r) ss[r] += __shfl_xor(ss[r], o); }
#pragma unroll
        for (int r = 0; r < 4; ++r) {
            const int m = m0 + r; if (m >= m_end) break;
            const float rstd = 1.f / sqrtf(ss[r] * (1.f / DM) + EPS);
            if (MODE == 0) {
#pragma unroll
                for (int hf = 0; hf < 2; ++hf) { const f32x4 y0 = cur[r][2 * hf] * rstd * gv[2 * hf] * sc[2 * hf] + sh[2 * hf], y1 = cur[r][2 * hf + 1] * rstd * gv[2 * hf + 1] * sc[2 * hf + 1] + sh[2 * hf + 1];
                    u32x4 w; w.x = cvt_pk_bf16(y0.x, y0.y); w.y = cvt_pk_bf16(y0.z, y0.w); w.z = cvt_pk_bf16(y1.x, y1.y); w.w = cvt_pk_bf16(y1.z, y1.w);
                    *(u32x4*)(dst + (size_t)m * DM + hf * 512 + 8 * lane) = w; } }
            else {
#pragma unroll
                for (int j = 0; j < 4; ++j) *(f32x4*)(outf + (size_t)m * DM + (j >> 1) * 512 + 8 * lane + 4 * (j & 1)) = cur[r][j] * rstd * gv[j]; }
        }
    }
}
__device__ __forceinline__ void fixup_panel(int pm, const float* __restrict__ SB, bf16_t* ACT, const float* __restrict__ cw) {
    constexpr int NITEM = 8 * (DFF / 4);
#pragma unroll 1
    for (int e0 = threadIdx.x; e0 < NITEM; e0 += 4 * 512) {
        f32x4 gc[4], val[4], nbr[4], wv[4];
#pragma unroll
        for (int q = 0; q < 4; ++q) {
            const int e = min(e0 + q * 512, NITEM - 1), rr = e / (DFF / 4), c4 = (e % (DFF / 4)) * 4, chunk = 4 * pm + (rr >> 1), which = rr & 1;
            const float* sb = SB + ((size_t)(chunk * 2 + which) * 3) * DFF + c4;
            gc[q] = *(const f32x4*)sb; val[q] = *(const f32x4*)(sb + DFF);
            const bool has = which == 0 ? ((chunk & 31) != 0) : ((chunk & 31) != 31);
            const int nchunk = has ? (which == 0 ? chunk - 1 : chunk + 1) : chunk;
            nbr[q] = *(const f32x4*)(SB + ((size_t)(nchunk * 2 + (which ^ 1)) * 3 + 2) * DFF + c4);
            wv[q] = *(const f32x4*)(cw + (which == 0 ? 0 : 2 * DFF) + c4);
            if (!has) wv[q] = (f32x4){0.f, 0.f, 0.f, 0.f};
        }
#pragma unroll
        for (int q = 0; q < 4; ++q) {
            const int e = e0 + q * 512; if (e >= NITEM) break;
            const int rr = e / (DFF / 4), c4 = (e % (DFF / 4)) * 4, chunk = 4 * pm + (rr >> 1), which = rr & 1;
            const f32x4 g2 = gc[q] + wv[q] * nbr[q];
            float a[4];
#pragma unroll
            for (int j = 0; j < 4; ++j) a[j] = g2[j] * val[q][j] * __builtin_amdgcn_rcpf(1.f + __builtin_amdgcn_exp2f(-LOG2E * g2[j]));
            u32x2 w; w.x = cvt_pk_bf16(a[0], a[1]); w.y = cvt_pk_bf16(a[2], a[3]);
            *(u32x2*)(ACT + (size_t)(chunk * 64 + which * 63) * DFF + c4) = w;
        }
    }
}

struct Args { const float* in[17]; float* out; unsigned char* ws; int ph_lo, ph_hi; };
static_assert(sizeof(Args) == 17 * 8 + 8 + 8 + 8, "Args has no padding");

__global__ void __launch_bounds__(512, 2) fwd_megakernel(Args args) {
    extern __shared__ __attribute__((aligned(16))) unsigned char lds_raw[];
    LAS unsigned char* lds = (LAS unsigned char*)lds_raw;
    cg::grid_group grid = cg::this_grid();
    const int tid = threadIdx.x, wave = __builtin_amdgcn_readfirstlane(tid >> 6), lane = tid & 63, G = gridDim.x, bid = blockIdx.x;
    const float* x = args.in[0]; const float* cvec = args.in[1]; const float* w_ada = args.in[2]; const float* b_ada = args.in[3]; const float* g_attn = args.in[4];
    const float* w_in = args.in[5]; const float* rpb = args.in[6]; const float* sink = args.in[7]; const float* g_na = args.in[8]; const float* g_sw = args.in[9];
    const float* w_out = args.in[10]; const float* g_ffn = args.in[11]; const float* w_up = args.in[12]; const float* conv_w = args.in[13]; const float* conv_b = args.in[14];
    const float* w_down = args.in[15]; const float* g_final = args.in[16];
    unsigned char* ws = args.ws; float* out = args.out;
    float* mod = (float*)(ws + WS_MOD); float* costab = (float*)(ws + WS_COS); float* sintab = (float*)(ws + WS_SIN);
    bf16_t* Win = (bf16_t*)(ws + WS_WIN); bf16_t* Wout = (bf16_t*)(ws + WS_WOUT); bf16_t* Wup = (bf16_t*)(ws + WS_WUP); bf16_t* Wdn = (bf16_t*)(ws + WS_WDN);
    bf16_t* H = (bf16_t*)(ws + WS_H); bf16_t* PROJ = (bf16_t*)(ws + WS_PROJ); bf16_t* AO = (bf16_t*)(ws + WS_AO); bf16_t* ACT = (bf16_t*)(ws + WS_ACT); float* SB = (float*)(ws + WS_SB); bf16_t* X1B = (bf16_t*)(ws + WS_X1B);
    const int lo = args.ph_lo, hi = args.ph_hi;
    volatile LAS unsigned* barst = (volatile LAS unsigned*)(lds + LDS_BARST_OFF);
    if (tid < 2) barst[tid] = 0u;
    __syncthreads();
    XcdBarrier xbar = xcd_barrier_post((unsigned*)(ws + WS_BAR), barst);
#define IN(k) (lo <= (k) && (k) < hi)
#define SEAM(k) do { if (IN(k) && IN((k) + 1)) { if (args.ph_hi > 1000) grid.sync(); else xcd_barrier(xbar); } } while (0)

    if (IN(0)) {
        {
            const int gi = bid * 512 + tid;
            for (int e = gi; e < SEQ * 32; e += G * 512) { const int pos = e >> 5, f = e & 31;
                const float inv = powf(10000.f, -(float)f / 32.f); const float ang = (float)pos * inv;
                costab[e] = cosf(ang); sintab[e] = sinf(ang); }
        }
        if (bid < 192) {
            LAS float* sc = (LAS float*)lds; LAS float* red = (LAS float*)(lds + 65536);
#pragma unroll 8
            for (int i = tid; i < NB * DM; i += 512) { const float v = cvec[i]; sc[i] = v / (1.f + __expf(-v)); }
            __syncthreads();
            const int n0 = 32 * bid, col = lane & 31, par = lane >> 5;
            float acc[16];
#pragma unroll
            for (int b = 0; b < 16; ++b) acc[b] = 0.f;
            const float* wp = w_ada + n0 + col;
#pragma unroll 8
            for (int kk = 0; kk < 64; ++kk) { const int k = wave * 128 + kk * 2 + par; const float w = wp[(size_t)k * 6144];
#pragma unroll
                for (int b = 0; b < 16; ++b) acc[b] += sc[b * DM + k] * w; }
#pragma unroll
            for (int b = 0; b < 16; ++b) red[((wave * 2 + par) * 16 + b) * 32 + col] = acc[b];
            __syncthreads();
            { const int b = tid >> 5, cc = tid & 31; float s = b_ada[n0 + cc];
#pragma unroll
              for (int g = 0; g < 16; ++g) s += red[(g * 16 + b) * 32 + cc];
              mod[b * 6144 + n0 + cc] = s; }
            __syncthreads();
        }
        {
            LAS float* scr = (LAS float*)(lds + wave * 16384);
            constexpr int I_IN = (DM / 64) * (NIN / 32), I_OUT = (DM / 64) * (DM / 32), I_UP = (DM / 64) * (NUP / 32), I_DN = (DFF / 64) * (DM / 32);
            const bool late_up = (G == 256);
            const int nit = I_IN + I_OUT + I_DN + (late_up ? 0 : I_UP);
            int first, step, lim;
            if (late_up) { constexpr int NFREE = 4 * 512;
                if (bid >= 192) { first = (bid - 192) * 8 + wave; step = 512; lim = NFREE; } else { first = NFREE + bid * 8 + wave; step = 1536; lim = nit; } }
            else { first = bid * 8 + wave; step = G * 8; lim = nit; }
            for (int it = first; it < lim; it += step) {
                int r = it;
                if (r < I_IN) { transpose_item<1>(w_in, DM, NIN, Win, nullptr, scr, r, lane); continue; } r -= I_IN;
                if (r < I_OUT) { const int kb = r / (DM / 32); transpose_item<0>(w_out, DM, DM, Wout, (kb < 8) ? g_na : (g_sw - 512), scr, r, lane); continue; } r -= I_OUT;
                if (r < I_DN) { transpose_item<0>(w_down, DFF, DM, Wdn, nullptr, scr, r, lane); continue; } r -= I_DN;
                transpose_item<2>(w_up, DM, NUP, Wup, nullptr, scr, r, lane);
            }
        }
    }
    SEAM(0);
    if (IN(1)) row_phase<0>(x, H, nullptr, g_attn, mod, 0, 1024);
    SEAM(1);
    if (IN(2)) {
        Gemm g{H, Win, MTOK, NIN, DM}; StaticOrder S; S.init(MTOK, NIN, G, bid);
        EpiIn E{PROJ, costab, sintab};
        gemm_phase<EpiIn, StaticOrder, true, true>(lds, g, S, E);
        if (G == 256 && bid >= 128) {
            __syncthreads();
            LAS float* scr = (LAS float*)(lds + wave * 16384);
            for (int r = (bid - 128) * 8 + wave; r < (DM / 64) * (NUP / 32); r += 1024) transpose_item<2>(w_up, DM, NUP, Wup, nullptr, scr, r, lane);
        }
    }
    SEAM(2);
    if (IN(3)) attn_phase(lds, PROJ, AO, rpb, sink);
    SEAM(3);
    if (IN(4)) {
        Gemm g{AO, Wout, MTOK, DM, DM}; StaticOrder S; S.init(MTOK, DM, G, bid);
        EpiResB<false> E{x, X1B, mod + 2048};
        gemm_phase<EpiResB<false>, StaticOrder, true, true>(lds, g, S, E);
    }
    SEAM(4);
    if (IN(5)) row_phase_b16<0>(X1B, H, nullptr, g_ffn, mod, 3072, 4096);
    SEAM(5);
    if (IN(6)) {
        Gemm g{H, Wup, MTOK, NUP, DM}; StaticOrder S; S.init(MTOK, NUP, G, bid);
        EpiUp E{ACT, SB, conv_w, conv_b};
        gemm_phase<EpiUp, StaticOrder, true, true, true>(lds, g, S, E);
    }
    SEAM(6);
    if (IN(7)) {
        StaticOrder S; S.init(MTOK, DM, G, bid);
        { Unit u; for (int i = 0; S.next(i, u); ++i) fixup_panel(u.pm, SB, ACT, conv_w); }
        __threadfence(); __syncthreads();
        Gemm g{ACT, Wdn, MTOK, DM, DFF};
        EpiResB<true> E{X1B, X1B, mod + 5120};
        gemm_phase<EpiResB<true>, StaticOrder, true, true>(lds, g, S, E);
    }
    SEAM(7);
    if (IN(8)) row_phase_b16<1>(X1B, nullptr, out, g_final, nullptr, 0, 0);
#undef IN
#undef SEAM
}

#ifndef N_LAUNCH_SPLIT
#define N_LAUNCH_SPLIT 0
#endif
extern "C" void kernel_launch(void* const* d_in, const int* in_sizes, int n_in, void* d_out, int out_size, void* d_ws, size_t ws_size, hipStream_t stream) {
    static int grid_blocks = 0;
    if (grid_blocks == 0) {
        if (n_in != 17 || out_size != MTOK * DM || ws_size < WS_END) { fprintf(stderr, "kernel_launch: unexpected shapes (n_in %d out %d ws %zu)\n", n_in, out_size, ws_size); grid_blocks = -1; return; }
        int dev = 0, cus = 0, per_cu = 0;
        hipGetDevice(&dev); hipDeviceGetAttribute(&cus, hipDeviceAttributeMultiprocessorCount, dev);
        if (hipFuncSetAttribute((const void*)fwd_megakernel, hipFuncAttributeMaxDynamicSharedMemorySize, LDS_BYTES) != hipSuccess) { fprintf(stderr, "kernel_launch: hipFuncSetAttribute failed\n"); grid_blocks = -1; return; }
        if (hipOccupancyMaxActiveBlocksPerMultiprocessor(&per_cu, (const void*)fwd_megakernel, 512, LDS_BYTES) != hipSuccess || per_cu < 1) { fprintf(stderr, "kernel_launch: occupancy query failed (%d)\n", per_cu); per_cu = 1; (void)hipGetLastError(); }
        grid_blocks = cus * per_cu; if (grid_blocks > 256) grid_blocks = 256;
        fprintf(stderr, "kernel_launch: %d CUs x %d blocks -> grid %d\n", cus, per_cu, grid_blocks);
    }
    if (grid_blocks < 0) return;
    if (hipMemsetAsync((char*)d_ws + WS_BAR, 0, BAR_ZERO_BYTES, stream) != hipSuccess) { fprintf(stderr, "kernel_launch: memset failed\n"); return; }
    Args a{};
    for (int i = 0; i < 17; ++i) a.in[i] = (const float*)d_in[i];
    a.out = (float*)d_out; a.ws = (unsigned char*)d_ws;
#if N_LAUNCH_SPLIT
    for (int p = 0; p < 9; ++p) { a.ph_lo = p; a.ph_hi = p + 1; void* kargs[] = {&a};
        hipError_t e = hipLaunchCooperativeKernel((const void*)fwd_megakernel, dim3(grid_blocks), dim3(512), kargs, LDS_BYTES, stream);
        if (e != hipSuccess) { fprintf(stderr, "cooperative launch (phase %d) failed: %s\n", p, hipGetErrorString(e)); return; } }
#else
    a.ph_lo = 0; a.ph_hi = 9; void* kargs[] = {&a};
    hipError_t e = hipLaunchCooperativeKernel((const void*)fwd_megakernel, dim3(grid_blocks), dim3(512), kargs, LDS_BYTES, stream);
    if (e != hipSuccess) fprintf(stderr, "cooperative launch failed: %s (grid %d)\n", hipGetErrorString(e), grid_blocks);
#endif
}
```

```cpp
#include <hip/hip_runtime.h>
#include <hip/hip_cooperative_groups.h>
#include <cstdio>
#include <cstdint>
namespace cg = cooperative_groups;
namespace pg8 {
#define PG8_LAS __attribute__((address_space(3)))
typedef unsigned short bf16_t;
typedef short bf16x8 __attribute__((ext_vector_type(8)));
typedef float f32x4 __attribute__((ext_vector_type(4)));
typedef unsigned u32x4 __attribute__((ext_vector_type(4)));
constexpr int BM = 256, BK = 64, HALF = 128, HTB = HALF * BK * 2  , STAGE_BYTES = 8 * HTB, NXCD = 8, WGM = 8;

__host__ __device__ __forceinline__ int lds_byte(int r, int c) { const int st = (r >> 4) * 2 + (c >> 5), rr = r & 15, cc = c & 31, ob = rr * 64 + cc * 2; return st * 1024 + (ob ^ (((ob >> 9) & 1) << 5)); }
__host__ __device__ __forceinline__ void stage_rc(int b, int& R, int& C) { const int st = b / 1024, sb = b % 1024, swz = sb ^ (((sb >> 9) & 1) << 5); R = (st >> 1) * 16 + swz / 64; C = (st & 1) * 32 + (swz % 64) / 2; }
__host__ __device__ __forceinline__ int perm32(int rho) { const int n = rho >> 4, i = rho & 15; return 8 * (i >> 2) + 4 * n + (i & 3); }

struct Unit { int pm, pn; };
struct Gemm { const bf16_t* A; const bf16_t* Bt; int M, N, K; };

struct StaticOrder {
    int nM, nN, nwg, G, c;
    __host__ __device__ void init(int M, int N, int G_, int c_) { nM = M / BM; nN = N / BM; nwg = nM * nN; G = G_; c = c_; }
    __host__ __device__ bool next(int i, Unit& u) const {
        const long L = (long)i * G + c; if (L >= nwg) return false;
        int wgid = (int)L; { const int q = nwg / NXCD, r = nwg % NXCD, xcd = wgid % NXCD, off = wgid / NXCD; wgid = (xcd < r ? xcd * (q + 1) : r * (q + 1) + (xcd - r) * q) + off; }
        const int nig = WGM * nN, gid = wgid / nig, fm = gid * WGM, gsz = (nM - fm) < WGM ? (nM - fm) : WGM;
        u.pm = fm + ((wgid % nig) % gsz); u.pn = (wgid % nig) / gsz; return true;
    }
    __device__ __forceinline__ void a_ready(const Unit&) const {}
    __device__ __forceinline__ void done(const Unit&) const {}
};

__device__ __forceinline__ unsigned cvt_pk_bf16(float lo, float hi) { unsigned r; asm volatile("v_cvt_pk_bf16_f32 %0, %1, %2" : "=v"(r) : "v"(lo), "v"(hi)); return r; }
typedef float f32x2 __attribute__((ext_vector_type(2)));
template <class Epi, class Sched, bool ALIGN_EPI = false, bool SP2 = false, bool ROWPERM = false>
__device__ __forceinline__ void gemm_phase(PG8_LAS unsigned char* lds, const Gemm g, const Sched& S, const Epi& E) {
    const int tid = threadIdx.x, wid = __builtin_amdgcn_readfirstlane(tid >> 6), lane = tid & 63, wr = wid >> 2, wc = wid & 3, fr = lane & 15, fq = lane >> 4;
    const int K = g.K, nt = K / BK;
    unsigned voffA[2], voffB[2];
#pragma unroll
    for (int i = 0; i < 2; ++i) { int R, C; stage_rc(tid * 16 + i * 8192, R, C); const int Rb = Epi::PERM ? ((R & ~31) + perm32(R & 31)) : R;
        const int Ra = ROWPERM ? ((R & ~63) + 4 * (R & 15) + ((R >> 4) & 3)) : R;
        voffA[i] = (unsigned)(Ra * K + C) * 2u; voffB[i] = (unsigned)(Rb * K + C) * 2u; }
    const size_t kstep = (size_t)(BK * 2);
    const size_t hstep = (size_t)HALF * K * 2;
    const size_t tstep = 2 * hstep;
    const unsigned ldsw = (unsigned)wid * 1024u;
    const int aoff = lds_byte(wr * 64 + fr, fq * 8), boff = lds_byte(wc * 32 + fr, fq * 8);
#define PG8_SA(b, h) (((b) * 2 + (h)) * HTB)
#define PG8_SB(b, h) ((4 + (b) * 2 + (h)) * HTB)
#define PG8_STAGE(bufoff, gbase, voff) do { _Pragma("unroll") for (int _i = 0; _i < 2; ++_i) \
        __builtin_amdgcn_global_load_lds((const unsigned*)((const char*)(gbase) + (voff)[_i]), (PG8_LAS unsigned*)(lds + (bufoff) + ldsw + _i * 8192), 16, 0, 0); } while (0)
#define PG8_LDA(dst, b, h) do { _Pragma("unroll") for (int m = 0; m < 4; ++m) _Pragma("unroll") for (int k = 0; k < 2; ++k) dst[m][k] = *(const PG8_LAS bf16x8*)(lds + PG8_SA(b, h) + aoff + m * 2048 + k * 1024); } while (0)
#define PG8_LDB(dst, b, h) do { _Pragma("unroll") for (int n = 0; n < 2; ++n) _Pragma("unroll") for (int k = 0; k < 2; ++k) dst[n][k] = *(const PG8_LAS bf16x8*)(lds + PG8_SB(b, h) + boff + n * 2048 + k * 1024); } while (0)
#define PG8_MMA(ai, bj, At, Bt) do { __builtin_amdgcn_s_setprio(1); _Pragma("unroll") for (int m = 0; m < 4; ++m) _Pragma("unroll") for (int n = 0; n < 2; ++n) _Pragma("unroll") for (int k = 0; k < 2; ++k) \
        acc[ai][bj][m][n] = __builtin_amdgcn_mfma_f32_16x16x32_bf16(Bt[n][k], At[m][k], acc[ai][bj][m][n], 0, 0, 0); __builtin_amdgcn_s_setprio(0); } while (0)
#define PG8_WAIT_V(n) asm volatile("s_waitcnt vmcnt(" #n ")" ::: "memory")
#define PG8_WAIT_L(n) asm volatile("s_waitcnt lgkmcnt(" #n ")" ::: "memory")
#define PG8_BAR __builtin_amdgcn_s_barrier()
#define PG8_SCHED __builtin_amdgcn_sched_barrier(0)
    Unit cur, nxt; int ui = 0;
    if (!S.next(0, cur)) return;
    f32x4 acc[2][2][4][2];
#pragma unroll
    for (int a = 0; a < 2; ++a)
#pragma unroll
        for (int b = 0; b < 2; ++b)
#pragma unroll
            for (int m = 0; m < 4; ++m)
#pragma unroll
                for (int n = 0; n < 2; ++n) acc[a][b][m][n] = (f32x4){0.f, 0.f, 0.f, 0.f};
    bf16x8 At[4][2], B0[2][2], B1[2][2];
    const char* cA = (const char*)g.A + (size_t)cur.pm * tstep; const char* cB = (const char*)g.Bt + (size_t)cur.pn * tstep;
    S.a_ready(cur);
    if constexpr (SP2) {
        PG8_STAGE(PG8_SB(0, 0), cB, voffB); PG8_STAGE(PG8_SB(0, 1), cB + hstep, voffB); PG8_STAGE(PG8_SA(0, 0), cA, voffA); PG8_STAGE(PG8_SA(0, 1), cA + hstep, voffA);
        if (wr == 1) PG8_BAR;
        PG8_WAIT_V(2); PG8_BAR;
        PG8_STAGE(PG8_SB(1, 0), cB + kstep, voffB); PG8_STAGE(PG8_SA(1, 0), cA + kstep, voffA); PG8_STAGE(PG8_SB(1, 1), cB + hstep + kstep, voffB);
        PG8_WAIT_V(6); PG8_BAR;
    } else {
        PG8_STAGE(PG8_SB(0, 0), cB, voffB); PG8_STAGE(PG8_SA(0, 0), cA, voffA); PG8_STAGE(PG8_SB(0, 1), cB + hstep, voffB); PG8_STAGE(PG8_SA(0, 1), cA + hstep, voffA);
        if (wr == 1) PG8_BAR;
        PG8_WAIT_V(4); PG8_BAR;
        PG8_STAGE(PG8_SB(1, 0), cB + kstep, voffB); PG8_STAGE(PG8_SA(1, 0), cA + kstep, voffA); PG8_STAGE(PG8_SB(1, 1), cB + hstep + kstep, voffB);
        PG8_WAIT_V(6); PG8_BAR;
    }
    for (;;) {
        const bool has_next = S.next(ui + 1, nxt);
        const char* nA = has_next ? (const char*)g.A + (size_t)nxt.pm * tstep : cA; const char* nB = has_next ? (const char*)g.Bt + (size_t)nxt.pn * tstep : cB;
        for (int t = 0; t < nt; t += 2) {
            const bool last = (t == nt - 2);
            const char* a1 = cA + (size_t)(t + 1) * kstep;
            const char* a2 = last ? nA : cA + (size_t)(t + 2) * kstep; const char* b2 = last ? nB : cB + (size_t)(t + 2) * kstep;
            const char* a3 = a2 + kstep; const char* b3 = b2 + kstep;
            if (last && has_next) S.a_ready(nxt);
            if constexpr (SP2) {
            PG8_LDB(B0, 0, 0); PG8_LDB(B1, 0, 1); PG8_SCHED; PG8_LDA(At, 0, 0); PG8_STAGE(PG8_SA(1, 1), a1 + hstep, voffA);
            PG8_WAIT_V(8); PG8_WAIT_L(0); PG8_BAR; PG8_MMA(0, 0, At, B0); PG8_MMA(0, 1, At, B1); PG8_BAR; PG8_SCHED;
            PG8_LDA(At, 0, 1); PG8_STAGE(PG8_SB(0, 0), b2, voffB); PG8_STAGE(PG8_SB(0, 1), b2 + hstep, voffB); PG8_STAGE(PG8_SA(0, 0), a2, voffA);
            PG8_WAIT_V(8); PG8_WAIT_L(0); PG8_BAR; PG8_MMA(1, 0, At, B0); PG8_MMA(1, 1, At, B1); PG8_BAR; PG8_SCHED;
            PG8_LDB(B0, 1, 0); PG8_LDB(B1, 1, 1); PG8_SCHED; PG8_LDA(At, 1, 0); PG8_STAGE(PG8_SA(0, 1), a2 + hstep, voffA);
            PG8_WAIT_V(8); PG8_WAIT_L(0); PG8_BAR; PG8_MMA(0, 0, At, B0); PG8_MMA(0, 1, At, B1); PG8_BAR; PG8_SCHED;
            PG8_LDA(At, 1, 1); PG8_STAGE(PG8_SB(1, 0), b3, voffB); PG8_STAGE(PG8_SB(1, 1), b3 + hstep, voffB); PG8_STAGE(PG8_SA(1, 0), a3, voffA);
            PG8_WAIT_V(8); PG8_WAIT_L(0); PG8_BAR; PG8_MMA(1, 0, At, B0); PG8_MMA(1, 1, At, B1); PG8_BAR; PG8_SCHED;
            } else {
            PG8_LDB(B0, 0, 0); PG8_SCHED; PG8_LDA(At, 0, 0); PG8_STAGE(PG8_SA(1, 1), a1 + hstep, voffA);
            PG8_WAIT_L(8); PG8_BAR; PG8_WAIT_L(0); PG8_MMA(0, 0, At, B0); PG8_BAR; PG8_SCHED;
            PG8_LDB(B1, 0, 1); PG8_STAGE(PG8_SB(0, 0), b2, voffB);
            PG8_BAR; PG8_WAIT_L(0); PG8_MMA(0, 1, At, B1); PG8_BAR;
            PG8_LDA(At, 0, 1); PG8_STAGE(PG8_SA(0, 0), a2, voffA);
            PG8_BAR; PG8_WAIT_L(0); PG8_MMA(1, 0, At, B0); PG8_BAR; PG8_SCHED;
            PG8_STAGE(PG8_SB(0, 1), b2 + hstep, voffB);
            PG8_WAIT_V(6); PG8_BAR; PG8_MMA(1, 1, At, B1); PG8_BAR;
            PG8_LDB(B0, 1, 0); PG8_SCHED; PG8_LDA(At, 1, 0); PG8_STAGE(PG8_SA(0, 1), a2 + hstep, voffA);
            PG8_WAIT_L(8); PG8_BAR; PG8_WAIT_L(0); PG8_MMA(0, 0, At, B0); PG8_BAR; PG8_SCHED;
            PG8_LDB(B1, 1, 1); PG8_STAGE(PG8_SB(1, 0), b3, voffB);
            PG8_BAR; PG8_WAIT_L(0); PG8_MMA(0, 1, At, B1); PG8_BAR;
            PG8_LDA(At, 1, 1); PG8_STAGE(PG8_SA(1, 0), a3, voffA);
            PG8_BAR; PG8_WAIT_L(0); PG8_MMA(1, 0, At, B0); PG8_BAR; PG8_SCHED;
            PG8_STAGE(PG8_SB(1, 1), b3 + hstep, voffB);
            PG8_WAIT_V(6); PG8_BAR; PG8_MMA(1, 1, At, B1); PG8_BAR;
            }
        }
        if constexpr (ALIGN_EPI) { if (wr == 0) PG8_BAR; }
        if constexpr (!Epi::AFTER_DRAIN) { E(acc, cur, wr, wc, fr, fq); S.done(cur); }
        if (!has_next) break;
#pragma unroll
        for (int a = 0; a < 2; ++a)
#pragma unroll
            for (int b = 0; b < 2; ++b)
#pragma unroll
                for (int m = 0; m < 4; ++m)
#pragma unroll
                    for (int n = 0; n < 2; ++n) acc[a][b][m][n] = (f32x4){0.f, 0.f, 0.f, 0.f};
        cur = nxt; cA = nA; cB = nB; ++ui;
        if constexpr (ALIGN_EPI) { if (wr == 1) PG8_BAR; }
    }
    PG8_WAIT_V(0);
    if constexpr (!ALIGN_EPI) { if (wr == 0) PG8_BAR; }
    PG8_BAR;
    if constexpr (Epi::AFTER_DRAIN) { E.fused(acc, cur, wr, wc, fr, fq, lds, wid, lane); S.done(cur); }
#undef PG8_SA
#undef PG8_SB
#undef PG8_STAGE
#undef PG8_LDA
#undef PG8_LDB
#undef PG8_MMA
#undef PG8_WAIT_V
#undef PG8_WAIT_L
#undef PG8_BAR
#undef PG8_SCHED
}
constexpr float LOG2E = 1.4426950408889634f;
constexpr float C2 = 0.125f * LOG2E;
struct EpiIn {
    static constexpr bool PERM = true, AFTER_DRAIN = false;
    bf16_t* O; const float* costab; const float* sintab;
    __device__ __forceinline__ void operator()(const f32x4 (&acc)[2][2][4][2], const Unit& u, int wr, int wc, int fr, int fq) const {
        const int pn = u.pn, row0 = u.pm * BM + wr * 64 + fr, col0 = pn * BM + wc * 32 + 8 * fq;
        const bool rope0 = (pn >= 6), rope1 = (pn == 6 || pn == 7);
        const float sc = (pn < 2 || pn == 6 || pn == 7) ? C2 : 1.f;
        const int G4 = 4 * ((wc & 1) * 4 + fq);
#pragma unroll
        for (int ai = 0; ai < 2; ++ai)
#pragma unroll
            for (int m = 0; m < 4; ++m) {
                const int row = row0 + ai * HALF + m * 16, pos = row & 2047;
                f32x4 cs = (f32x4){1.f, 1.f, 1.f, 1.f}, sn = (f32x4){0.f, 0.f, 0.f, 0.f};
                if (rope0) { cs = *(const f32x4*)(costab + pos * 32 + G4); sn = *(const f32x4*)(sintab + pos * 32 + G4); }
                bf16_t* rowp = O + (size_t)row * 2304 + col0;
#pragma unroll
                for (int bj = 0; bj < 2; ++bj) {
                    f32x4 v0 = acc[ai][bj][m][0], v1 = acc[ai][bj][m][1];
                    if (bj == 0 ? rope0 : rope1) { const f32x4 o0 = v0 * cs - v1 * sn, o1 = v1 * cs + v0 * sn; v0 = o0; v1 = o1; }
                    v0 = v0 * sc; v1 = v1 * sc;
                    u32x4 w; w.x = cvt_pk_bf16(v0[0], v0[1]); w.y = cvt_pk_bf16(v0[2], v0[3]); w.z = cvt_pk_bf16(v1[0], v1[1]); w.w = cvt_pk_bf16(v1[2], v1[3]);
                    *(u32x4*)(rowp + bj * HALF) = w;
                }
            }
    }
};
struct EpiRes {
    static constexpr bool PERM = false, AFTER_DRAIN = false;
    const float* base; float* out; const float* gate;
    __device__ __forceinline__ void operator()(const f32x4 (&acc)[2][2][4][2], const Unit& u, int wr, int wc, int fr, int fq) const {
        const int col0 = u.pn * BM + wc * 32 + 4 * fq, b = u.pm >> 3;
        f32x4 gv[2][2];
#pragma unroll
        for (int bj = 0; bj < 2; ++bj)
#pragma unroll
            for (int n = 0; n < 2; ++n) gv[bj][n] = *(const f32x4*)(gate + b * 6144 + col0 + bj * HALF + n * 16);
#pragma unroll
        for (int ai = 0; ai < 2; ++ai)
#pragma unroll
            for (int mp = 0; mp < 2; ++mp) {
                f32x4 bs[2][2][2];
#pragma unroll
                for (int mm = 0; mm < 2; ++mm) { const size_t off = (size_t)(u.pm * BM + ai * HALF + wr * 64 + (2 * mp + mm) * 16 + fr) * 1024 + col0;
#pragma unroll
                    for (int bj = 0; bj < 2; ++bj)
#pragma unroll
                        for (int n = 0; n < 2; ++n) bs[mm][bj][n] = *(const f32x4*)(base + off + bj * HALF + n * 16); }
                asm volatile("" ::: "memory");
#pragma unroll
                for (int mm = 0; mm < 2; ++mm) { const size_t off = (size_t)(u.pm * BM + ai * HALF + wr * 64 + (2 * mp + mm) * 16 + fr) * 1024 + col0;
#pragma unroll
                    for (int bj = 0; bj < 2; ++bj)
#pragma unroll
                        for (int n = 0; n < 2; ++n) *(f32x4*)(out + off + bj * HALF + n * 16) = bs[mm][bj][n] + gv[bj][n] * acc[ai][bj][2 * mp + mm][n]; }
                asm volatile("" ::: "memory");
            }
    }
};
template <bool BASE_B16> struct EpiResB {
    static constexpr bool PERM = false, AFTER_DRAIN = false;
    const void* base; bf16_t* outb; const float* gate;
    __device__ __forceinline__ void operator()(const f32x4 (&acc)[2][2][4][2], const Unit& u, int wr, int wc, int fr, int fq) const {
        typedef unsigned u32x2v __attribute__((ext_vector_type(2)));
        const int col0 = u.pn * BM + wc * 32 + 4 * fq, b = u.pm >> 3;
        f32x4 gv[2][2];
#pragma unroll
        for (int bj = 0; bj < 2; ++bj)
#pragma unroll
            for (int n = 0; n < 2; ++n) gv[bj][n] = *(const f32x4*)(gate + b * 6144 + col0 + bj * HALF + n * 16);
#pragma unroll
        for (int ai = 0; ai < 2; ++ai)
#pragma unroll
            for (int mp = 0; mp < 2; ++mp) {
                f32x4 bs[2][2][2];
#pragma unroll
                for (int mm = 0; mm < 2; ++mm) { const size_t off = (size_t)(u.pm * BM + ai * HALF + wr * 64 + (2 * mp + mm) * 16 + fr) * 1024 + col0;
#pragma unroll
                    for (int bj = 0; bj < 2; ++bj)
#pragma unroll
                        for (int n = 0; n < 2; ++n) {
                            if (BASE_B16) { const u32x2v w = *(const u32x2v*)((const bf16_t*)base + off + bj * HALF + n * 16);
                                bs[mm][bj][n] = (f32x4){__builtin_bit_cast(float, w.x << 16), __builtin_bit_cast(float, w.x & 0xffff0000u), __builtin_bit_cast(float, w.y << 16), __builtin_bit_cast(float, w.y & 0xffff0000u)}; }
                            else bs[mm][bj][n] = *(const f32x4*)((const float*)base + off + bj * HALF + n * 16); } }
                asm volatile("" ::: "memory");
#pragma unroll
                for (int mm = 0; mm < 2; ++mm) { const size_t off = (size_t)(u.pm * BM + ai * HALF + wr * 64 + (2 * mp + mm) * 16 + fr) * 1024 + col0;
#pragma unroll
                    for (int bj = 0; bj < 2; ++bj)
#pragma unroll
                        for (int n = 0; n < 2; ++n) { const f32x4 v = bs[mm][bj][n] + gv[bj][n] * acc[ai][bj][2 * mp + mm][n];
                            u32x2v w; w.x = cvt_pk_bf16(v[0], v[1]); w.y = cvt_pk_bf16(v[2], v[3]); *(u32x2v*)(outb + off + bj * HALF + n * 16) = w; } }
                asm volatile("" ::: "memory");
            }
    }
};
__device__ __forceinline__ float dpp_ror1(float v) { return __builtin_bit_cast(float, __builtin_amdgcn_update_dpp(0, __builtin_bit_cast(int, v), 0x121, 0xf, 0xf, false)); }
__device__ __forceinline__ float dpp_shr1z(float v) { return __builtin_bit_cast(float, __builtin_amdgcn_update_dpp(0, __builtin_bit_cast(int, v), 0x111, 0xf, 0xf, true)); }
__device__ __forceinline__ float dpp_shl1z(float v) { return __builtin_bit_cast(float, __builtin_amdgcn_update_dpp(0, __builtin_bit_cast(int, v), 0x101, 0xf, 0xf, true)); }
__device__ __forceinline__ float dpp_rol1(float v) { return __builtin_bit_cast(float, __builtin_amdgcn_update_dpp(0, __builtin_bit_cast(int, v), 0x12f, 0xf, 0xf, false)); }
struct EpiUp {
    static constexpr bool PERM = true, AFTER_DRAIN = false;
    bf16_t* ACT; float* SB; const float* cw; const float* cb;
    __device__ __forceinline__ void operator()(const f32x4 (&acc)[2][2][4][2], const Unit& u, int wr, int wc, int fr, int fq) const {
        const int ff0 = u.pn * 128 + wc * 32 + 8 * fq;
        f32x4 w0a[2], w1a[2], w2a[2], bba[2];
#pragma unroll
        for (int n = 0; n < 2; ++n) { w0a[n] = *(const f32x4*)(cw + ff0 + 4 * n); w1a[n] = *(const f32x4*)(cw + 2816 + ff0 + 4 * n); w2a[n] = *(const f32x4*)(cw + 5632 + ff0 + 4 * n); bba[n] = *(const f32x4*)(cb + ff0 + 4 * n); }
#pragma unroll
        for (int ai = 0; ai < 2; ++ai) {
            const int chunk = 4 * u.pm + 2 * ai + wr, row0 = chunk * 64;
            unsigned pk[4][4];
            float bG[8], bV[8], bC[8];
#pragma unroll
            for (int n = 0; n < 2; ++n) {
                const f32x4 w0 = w0a[n], w1 = w1a[n], w2 = w2a[n], bb = bba[n];
#pragma unroll
                for (int jp = 0; jp < 2; ++jp) {
                    float av[4][2];
#pragma unroll
                    for (int jj = 0; jj < 2; ++jj) {
                        const int j = 2 * jp + jj;
                        const float pm0 = dpp_shr1z(acc[ai][1][3][n][j]), nm3 = dpp_shl1z(acc[ai][1][0][n][j]);
#pragma unroll
                        for (int m = 0; m < 4; ++m) {
                            const float cur = acc[ai][1][m][n][j], val = acc[ai][0][m][n][j];
                            const float pv = (m > 0) ? acc[ai][1][m > 0 ? m - 1 : 0][n][j] : pm0, nx = (m < 3) ? acc[ai][1][m < 3 ? m + 1 : 3][n][j] : nm3;
                            const float gc = w0[j] * pv + w1[j] * cur + w2[j] * nx + bb[j];
                            av[m][jj] = gc * val * __builtin_amdgcn_rcpf(1.f + __builtin_amdgcn_exp2f(-LOG2E * gc));
                            if (m == 0) { bG[4 * n + j] = gc; bV[4 * n + j] = val; bC[4 * n + j] = cur; }
                            if (m == 3) { const bool l = (fr == 15); bG[4 * n + j] = l ? gc : bG[4 * n + j]; bV[4 * n + j] = l ? val : bV[4 * n + j]; bC[4 * n + j] = l ? cur : bC[4 * n + j]; }
                        }
                    }
#pragma unroll
                    for (int m = 0; m < 4; ++m) pk[m][2 * n + jp] = cvt_pk_bf16(av[m][0], av[m][1]);
                }
            }
#pragma unroll
            for (int m = 0; m < 4; ++m) { u32x4 w; w.x = pk[m][0]; w.y = pk[m][1]; w.z = pk[m][2]; w.w = pk[m][3]; *(u32x4*)(ACT + (size_t)(row0 + 4 * fr + m) * 2816 + ff0) = w; }
            if (fr == 0 || fr == 15) {
                float* sb = SB + ((size_t)(chunk * 2 + (fr == 15 ? 1 : 0)) * 3) * 2816 + ff0;
#pragma unroll
                for (int n = 0; n < 2; ++n) { *(f32x4*)(sb + 4 * n) = (f32x4){bG[4 * n], bG[4 * n + 1], bG[4 * n + 2], bG[4 * n + 3]}; *(f32x4*)(sb + 2816 + 4 * n) = (f32x4){bV[4 * n], bV[4 * n + 1], bV[4 * n + 2], bV[4 * n + 3]};
                    *(f32x4*)(sb + 5632 + 4 * n) = (f32x4){bC[4 * n], bC[4 * n + 1], bC[4 * n + 2], bC[4 * n + 3]}; }
            }
        }
    }
};
}
using namespace pg8;
#define LAS PG8_LAS
typedef float f32x16 __attribute__((ext_vector_type(16)));
typedef short s16x4 __attribute__((ext_vector_type(4)));
typedef short v4i16_t __attribute__((ext_vector_type(4)));
typedef unsigned u32x2 __attribute__((ext_vector_type(2)));

constexpr int NB = 16, SEQ = 2048, DM = 1024, MTOK = NB * SEQ, NIN = 2304, DFF = 2816, NUP = 5632;
constexpr float EPS = 1e-6f;
constexpr size_t MiB = 1u << 20;
constexpr size_t WS_BAR = 0, BAR_ZERO_BYTES = 16384;
constexpr size_t WS_MOD = 1 * MiB, WS_COS = 2 * MiB, WS_SIN = 2 * MiB + 512 * 1024, WS_WIN = 4 * MiB, WS_WOUT = 10 * MiB, WS_WUP = 12 * MiB, WS_WDN = 24 * MiB;
constexpr size_t WS_H = 32 * MiB, WS_PROJ = 96 * MiB, WS_AO = 240 * MiB, WS_ACT = 96 * MiB  , WS_SB = 304 * MiB, WS_X1B = 346 * MiB, WS_END = 410 * MiB;
static_assert(WS_ACT + (size_t)MTOK * DFF * 2 <= WS_SB && WS_SB + (size_t)512 * 2 * 3 * DFF * 4 <= WS_END, "ws map");
constexpr int LDS_BYTES = 147456, LDS_BARST_OFF = 131072;
constexpr int ATT_BIAS_OFF = 0, ATT_BSTR = 640, ATT_V_OFF = 20480, ATT_VROW = 192, ATT_VBUF = 32 * ATT_VROW, ATT_RED_OFF = ATT_V_OFF + 8 * 2 * ATT_VBUF;
static_assert(ATT_RED_OFF + 2 * 8 * 64 * 4 <= LDS_BYTES, "attention LDS");

__device__ __forceinline__ float wave_sum(float v) {
#pragma unroll
    for (int o = 1; o < 64; o <<= 1) v += __shfl_xor(v, o);
    return v;
}
__device__ __forceinline__ s16x4 vtr(unsigned a) { return __builtin_bit_cast(s16x4, __builtin_amdgcn_ds_read_tr16_b64_v4i16((LAS v4i16_t*)(a))); }
__device__ __forceinline__ f32x16 mfma32(bf16x8 a, bf16x8 b, f32x16 c) { return __builtin_amdgcn_mfma_f32_32x32x16_bf16(a, b, c, 0, 0, 0); }
__device__ __forceinline__ bf16x8 pack8(float a0, float a1, float a2, float a3, float a4, float a5, float a6, float a7) {
    u32x4 w; w.x = cvt_pk_bf16(a0, a1); w.y = cvt_pk_bf16(a2, a3); w.z = cvt_pk_bf16(a4, a5); w.w = cvt_pk_bf16(a6, a7); return __builtin_bit_cast(bf16x8, w);
}
struct NaXf {
    const LAS float* bt; int kc0;
    template <int QUAD> __device__ __forceinline__ void apply(f32x16& s) const {
#pragma unroll
        for (int i = 0; i < 16; ++i) { const int a = i >> 2, b = i & 3, ap = QUAD ? 0 : a, ra = QUAD ? a : 0;
            const float bias = bt[ra * 31 + 8 * ap + b]; const bool ok = (unsigned)(kc0 + 8 * ap + b) < 16u; s[i] = ok ? s[i] + bias : -1e30f; }
    }
};
struct SwXf {
    int mode, ql, h, dq;
    __device__ __forceinline__ void apply(f32x16& s) const {
        {
#pragma unroll
            for (int i = 0; i < 16; ++i) { const int kb = 8 * (i >> 2) + 4 * h + (i & 3); const int d = dq + kb - ql; const bool ok = (d >= -128) && (d <= 128); s[i] = ok ? s[i] : -1e30f; }
        }
    }
};
struct AttnSt { f32x16 o0, o1; float m, l; };
__device__ __forceinline__ void attn_softmax_pv(f32x16& s, AttnSt& st, unsigned vaddr) {
    float mx = s[0];
#pragma unroll
    for (int i = 1; i < 16; ++i) mx = fmaxf(mx, s[i]);
    mx = fmaxf(mx, __shfl_xor(mx, 32));
    const float mn = fmaxf(st.m, mx), al = __builtin_amdgcn_exp2f(st.m - mn); st.m = mn;
    float ps = 0.f;
#pragma unroll
    for (int i = 0; i < 16; ++i) { s[i] = __builtin_amdgcn_exp2f(s[i] - mn); ps += s[i]; }
    st.l = st.l * al + ps; st.o0 = st.o0 * al; st.o1 = st.o1 * al;
    const bf16x8 p0 = pack8(s[0], s[1], s[2], s[3], s[4], s[5], s[6], s[7]), p1 = pack8(s[8], s[9], s[10], s[11], s[12], s[13], s[14], s[15]);
    bf16x8 a[2][2];
#pragma unroll
    for (int db = 0; db < 2; ++db)
#pragma unroll
        for (int ks = 0; ks < 2; ++ks) { const s16x4 lo = vtr(vaddr + ks * 16 * ATT_VROW + db * 64), hi = vtr(vaddr + ks * 16 * ATT_VROW + 8 * ATT_VROW + db * 64);
            a[db][ks] = (bf16x8){lo[0], lo[1], lo[2], lo[3], hi[0], hi[1], hi[2], hi[3]}; }
    st.o0 = mfma32(a[0][0], p0, st.o0); st.o0 = mfma32(a[0][1], p1, st.o0);
    st.o1 = mfma32(a[1][0], p0, st.o1); st.o1 = mfma32(a[1][1], p1, st.o1);
}
struct BlkDesc { int base, hs; };
__device__ __forceinline__ void load_k(bf16x8 (&kf)[4], const bf16_t* proj, int koff, const BlkDesc& d, int ql, int h) {
    const bf16_t* p = proj + (size_t)(d.base + (d.hs ? (ql & 7) + (ql >> 3) * 64 : ql)) * NIN + koff + 32 * h;
#pragma unroll
    for (int kk = 0; kk < 4; ++kk) kf[kk] = *(const bf16x8*)(p + 8 * kk);
}
__device__ __forceinline__ void load_v(u32x4 (&vf)[4], const bf16_t* proj, int voff, const BlkDesc& d, int lane) {
#pragma unroll
    for (int i = 0; i < 4; ++i) { const int x = 8 * i + (lane >> 3); vf[i] = *(const u32x4*)(proj + (size_t)(d.base + (d.hs ? (x & 7) + (x >> 3) * 64 : x)) * NIN + voff + 8 * (lane & 7)); }
}
__device__ __forceinline__ void store_v(LAS unsigned char* vb, const u32x4 (&vf)[4], int lane) {
#pragma unroll
    for (int i = 0; i < 4; ++i) *(LAS u32x4*)(vb + (8 * i + (lane >> 3)) * ATT_VROW + 16 * (lane & 7)) = vf[i];
}

struct UnitId { int valid, swp, b, sub; };
__device__ __forceinline__ UnitId unit_id(int it, int G, int bid) {
    UnitId d; const int u = it * G + bid; d.valid = (u < 1536) ? 1 : 0; const int q3 = u / 3, r3 = u - 3 * q3;
    d.swp = (r3 == 2) ? 1 : 0;
    if (d.swp) { d.b = q3 >> 5; d.sub = q3 & 31; } else { const int idx = q3 * 2 + r3; d.b = idx >> 6; d.sub = idx & 63; }
    return d;
}
struct UnitPre { int valid, tokq, qoff, koff, voff; BlkDesc d0; };
__device__ __forceinline__ UnitPre unit_pre(int it, int G, int bid, int wave, int ql) {
    UnitPre p; const UnitId d = unit_id(it, G, bid); p.valid = d.valid;
    if (!d.swp) { const int r = d.sub >> 1, jp = d.sub & 1, rs = min(max(r - 4, 0), 24);
        p.tokq = d.b * SEQ + r * 64 + 32 * jp + ql; p.qoff = wave * 64; p.koff = 512 + wave * 64; p.voff = 1024 + wave * 64; p.d0.base = d.b * SEQ + rs * 64 + 32 * jp; p.d0.hs = 0; }
    else { const int q0 = 64 * d.sub, kvh = wave >> 2, tlo = max(0, (128 - q0) / 32);
        p.tokq = d.b * SEQ + q0 + ql; p.qoff = 1536 + wave * 64; p.koff = 2048 + kvh * 64; p.voff = 2176 + kvh * 64; p.d0.base = d.b * SEQ + q0 - 128 + 32 * tlo; p.d0.hs = 0; }
    return p;
}
__device__ __forceinline__ f32x16 qk_scores(const bf16x8 (&kf)[4], const bf16x8 (&qf)[4]) {
    f32x16 s;
#pragma unroll
    for (int e = 0; e < 16; ++e) s[e] = 0.f;
#pragma unroll
    for (int kk = 0; kk < 4; ++kk) s = mfma32(kf[kk], qf[kk], s);
    return s;
}
__device__ __forceinline__ float attn_norm_l(AttnSt& st) {
    const float lt = st.l + __shfl_xor(st.l, 32), inv = 1.f / lt;
    float ss = 0.f;
#pragma unroll
    for (int i = 0; i < 16; ++i) { st.o0[i] *= inv; st.o1[i] *= inv; ss += st.o0[i] * st.o0[i] + st.o1[i] * st.o1[i]; }
    return ss + __shfl_xor(ss, 32);
}
__device__ __forceinline__ void attn_store(const AttnSt& st, float rn, bf16_t* op) {
#pragma unroll
    for (int a = 0; a < 4; ++a) {
        u32x2 w0, w1;
        w0.x = cvt_pk_bf16(st.o0[4 * a] * rn, st.o0[4 * a + 1] * rn); w0.y = cvt_pk_bf16(st.o0[4 * a + 2] * rn, st.o0[4 * a + 3] * rn);
        w1.x = cvt_pk_bf16(st.o1[4 * a] * rn, st.o1[4 * a + 1] * rn); w1.y = cvt_pk_bf16(st.o1[4 * a + 2] * rn, st.o1[4 * a + 3] * rn);
        *(u32x2*)(op + 8 * a) = w0; *(u32x2*)(op + 32 + 8 * a) = w1;
    }
}
__device__ __forceinline__ void attn_phase(LAS unsigned char* lds, const bf16_t* __restrict__ proj, bf16_t* __restrict__ ao, const float* __restrict__ rpb, const float* __restrict__ sink) {
    const int tid = threadIdx.x, wave = __builtin_amdgcn_readfirstlane(tid >> 6), lane = tid & 63, ql = lane & 31, h = lane >> 5;
    const int G = gridDim.x, bid = blockIdx.x;
    LAS float* btab = (LAS float*)(lds + ATT_BIAS_OFF);
    LAS unsigned char* vbuf = lds + ATT_V_OFF + wave * 2 * ATT_VBUF;
    LAS float* red = (LAS float*)(lds + ATT_RED_OFF);
    bf16x8 qf[4], kf[4], kn[4]; u32x4 vf[4];
    { const UnitPre p = unit_pre(0, G, bid, wave, ql);
      if (p.valid) {
#pragma unroll
          for (int kk = 0; kk < 4; ++kk) qf[kk] = *(const bf16x8*)(proj + (size_t)p.tokq * NIN + p.qoff + 32 * h + 8 * kk);
          load_k(kf, proj, p.koff, p.d0, ql, h); load_v(vf, proj, p.voff, p.d0, lane); } }
#pragma unroll
    for (int i0 = 0; i0 < 8 * ATT_BSTR; i0 += 512) { const int i = i0 + tid, hh = i / ATT_BSTR, j = i % ATT_BSTR - 64; const bool okb = (j >= 0 && j < 465); const float v = rpb[okb ? hh * 465 + j : 0]; btab[i] = okb ? v * LOG2E : 0.f; }
    __syncthreads();
    const int g4 = lane >> 4, i16 = lane & 15;
    const unsigned trb = (unsigned)((4 * (g4 >> 1) + (i16 >> 2)) * ATT_VROW + (16 * (g4 & 1) + 4 * (i16 & 3)) * 2);
    const unsigned vb0 = (unsigned)(size_t)vbuf;
    for (int it = 0;; ++it) {
        const UnitId ud = unit_id(it, G, bid); if (!ud.valid) break;
        const int b = ud.b, sub = ud.sub;
        AttnSt st, stB;
#pragma unroll
        for (int i = 0; i < 16; ++i) { st.o0[i] = 0.f; st.o1[i] = 0.f; stB.o0[i] = 0.f; stB.o1[i] = 0.f; }
        stB.m = 0.f; stB.l = 1.f;
        int tokq, goff;
        store_v(vbuf, vf, lane);
        if (!ud.swp) {
            const int r = sub >> 1, jp = sub & 1, rs = min(max(r - 4, 0), 24), qcol = 32 * jp + ql, cs = min(max(qcol - 8, 0), 48), cq0 = jp ? 24 : 32;
            tokq = b * SEQ + r * 64 + qcol; goff = 0;
            const int koff = 512 + wave * 64, voff = 1024 + wave * 64;
            st.m = -1e30f; st.l = 0.f;
            const LAS float* bt0 = btab + wave * ATT_BSTR + 64;
            auto desc = [&](int i) { BlkDesc d; if (i < 8) { d.base = b * SEQ + (rs + i) * 64 + 32 * jp; d.hs = 0; } else { d.base = b * SEQ + (rs + 4 * (i - 8)) * 64 + cq0; d.hs = 1; } return d; };
            for (int i = 0; i < 10; ++i) {
                if (i + 1 < 10) { const BlkDesc d = desc(i + 1); load_k(kn, proj, koff, d, ql, h); load_v(vf, proj, voff, d, lane); }
                f32x16 s = qk_scores(kf, qf);
                if (i < 8) { const int R = rs + i, c0 = 32 * jp; NaXf xf{bt0 + (R - r + 7) * 31 + (c0 + 4 * h - qcol + 15), c0 + 4 * h - cs}; xf.apply<0>(s); }
                else { const int R = rs + 4 * (i - 8); NaXf xf{bt0 + (R - r + 7) * 31 + (cq0 + 4 * h - qcol + 15), cq0 + 4 * h - cs}; xf.apply<1>(s); }
                attn_softmax_pv(s, st, vb0 + (unsigned)((i & 1) * ATT_VBUF) + trb);
                if (i + 1 < 10) { store_v(vbuf + ((i + 1) & 1) * ATT_VBUF, vf, lane);
#pragma unroll
                    for (int kk = 0; kk < 4; ++kk) kf[kk] = kn[kk]; }
            }
        } else {
            const int q0 = 64 * sub; tokq = b * SEQ + q0 + ql; goff = 512;
            const int kvh = wave >> 2, koff = 2048 + kvh * 64, voff = 2176 + kvh * 64;
            bf16x8 qB[4];
#pragma unroll
            for (int kk = 0; kk < 4; ++kk) qB[kk] = *(const bf16x8*)(proj + (size_t)(tokq + 32) * NIN + 1536 + wave * 64 + 32 * h + 8 * kk);
            st.m = sink[wave] * LOG2E; st.l = (h == 0) ? 1.f : 0.f; stB.m = st.m; stB.l = st.l;
            const int tlo = max(0, (128 - q0) / 32), thi = min(9, (SEQ - 1 - (q0 - 128)) / 32);
            for (int t = tlo, i = 0; t <= thi; ++t, ++i) {
                if (t + 1 <= thi) { BlkDesc d; d.base = b * SEQ + q0 - 128 + 32 * (t + 1); d.hs = 0; load_k(kn, proj, koff, d, ql, h); load_v(vf, proj, voff, d, lane); }
                const unsigned va = vb0 + (unsigned)((i & 1) * ATT_VBUF) + trb;
                if (t <= 8) { f32x16 s = qk_scores(kf, qf); if (t == 0 || t == 8) { SwXf xf{0, ql, h, 32 * t - 128}; xf.apply(s); } attn_softmax_pv(s, st, va); }
                if (t >= 1) { f32x16 s = qk_scores(kf, qB); if (t == 1 || t == 9) { SwXf xf{0, ql, h, 32 * t - 160}; xf.apply(s); } attn_softmax_pv(s, stB, va); }
                if (t + 1 <= thi) { store_v(vbuf + ((i + 1) & 1) * ATT_VBUF, vf, lane);
#pragma unroll
                    for (int kk = 0; kk < 4; ++kk) kf[kk] = kn[kk]; }
            }
        }
        bf16x8 qn[4];
        const UnitPre pn = unit_pre(it + 1, G, bid, wave, ql);
        if (pn.valid) {
#pragma unroll
            for (int kk = 0; kk < 4; ++kk) qn[kk] = *(const bf16x8*)(proj + (size_t)pn.tokq * NIN + pn.qoff + 32 * h + 8 * kk);
            load_k(kn, proj, pn.koff, pn.d0, ql, h); load_v(vf, proj, pn.voff, pn.d0, lane); }
        const float ssA = attn_norm_l(st), ssB = ud.swp ? attn_norm_l(stB) : 0.f;
        LAS float* rp = red + (it & 1) * 512;
        if (h == 0) { rp[wave * 64 + ql] = ssA; rp[wave * 64 + 32 + ql] = ssB; }
        __syncthreads();
        float totA = 0.f, totB = 0.f;
#pragma unroll
        for (int w = 0; w < 8; ++w) { totA += rp[w * 64 + ql]; totB += rp[w * 64 + 32 + ql]; }
        bf16_t* op = ao + (size_t)tokq * DM + goff + wave * 64 + 4 * h;
        attn_store(st, 1.f / sqrtf(totA * (1.f / 512.f) + EPS), op);
        if (ud.swp) attn_store(stB, 1.f / sqrtf(totB * (1.f / 512.f) + EPS), op + (size_t)32 * DM);
        if (pn.valid) {
#pragma unroll
            for (int kk = 0; kk < 4; ++kk) { qf[kk] = qn[kk]; kf[kk] = kn[kk]; } }
    }
    __syncthreads();
}

#define XB_TMO      128
#define XB_XCNT(j)  (256  + 64 * (j))
#define XB_XSUB(j)  (1280 + 64 * (j))
#define XB_XGEN(j)  (2304 + 64 * (j))
#define XB_TOP      3328
#define XB_TOPGEN   3392
#define XCD_BAR_WORDS 3456
#define XB_SPIN_CAP (1u << 18)

__device__ __forceinline__ unsigned xb_ld(unsigned* p)              { return __hip_atomic_load(p, __ATOMIC_RELAXED, __HIP_MEMORY_SCOPE_AGENT); }
__device__ __forceinline__ unsigned xb_add(unsigned* p, unsigned v) { return __hip_atomic_fetch_add(p, v, __ATOMIC_RELAXED, __HIP_MEMORY_SCOPE_AGENT); }
__device__ __forceinline__ unsigned xb_xcc_id() { return (unsigned)__builtin_amdgcn_s_getreg((3 << 11) | 20) & 0xFu; }
#define XB_SPIN(cond, bar) do { unsigned _sp = 0; while (cond) { __builtin_amdgcn_s_sleep(1); \
    if ((++_sp & 255u) == 0u) { if (xb_ld(&(bar)[XB_TMO])) break; if (_sp > XB_SPIN_CAP) { atomicAdd(&(bar)[XB_TMO], 1u); break; } } } } while (0)

struct XcdBarrier {
    unsigned* bar; unsigned x;
    volatile LAS unsigned* st;
};

__device__ __forceinline__ XcdBarrier xcd_barrier_post(unsigned* bar, volatile LAS unsigned* st) {
    XcdBarrier b; b.bar = bar; b.x = xb_xcc_id(); b.st = st;
    if (threadIdx.x == 0) (void)xb_add(&bar[XB_XCNT(b.x)], 1u);
    return b;
}
__device__ __forceinline__ void xcd_barrier_complete(unsigned* bar, unsigned x, unsigned& nloc, unsigned& nx) {
    const unsigned G = gridDim.x * gridDim.y * gridDim.z;
    unsigned sum, cnt, mine, sp = 0u;
    for (;;) {
        sum = 0u; cnt = 0u; mine = 0u;
#pragma unroll
        for (unsigned j = 0; j < 16; ++j) { const unsigned c = xb_ld(&bar[XB_XCNT(j)]); sum += c; cnt += (c > 0u) ? 1u : 0u; mine = (j == x) ? c : mine; }
        if (sum == G) break;
        __builtin_amdgcn_s_sleep(1);
        if ((++sp & 255u) == 0u) { if (xb_ld(&bar[XB_TMO])) break; if (sp > XB_SPIN_CAP) { atomicAdd(&bar[XB_TMO], 1u); break; } }
    }
    nloc = mine > 0u ? mine : 1u; nx = cnt > 0u ? cnt : 1u;
}

__device__ __forceinline__ void xcd_barrier(const XcdBarrier& b) {
    asm volatile("s_waitcnt vmcnt(0)" ::: "memory");
    __syncthreads();
    if (threadIdx.x == 0) {
        unsigned* bar = b.bar;
        __builtin_amdgcn_s_waitcnt(0);
        unsigned nloc = b.st[0], nx = b.st[1];
        if (nloc == 0u) { xcd_barrier_complete(bar, b.x, nloc, nx); b.st[0] = nloc; b.st[1] = nx; }
        const unsigned old = xb_add(&bar[XB_XSUB(b.x)], 1u);
        const unsigned gen = old / nloc;
        if (old + 1u == (gen + 1u) * nloc) {
            __builtin_amdgcn_fence(__ATOMIC_RELEASE, "agent");
            asm volatile("s_waitcnt vmcnt(0)" ::: "memory");
            const unsigned og = xb_add(&bar[XB_TOP], 1u);
            const unsigned tg = og / nx;
            if (og + 1u == (tg + 1u) * nx) xb_add(&bar[XB_TOPGEN], 1u);
            else XB_SPIN(xb_ld(&bar[XB_TOPGEN]) == tg, bar);
            __builtin_amdgcn_fence(__ATOMIC_ACQUIRE, "agent");
            xb_add(&bar[XB_XGEN(b.x)], 1u);
            asm volatile("s_waitcnt vmcnt(0)" ::: "memory");
        } else {
            XB_SPIN(xb_ld(&bar[XB_XGEN(b.x)]) == gen, bar);
            __builtin_amdgcn_fence(__ATOMIC_ACQUIRE, "agent");
            asm volatile("s_waitcnt vmcnt(0)" ::: "memory");
        }
    }
    __syncthreads();
}


__device__ __forceinline__ unsigned f2bf(float f) { unsigned u = __builtin_bit_cast(unsigned, f); return (u + 0x7fffu + ((u >> 16) & 1u)) >> 16; }
__device__ __forceinline__ unsigned pk2(float lo, float hi) { return f2bf(lo) | (f2bf(hi) << 16); }
template <int MAP> __device__ __forceinline__ int rowmap(int n) {
    if (MAP == 1) { if (n < 1536 || n >= 2176) return n; const int e = n - 1536, hh = e >> 6, d = e & 63, dd = d & 31, Gq = dd >> 2, i = dd & 3; return 1536 + 64 * hh + 8 * Gq + (d >= 32 ? 4 : 0) + i; }
    if (MAP == 2) { const int g = (n >= DFF) ? 1 : 0, ff = n - g * DFF; return 256 * (ff >> 7) + 128 * g + (ff & 127); }
    return n;
}
template <int MAP> __device__ __forceinline__ void transpose_item(const float* __restrict__ W, int K, int N, bf16_t* __restrict__ WT, const float* __restrict__ kscale, LAS float* scr, int item, int lane) {
    const int nblk = N / 32, kb = item / nblk, nb = item % nblk, k0 = 64 * kb, n0 = 32 * nb;
#pragma unroll
    for (int i = 0; i < 32; ++i) { const int kk = 2 * i + (lane >> 5); float v = W[(size_t)(k0 + kk) * N + n0 + (lane & 31)]; if (kscale) v *= kscale[k0 + kk]; scr[kk * 33 + (lane & 31)] = v; }
    asm volatile("s_waitcnt lgkmcnt(0)" ::: "memory");
    const int c = lane & 7;
#pragma unroll
    for (int j = 0; j < 4; ++j) { const int n = (lane >> 3) + 8 * j; const LAS float* s = scr + (8 * c) * 33 + n;
        u32x4 o; o.x = pk2(s[0 * 33], s[1 * 33]); o.y = pk2(s[2 * 33], s[3 * 33]); o.z = pk2(s[4 * 33], s[5 * 33]); o.w = pk2(s[6 * 33], s[7 * 33]);
        *(u32x4*)(WT + (size_t)rowmap<MAP>(n0 + n) * K + k0 + 8 * c) = o; }
    asm volatile("s_waitcnt lgkmcnt(0)" ::: "memory");
}
struct CvItem { const float* W; bf16_t* WT; const float* ks; int K, N, map, item; };
__device__ __forceinline__ void cv_load(float (&v)[32], const CvItem& c, int lane) {
    const int nblk = c.N / 32, kb = c.item / nblk, nb = c.item - kb * nblk, k0 = 64 * kb, n0 = 32 * nb;
    const float* p = c.W + (size_t)(k0 + (lane >> 5)) * c.N + n0 + (lane & 31);
#pragma unroll
    for (int i = 0; i < 32; ++i) v[i] = p[(size_t)(2 * i) * c.N];
}
__device__ __forceinline__ void cv_finish(const float (&v)[32], const CvItem& c, LAS float* scr, int lane) {
    const int nblk = c.N / 32, kb = c.item / nblk, nb = c.item - kb * nblk, k0 = 64 * kb, n0 = 32 * nb;
    if (c.ks) {
#pragma unroll
        for (int i = 0; i < 32; ++i) { const int kk = 2 * i + (lane >> 5); scr[kk * 33 + (lane & 31)] = v[i] * c.ks[k0 + kk]; } }
    else {
#pragma unroll
        for (int i = 0; i < 32; ++i) { const int kk = 2 * i + (lane >> 5); scr[kk * 33 + (lane & 31)] = v[i]; } }
    asm volatile("s_waitcnt lgkmcnt(0)" ::: "memory");
    const int cc = lane & 7;
#pragma unroll
    for (int j = 0; j < 4; ++j) { const int n = (lane >> 3) + 8 * j; const LAS float* sp = scr + (8 * cc) * 33 + n;
        u32x4 o; o.x = pk2(sp[0 * 33], sp[1 * 33]); o.y = pk2(sp[2 * 33], sp[3 * 33]); o.z = pk2(sp[4 * 33], sp[5 * 33]); o.w = pk2(sp[6 * 33], sp[7 * 33]);
        const int nn = n0 + n, row = (c.map == 1) ? rowmap<1>(nn) : ((c.map == 2) ? rowmap<2>(nn) : nn);
        *(u32x4*)(c.WT + (size_t)row * c.K + k0 + 8 * cc) = o; }
    asm volatile("s_waitcnt lgkmcnt(0)" ::: "memory");
}
template <int MODE> __device__ __forceinline__ void row_phase(const float* src, bf16_t* dst, float* io, const float* __restrict__ g, const float* __restrict__ mod, int shift_off, int scale_off) {
    const int lane = threadIdx.x & 63, gw = blockIdx.x * 8 + (threadIdx.x >> 6), NGW = gridDim.x * 8, rpw = MTOK / NGW, m_beg = gw * rpw, m_end = (gw == NGW - 1) ? MTOK : m_beg + rpw;
    const float* base = (MODE == 0) ? src : io;
    for (int m0 = m_beg; m0 < m_end; m0 += 4) {
        f32x4 cur[4][4];
#pragma unroll
        for (int r = 0; r < 4; ++r)
#pragma unroll
            for (int j = 0; j < 4; ++j) cur[r][j] = ((const f32x4*)(base + (size_t)min(m0 + r, MTOK - 1) * DM) + lane)[64 * j];
        const int b = m0 >> 11;
        f32x4 gv[4], sc[4], sh[4];
#pragma unroll
        for (int j = 0; j < 4; ++j) { const int c = 4 * lane + 256 * j; gv[j] = *(const f32x4*)(g + c);
            if (MODE == 0) { sc[j] = *(const f32x4*)(mod + b * 6144 + scale_off + c) + 1.f; sh[j] = *(const f32x4*)(mod + b * 6144 + shift_off + c); } }
        float ss[4];
#pragma unroll
        for (int r = 0; r < 4; ++r) { ss[r] = 0.f;
#pragma unroll
            for (int j = 0; j < 4; ++j) { const f32x4 v = cur[r][j]; ss[r] += (v.x * v.x + v.y * v.y) + (v.z * v.z + v.w * v.w); } }
#pragma unroll
        for (int o = 1; o < 64; o <<= 1) {
#pragma unroll
            for (int r = 0; r < 4; ++r) ss[r] += __shfl_xor(ss[r], o); }
#pragma unroll
        for (int r = 0; r < 4; ++r) {
            const int m = m0 + r; if (m >= m_end) break;
            const float rstd = 1.f / sqrtf(ss[r] * (1.f / DM) + EPS);
            if (MODE == 0) { unsigned long long* o8 = (unsigned long long*)(dst + (size_t)m * DM) + lane;
#pragma unroll
                for (int j = 0; j < 4; ++j) { const f32x4 y = cur[r][j] * rstd * gv[j] * sc[j] + sh[j]; o8[64 * j] = (unsigned long long)(cvt_pk_bf16(y.x, y.y)) | ((unsigned long long)cvt_pk_bf16(y.z, y.w) << 32); } }
            else { f32x4* xr = (f32x4*)(io + (size_t)m * DM) + lane;
#pragma unroll
                for (int j = 0; j < 4; ++j) xr[64 * j] = cur[r][j] * rstd * gv[j]; }
        }
    }
}
template <int MODE> __device__ __forceinline__ void row_phase_b16(const bf16_t* src, bf16_t* dst, float* outf, const float* __restrict__ g, const float* __restrict__ mod, int shift_off, int scale_off) {
    const int lane = threadIdx.x & 63, gw = blockIdx.x * 8 + (threadIdx.x >> 6), NGW = gridDim.x * 8, rpw = MTOK / NGW, m_beg = gw * rpw, m_end = (gw == NGW - 1) ? MTOK : m_beg + rpw;
    for (int m0 = m_beg; m0 < m_end; m0 += 4) {
        u32x4 raw[4][2];
#pragma unroll
        for (int r = 0; r < 4; ++r) { const bf16_t* p = src + (size_t)min(m0 + r, MTOK - 1) * DM + 8 * lane; raw[r][0] = *(const u32x4*)p; raw[r][1] = *(const u32x4*)(p + 512); }
        const int b = m0 >> 11;
        f32x4 gv[4], sc[4], sh[4];
#pragma unroll
        for (int j = 0; j < 4; ++j) { const int c = (j >> 1) * 512 + 8 * lane + 4 * (j & 1); gv[j] = *(const f32x4*)(g + c);
            if (MODE == 0) { sc[j] = *(const f32x4*)(mod + b * 6144 + scale_off + c) + 1.f; sh[j] = *(const f32x4*)(mod + b * 6144 + shift_off + c); } }
        f32x4 cur[4][4]; float ss[4];
#pragma unroll
        for (int r = 0; r < 4; ++r) { ss[r] = 0.f;
#pragma unroll
            for (int j = 0; j < 4; ++j) { const unsigned w0 = raw[r][j >> 1][2 * (j & 1)], w1 = raw[r][j >> 1][2 * (j & 1) + 1];
                const f32x4 v = (f32x4){__builtin_bit_cast(float, w0 << 16), __builtin_bit_cast(float, w0 & 0xffff0000u), __builtin_bit_cast(float, w1 << 16), __builtin_bit_cast(float, w1 & 0xffff0000u)};
                cur[r][j] = v; ss[r] += (v.x * v.x + v.y * v.y) + (v.z * v.z + v.w * v.w); } }
#pragma unroll
        for (int o = 1; o < 64; o <<= 1) {
#pragma unroll
            for (int r = 0; r < 4; ++r) ss[r] += __shfl_xor(ss[r], o); }
#pragma unroll
        for (int r = 0; r < 4; ++r) {
            const int m = m0 + r; if (m >= m_end) break;
            const float rstd = 1.f / sqrtf(ss[r] * (1.f / DM) + EPS);
            if (MODE == 0) {
#pragma unroll
                for (int hf = 0; hf < 2; ++hf) { const f32x4 y0 = cur[r][2 * hf] * rstd * gv[2 * hf] * sc[2 * hf] + sh[2 * hf], y1 = cur[r][2 * hf + 1] * rstd * gv[2 * hf + 1] * sc[2 * hf + 1] + sh[2 * hf + 1];
                    u32x4 w; w.x = cvt_pk_bf16(y0.x, y0.y); w.y = cvt_pk_bf16(y0.z, y0.w); w.z = cvt_pk_bf16(y1.x, y1.y); w.w = cvt_pk_bf16(y1.z, y1.w);
                    *(u32x4*)(dst + (size_t)m * DM + hf * 512 + 8 * lane) = w; } }
            else {
#pragma unroll
                for (int j = 0; j < 4; ++j) *(f32x4*)(outf + (size_t)m * DM + (j >> 1) * 512 + 8 * lane + 4 * (j & 1)) = cur[r][j] * rstd * gv[j]; }
        }
    }
}
__device__ __forceinline__ void fixup_panel(int pm, const float* __restrict__ SB, bf16_t* ACT, const float* __restrict__ cw) {
    constexpr int NITEM = 8 * (DFF / 4);
#pragma unroll 1
    for (int e0 = threadIdx.x; e0 < NITEM; e0 += 4 * 512) {
        f32x4 gc[4], val[4], nbr[4], wv[4];
#pragma unroll
        for (int q = 0; q < 4; ++q) {
            const int e = min(e0 + q * 512, NITEM - 1), rr = e / (DFF / 4), c4 = (e % (DFF / 4)) * 4, chunk = 4 * pm + (rr >> 1), which = rr & 1;
            const float* sb = SB + ((size_t)(chunk * 2 + which) * 3) * DFF + c4;
            gc[q] = *(const f32x4*)sb; val[q] = *(const f32x4*)(sb + DFF);
            const bool has = which == 0 ? ((chunk & 31) != 0) : ((chunk & 31) != 31);
            const int nchunk = has ? (which == 0 ? chunk - 1 : chunk + 1) : chunk;
            nbr[q] = *(const f32x4*)(SB + ((size_t)(nchunk * 2 + (which ^ 1)) * 3 + 2) * DFF + c4);
            wv[q] = *(const f32x4*)(cw + (which == 0 ? 0 : 2 * DFF) + c4);
            if (!has) wv[q] = (f32x4){0.f, 0.f, 0.f, 0.f};
        }
#pragma unroll
        for (int q = 0; q < 4; ++q) {
            const int e = e0 + q * 512; if (e >= NITEM) break;
            const int rr = e / (DFF / 4), c4 = (e % (DFF / 4)) * 4, chunk = 4 * pm + (rr >> 1), which = rr & 1;
            const f32x4 g2 = gc[q] + wv[q] * nbr[q];
            float a[4];
#pragma unroll
            for (int j = 0; j < 4; ++j) a[j] = g2[j] * val[q][j] * __builtin_amdgcn_rcpf(1.f + __builtin_amdgcn_exp2f(-LOG2E * g2[j]));
            u32x2 w; w.x = cvt_pk_bf16(a[0], a[1]); w.y = cvt_pk_bf16(a[2], a[3]);
            *(u32x2*)(ACT + (size_t)(chunk * 64 + which * 63) * DFF + c4) = w;
        }
    }
}

struct Args { const float* in[17]; float* out; unsigned char* ws; int ph_lo, ph_hi; };
static_assert(sizeof(Args) == 17 * 8 + 8 + 8 + 8, "Args has no padding");

__global__ void __launch_bounds__(512, 2) fwd_megakernel(Args args) {
    extern __shared__ __attribute__((aligned(16))) unsigned char lds_raw[];
    LAS unsigned char* lds = (LAS unsigned char*)lds_raw;
    cg::grid_group grid = cg::this_grid();
    const int tid = threadIdx.x, wave = __builtin_amdgcn_readfirstlane(tid >> 6), lane = tid & 63, G = gridDim.x, bid = blockIdx.x;
    const float* x = args.in[0]; const float* cvec = args.in[1]; const float* w_ada = args.in[2]; const float* b_ada = args.in[3]; const float* g_attn = args.in[4];
    const float* w_in = args.in[5]; const float* rpb = args.in[6]; const float* sink = args.in[7]; const float* g_na = args.in[8]; const float* g_sw = args.in[9];
    const float* w_out = args.in[10]; const float* g_ffn = args.in[11]; const float* w_up = args.in[12]; const float* conv_w = args.in[13]; const float* conv_b = args.in[14];
    const float* w_down = args.in[15]; const float* g_final = args.in[16];
    unsigned char* ws = args.ws; float* out = args.out;
    float* mod = (float*)(ws + WS_MOD); float* costab = (float*)(ws + WS_COS); float* sintab = (float*)(ws + WS_SIN);
    bf16_t* Win = (bf16_t*)(ws + WS_WIN); bf16_t* Wout = (bf16_t*)(ws + WS_WOUT); bf16_t* Wup = (bf16_t*)(ws + WS_WUP); bf16_t* Wdn = (bf16_t*)(ws + WS_WDN);
    bf16_t* H = (bf16_t*)(ws + WS_H); bf16_t* PROJ = (bf16_t*)(ws + WS_PROJ); bf16_t* AO = (bf16_t*)(ws + WS_AO); bf16_t* ACT = (bf16_t*)(ws + WS_ACT); float* SB = (float*)(ws + WS_SB); bf16_t* X1B = (bf16_t*)(ws + WS_X1B);
    const int lo = args.ph_lo, hi = args.ph_hi;
    volatile LAS unsigned* barst = (volatile LAS unsigned*)(lds + LDS_BARST_OFF);
    if (tid < 2) barst[tid] = 0u;
    __syncthreads();
    XcdBarrier xbar = xcd_barrier_post((unsigned*)(ws + WS_BAR), barst);
#define IN(k) (lo <= (k) && (k) < hi)
#define SEAM(k) do { if (IN(k) && IN((k) + 1)) { if (args.ph_hi > 1000) grid.sync(); else xcd_barrier(xbar); } } while (0)

    if (IN(0)) {
        {
            const int gi = bid * 512 + tid;
            for (int e = gi; e < SEQ * 32; e += G * 512) { const int pos = e >> 5, f = e & 31;
                const float inv = powf(10000.f, -(float)f / 32.f); const float ang = (float)pos * inv;
                costab[e] = cosf(ang); sintab[e] = sinf(ang); }
        }
        if (bid < 192) {
            LAS float* sc = (LAS float*)lds; LAS float* red = (LAS float*)(lds + 65536);
#pragma unroll 8
            for (int i = tid; i < NB * DM; i += 512) { const float v = cvec[i]; sc[i] = v / (1.f + __expf(-v)); }
            __syncthreads();
            const int n0 = 32 * bid, col = lane & 31, par = lane >> 5;
            float acc[16];
#pragma unroll
            for (int b = 0; b < 16; ++b) acc[b] = 0.f;
            const float* wp = w_ada + n0 + col;
#pragma unroll 8
            for (int kk = 0; kk < 64; ++kk) { const int k = wave * 128 + kk * 2 + par; const float w = wp[(size_t)k * 6144];
#pragma unroll
                for (int b = 0; b < 16; ++b) acc[b] += sc[b * DM + k] * w; }
#pragma unroll
            for (int b = 0; b < 16; ++b) red[((wave * 2 + par) * 16 + b) * 32 + col] = acc[b];
            __syncthreads();
            { const int b = tid >> 5, cc = tid & 31; float s = b_ada[n0 + cc];
#pragma unroll
              for (int g = 0; g < 16; ++g) s += red[(g * 16 + b) * 32 + cc];
              mod[b * 6144 + n0 + cc] = s; }
            __syncthreads();
        }
        {
            LAS float* scr = (LAS float*)(lds + wave * 16384);
            constexpr int I_IN = (DM / 64) * (NIN / 32), I_OUT = (DM / 64) * (DM / 32), I_UP = (DM / 64) * (NUP / 32), I_DN = (DFF / 64) * (DM / 32);
            const bool late_up = (G == 256);
            const int nit = I_IN + I_OUT + I_DN + (late_up ? 0 : I_UP);
            int first, step, lim;
            if (late_up) { if (bid >= 192) { first = (bid - 192) * 8 + wave; step = 512; lim = nit; } else { first = 0; step = 1; lim = 0; } }
            else { first = bid * 8 + wave; step = G * 8; lim = nit; }
            auto mk = [&](int it) { CvItem c; int r = it;
                if (r < I_IN) { c.W = w_in; c.WT = Win; c.ks = nullptr; c.K = DM; c.N = NIN; c.map = 1; c.item = r; return c; } r -= I_IN;
                if (r < I_OUT) { const int kb = r / (DM / 32); c.W = w_out; c.WT = Wout; c.ks = (kb < 8) ? g_na : (g_sw - 512); c.K = DM; c.N = DM; c.map = 0; c.item = r; return c; } r -= I_OUT;
                if (r < I_DN) { c.W = w_down; c.WT = Wdn; c.ks = nullptr; c.K = DFF; c.N = DM; c.map = 0; c.item = r; return c; } r -= I_DN;
                c.W = w_up; c.WT = Wup; c.ks = nullptr; c.K = DM; c.N = NUP; c.map = 2; c.item = r; return c; };
            if (first < lim) {
                float va[32], vb[32];
                CvItem ca = mk(first), cb = ca; cv_load(va, ca, lane);
#pragma unroll 1
                for (int it = first;;) {
                    const int i1 = it + step; const bool m1 = i1 < lim;
                    if (m1) { cb = mk(i1); cv_load(vb, cb, lane); }
                    cv_finish(va, ca, scr, lane);
                    if (!m1) break;
                    const int i2 = i1 + step; const bool m2 = i2 < lim;
                    if (m2) { ca = mk(i2); cv_load(va, ca, lane); }
                    cv_finish(vb, cb, scr, lane);
                    if (!m2) break;
                    it = i2;
                }
            }
        }
    }
    SEAM(0);
    if (IN(1)) row_phase<0>(x, H, nullptr, g_attn, mod, 0, 1024);
    SEAM(1);
    if (IN(2)) {
        Gemm g{H, Win, MTOK, NIN, DM}; StaticOrder S; S.init(MTOK, NIN, G, bid);
        EpiIn E{PROJ, costab, sintab};
        gemm_phase<EpiIn, StaticOrder, true, true>(lds, g, S, E);
        if (G == 256 && bid >= 128) {
            __syncthreads();
            LAS float* scr = (LAS float*)(lds + wave * 16384);
            constexpr int I_UPc = (DM / 64) * (NUP / 32);
            float va[32], vb[32];
            CvItem ca{w_up, Wup, nullptr, DM, NUP, 2, (bid - 128) * 8 + wave}, cb = ca;
            cv_load(va, ca, lane);
#pragma unroll 1
            for (;;) {
                const bool m1 = ca.item + 1024 < I_UPc;
                if (m1) { cb.item = ca.item + 1024; cv_load(vb, cb, lane); }
                cv_finish(va, ca, scr, lane);
                if (!m1) break;
                const bool m2 = cb.item + 1024 < I_UPc;
                if (m2) { ca.item = cb.item + 1024; cv_load(va, ca, lane); }
                cv_finish(vb, cb, scr, lane);
                if (!m2) break;
            }
        }
    }
    SEAM(2);
    if (IN(3)) attn_phase(lds, PROJ, AO, rpb, sink);
    SEAM(3);
    if (IN(4)) {
        Gemm g{AO, Wout, MTOK, DM, DM}; StaticOrder S; S.init(MTOK, DM, G, bid);
        EpiResB<false> E{x, X1B, mod + 2048};
        gemm_phase<EpiResB<false>, StaticOrder, true, true>(lds, g, S, E);
    }
    SEAM(4);
    if (IN(5)) row_phase_b16<0>(X1B, H, nullptr, g_ffn, mod, 3072, 4096);
    SEAM(5);
    if (IN(6)) {
        Gemm g{H, Wup, MTOK, NUP, DM}; StaticOrder S; S.init(MTOK, NUP, G, bid);
        EpiUp E{ACT, SB, conv_w, conv_b};
        gemm_phase<EpiUp, StaticOrder, true, true, true>(lds, g, S, E);
    }
    SEAM(6);
    if (IN(7)) {
        StaticOrder S; S.init(MTOK, DM, G, bid);
        { Unit u; for (int i = 0; S.next(i, u); ++i) fixup_panel(u.pm, SB, ACT, conv_w); }
        __threadfence(); __syncthreads();
        Gemm g{ACT, Wdn, MTOK, DM, DFF};
        EpiResB<true> E{X1B, X1B, mod + 5120};
        gemm_phase<EpiResB<true>, StaticOrder, true, true>(lds, g, S, E);
    }
    SEAM(7);
    if (IN(8)) row_phase_b16<1>(X1B, nullptr, out, g_final, nullptr, 0, 0);
#undef IN
#undef SEAM
}

#ifndef N_LAUNCH_SPLIT
#define N_LAUNCH_SPLIT 0
#endif
extern "C" void kernel_launch(void* const* d_in, const int* in_sizes, int n_in, void* d_out, int out_size, void* d_ws, size_t ws_size, hipStream_t stream) {
    static int grid_blocks = 0;
    if (grid_blocks == 0) {
        if (n_in != 17 || out_size != MTOK * DM || ws_size < WS_END) { fprintf(stderr, "kernel_launch: unexpected shapes (n_in %d out %d ws %zu)\n", n_in, out_size, ws_size); grid_blocks = -1; return; }
        int dev = 0, cus = 0, per_cu = 0;
        hipGetDevice(&dev); hipDeviceGetAttribute(&cus, hipDeviceAttributeMultiprocessorCount, dev);
        if (hipFuncSetAttribute((const void*)fwd_megakernel, hipFuncAttributeMaxDynamicSharedMemorySize, LDS_BYTES) != hipSuccess) { fprintf(stderr, "kernel_launch: hipFuncSetAttribute failed\n"); grid_blocks = -1; return; }
        if (hipOccupancyMaxActiveBlocksPerMultiprocessor(&per_cu, (const void*)fwd_megakernel, 512, LDS_BYTES) != hipSuccess || per_cu < 1) { fprintf(stderr, "kernel_launch: occupancy query failed (%d)\n", per_cu); per_cu = 1; (void)hipGetLastError(); }
        grid_blocks = cus * per_cu; if (grid_blocks > 256) grid_blocks = 256;
        fprintf(stderr, "kernel_launch: %d CUs x %d blocks -> grid %d\n", cus, per_cu, grid_blocks);
    }
    if (grid_blocks < 0) return;
    if (hipMemsetAsync((char*)d_ws + WS_BAR, 0, BAR_ZERO_BYTES, stream) != hipSuccess) { fprintf(stderr, "kernel_launch: memset failed\n"); return; }
    Args a{};
    for (int i = 0; i < 17; ++i) a.in[i] = (const float*)d_in[i];
    a.out = (float*)d_out; a.ws = (unsigned char*)d_ws;
#if N_LAUNCH_SPLIT
    for (int p = 0; p < 9; ++p) { a.ph_lo = p; a.ph_hi = p + 1; void* kargs[] = {&a};
        hipError_t e = hipLaunchCooperativeKernel((const void*)fwd_megakernel, dim3(grid_blocks), dim3(512), kargs, LDS_BYTES, stream);
        if (e != hipSuccess) { fprintf(stderr, "cooperative launch (phase %d) failed: %s\n", p, hipGetErrorString(e)); return; } }
#else
    a.ph_lo = 0; a.ph_hi = 9; void* kargs[] = {&a};
    hipError_t e = hipLaunchCooperativeKernel((const void*)fwd_megakernel, dim3(grid_blocks), dim3(512), kargs, LDS_BYTES, stream);
    if (e != hipSuccess) fprintf(stderr, "cooperative launch failed: %s (grid %d)\n", hipGetErrorString(e), grid_blocks);
#endif
}
```

```cpp
#include <hip/hip_runtime.h>
#include <hip/hip_cooperative_groups.h>
#include <cstdio>
#include <cstdint>
namespace cg = cooperative_groups;
namespace pg8 {
#define PG8_LAS __attribute__((address_space(3)))
typedef unsigned short bf16_t;
typedef short bf16x8 __attribute__((ext_vector_type(8)));
typedef float f32x4 __attribute__((ext_vector_type(4)));
typedef unsigned u32x4 __attribute__((ext_vector_type(4)));
constexpr int BM = 256, BK = 64, HALF = 128, HTB = HALF * BK * 2  , STAGE_BYTES = 8 * HTB, NXCD = 8, WGM = 8;

__host__ __device__ __forceinline__ int lds_byte(int r, int c) { const int st = (r >> 4) * 2 + (c >> 5), rr = r & 15, cc = c & 31, ob = rr * 64 + cc * 2; return st * 1024 + (ob ^ (((ob >> 9) & 1) << 5)); }
__host__ __device__ __forceinline__ void stage_rc(int b, int& R, int& C) { const int st = b / 1024, sb = b % 1024, swz = sb ^ (((sb >> 9) & 1) << 5); R = (st >> 1) * 16 + swz / 64; C = (st & 1) * 32 + (swz % 64) / 2; }
__host__ __device__ __forceinline__ int perm32(int rho) { const int n = rho >> 4, i = rho & 15; return 8 * (i >> 2) + 4 * n + (i & 3); }

struct Unit { int pm, pn; };
struct Gemm { const bf16_t* A; const bf16_t* Bt; int M, N, K; };

struct StaticOrder {
    int nM, nN, nwg, G, c;
    __host__ __device__ void init(int M, int N, int G_, int c_) { nM = M / BM; nN = N / BM; nwg = nM * nN; G = G_; c = c_; }
    __host__ __device__ bool next(int i, Unit& u) const {
        const long L = (long)i * G + c; if (L >= nwg) return false;
        int wgid = (int)L; { const int q = nwg / NXCD, r = nwg % NXCD, xcd = wgid % NXCD, off = wgid / NXCD; wgid = (xcd < r ? xcd * (q + 1) : r * (q + 1) + (xcd - r) * q) + off; }
        const int nig = WGM * nN, gid = wgid / nig, fm = gid * WGM, gsz = (nM - fm) < WGM ? (nM - fm) : WGM;
        u.pm = fm + ((wgid % nig) % gsz); u.pn = (wgid % nig) / gsz; return true;
    }
    __device__ __forceinline__ void a_ready(const Unit&) const {}
    __device__ __forceinline__ void done(const Unit&) const {}
};

__device__ __forceinline__ unsigned cvt_pk_bf16(float lo, float hi) { unsigned r; asm volatile("v_cvt_pk_bf16_f32 %0, %1, %2" : "=v"(r) : "v"(lo), "v"(hi)); return r; }
__device__ __forceinline__ void store16_wt(void* p, u32x4 v) { asm volatile("global_store_dwordx4 %0, %1, off sc1\n\ts_nop 2" :: "v"(p), "v"(v) : "memory");     }
typedef float f32x2 __attribute__((ext_vector_type(2)));
template <class Epi, class Sched, bool ALIGN_EPI = false, bool SP2 = false, bool ROWPERM = false>
__device__ __forceinline__ void gemm_phase(PG8_LAS unsigned char* lds, const Gemm g, const Sched& S, const Epi& E) {
    const int tid = threadIdx.x, wid = __builtin_amdgcn_readfirstlane(tid >> 6), lane = tid & 63, wr = wid >> 2, wc = wid & 3, fr = lane & 15, fq = lane >> 4;
    const int K = g.K, nt = K / BK;
    unsigned voffA[2], voffB[2];
#pragma unroll
    for (int i = 0; i < 2; ++i) { int R, C; stage_rc(tid * 16 + i * 8192, R, C); const int Rb = Epi::PERM ? ((R & ~31) + perm32(R & 31)) : R;
        const int Ra = ROWPERM ? ((R & ~63) + 4 * (R & 15) + ((R >> 4) & 3)) : R;
        voffA[i] = (unsigned)(Ra * K + C) * 2u; voffB[i] = (unsigned)(Rb * K + C) * 2u; }
    const size_t kstep = (size_t)(BK * 2);
    const size_t hstep = (size_t)HALF * K * 2;
    const size_t tstep = 2 * hstep;
    const unsigned ldsw = (unsigned)wid * 1024u;
    const int aoff = lds_byte(wr * 64 + fr, fq * 8), boff = lds_byte(wc * 32 + fr, fq * 8);
#define PG8_SA(b, h) (((b) * 2 + (h)) * HTB)
#define PG8_SB(b, h) ((4 + (b) * 2 + (h)) * HTB)
#define PG8_STAGE(bufoff, gbase, voff) do { _Pragma("unroll") for (int _i = 0; _i < 2; ++_i) \
        __builtin_amdgcn_global_load_lds((const unsigned*)((const char*)(gbase) + (voff)[_i]), (PG8_LAS unsigned*)(lds + (bufoff) + ldsw + _i * 8192), 16, 0, 0); } while (0)
#define PG8_LDA(dst, b, h) do { _Pragma("unroll") for (int m = 0; m < 4; ++m) _Pragma("unroll") for (int k = 0; k < 2; ++k) dst[m][k] = *(const PG8_LAS bf16x8*)(lds + PG8_SA(b, h) + aoff + m * 2048 + k * 1024); } while (0)
#define PG8_LDB(dst, b, h) do { _Pragma("unroll") for (int n = 0; n < 2; ++n) _Pragma("unroll") for (int k = 0; k < 2; ++k) dst[n][k] = *(const PG8_LAS bf16x8*)(lds + PG8_SB(b, h) + boff + n * 2048 + k * 1024); } while (0)
#define PG8_MMA(ai, bj, At, Bt) do { __builtin_amdgcn_s_setprio(1); _Pragma("unroll") for (int m = 0; m < 4; ++m) _Pragma("unroll") for (int n = 0; n < 2; ++n) _Pragma("unroll") for (int k = 0; k < 2; ++k) \
        acc[ai][bj][m][n] = __builtin_amdgcn_mfma_f32_16x16x32_bf16(Bt[n][k], At[m][k], acc[ai][bj][m][n], 0, 0, 0); __builtin_amdgcn_s_setprio(0); } while (0)
#define PG8_WAIT_V(n) asm volatile("s_waitcnt vmcnt(" #n ")" ::: "memory")
#define PG8_WAIT_L(n) asm volatile("s_waitcnt lgkmcnt(" #n ")" ::: "memory")
#define PG8_BAR __builtin_amdgcn_s_barrier()
#define PG8_SCHED __builtin_amdgcn_sched_barrier(0)
    Unit cur, nxt; int ui = 0;
    if (!S.next(0, cur)) return;
    f32x4 acc[2][2][4][2];
#pragma unroll
    for (int a = 0; a < 2; ++a)
#pragma unroll
        for (int b = 0; b < 2; ++b)
#pragma unroll
            for (int m = 0; m < 4; ++m)
#pragma unroll
                for (int n = 0; n < 2; ++n) acc[a][b][m][n] = (f32x4){0.f, 0.f, 0.f, 0.f};
    bf16x8 At[4][2], B0[2][2], B1[2][2];
    const char* cA = (const char*)g.A + (size_t)cur.pm * tstep; const char* cB = (const char*)g.Bt + (size_t)cur.pn * tstep;
    S.a_ready(cur);
    if constexpr (SP2) {
        PG8_STAGE(PG8_SB(0, 0), cB, voffB); PG8_STAGE(PG8_SB(0, 1), cB + hstep, voffB); PG8_STAGE(PG8_SA(0, 0), cA, voffA); PG8_STAGE(PG8_SA(0, 1), cA + hstep, voffA);
        if (wr == 1) PG8_BAR;
        PG8_WAIT_V(2); PG8_BAR;
        PG8_STAGE(PG8_SB(1, 0), cB + kstep, voffB); PG8_STAGE(PG8_SA(1, 0), cA + kstep, voffA); PG8_STAGE(PG8_SB(1, 1), cB + hstep + kstep, voffB);
        PG8_WAIT_V(6); PG8_BAR;
    } else {
        PG8_STAGE(PG8_SB(0, 0), cB, voffB); PG8_STAGE(PG8_SA(0, 0), cA, voffA); PG8_STAGE(PG8_SB(0, 1), cB + hstep, voffB); PG8_STAGE(PG8_SA(0, 1), cA + hstep, voffA);
        if (wr == 1) PG8_BAR;
        PG8_WAIT_V(4); PG8_BAR;
        PG8_STAGE(PG8_SB(1, 0), cB + kstep, voffB); PG8_STAGE(PG8_SA(1, 0), cA + kstep, voffA); PG8_STAGE(PG8_SB(1, 1), cB + hstep + kstep, voffB);
        PG8_WAIT_V(6); PG8_BAR;
    }
    for (;;) {
        const bool has_next = S.next(ui + 1, nxt);
        const char* nA = has_next ? (const char*)g.A + (size_t)nxt.pm * tstep : cA; const char* nB = has_next ? (const char*)g.Bt + (size_t)nxt.pn * tstep : cB;
        for (int t = 0; t < nt; t += 2) {
            const bool last = (t == nt - 2);
            const char* a1 = cA + (size_t)(t + 1) * kstep;
            const char* a2 = last ? nA : cA + (size_t)(t + 2) * kstep; const char* b2 = last ? nB : cB + (size_t)(t + 2) * kstep;
            const char* a3 = a2 + kstep; const char* b3 = b2 + kstep;
            if (last && has_next) S.a_ready(nxt);
            if constexpr (SP2) {
            PG8_LDB(B0, 0, 0); PG8_LDB(B1, 0, 1); PG8_SCHED; PG8_LDA(At, 0, 0); PG8_STAGE(PG8_SA(1, 1), a1 + hstep, voffA);
            PG8_WAIT_V(8); PG8_WAIT_L(0); PG8_BAR; PG8_MMA(0, 0, At, B0); PG8_MMA(0, 1, At, B1); PG8_BAR; PG8_SCHED;
            PG8_LDA(At, 0, 1); PG8_STAGE(PG8_SB(0, 0), b2, voffB); PG8_STAGE(PG8_SB(0, 1), b2 + hstep, voffB); PG8_STAGE(PG8_SA(0, 0), a2, voffA);
            PG8_WAIT_V(8); PG8_WAIT_L(0); PG8_BAR; PG8_MMA(1, 0, At, B0); PG8_MMA(1, 1, At, B1); PG8_BAR; PG8_SCHED;
            PG8_LDB(B0, 1, 0); PG8_LDB(B1, 1, 1); PG8_SCHED; PG8_LDA(At, 1, 0); PG8_STAGE(PG8_SA(0, 1), a2 + hstep, voffA);
            PG8_WAIT_V(8); PG8_WAIT_L(0); PG8_BAR; PG8_MMA(0, 0, At, B0); PG8_MMA(0, 1, At, B1); PG8_BAR; PG8_SCHED;
            PG8_LDA(At, 1, 1); PG8_STAGE(PG8_SB(1, 0), b3, voffB); PG8_STAGE(PG8_SB(1, 1), b3 + hstep, voffB); PG8_STAGE(PG8_SA(1, 0), a3, voffA);
            PG8_WAIT_V(8); PG8_WAIT_L(0); PG8_BAR; PG8_MMA(1, 0, At, B0); PG8_MMA(1, 1, At, B1); PG8_BAR; PG8_SCHED;
            } else {
            PG8_LDB(B0, 0, 0); PG8_SCHED; PG8_LDA(At, 0, 0); PG8_STAGE(PG8_SA(1, 1), a1 + hstep, voffA);
            PG8_WAIT_L(8); PG8_BAR; PG8_WAIT_L(0); PG8_MMA(0, 0, At, B0); PG8_BAR; PG8_SCHED;
            PG8_LDB(B1, 0, 1); PG8_STAGE(PG8_SB(0, 0), b2, voffB);
            PG8_BAR; PG8_WAIT_L(0); PG8_MMA(0, 1, At, B1); PG8_BAR;
            PG8_LDA(At, 0, 1); PG8_STAGE(PG8_SA(0, 0), a2, voffA);
            PG8_BAR; PG8_WAIT_L(0); PG8_MMA(1, 0, At, B0); PG8_BAR; PG8_SCHED;
            PG8_STAGE(PG8_SB(0, 1), b2 + hstep, voffB);
            PG8_WAIT_V(6); PG8_BAR; PG8_MMA(1, 1, At, B1); PG8_BAR;
            PG8_LDB(B0, 1, 0); PG8_SCHED; PG8_LDA(At, 1, 0); PG8_STAGE(PG8_SA(0, 1), a2 + hstep, voffA);
            PG8_WAIT_L(8); PG8_BAR; PG8_WAIT_L(0); PG8_MMA(0, 0, At, B0); PG8_BAR; PG8_SCHED;
            PG8_LDB(B1, 1, 1); PG8_STAGE(PG8_SB(1, 0), b3, voffB);
            PG8_BAR; PG8_WAIT_L(0); PG8_MMA(0, 1, At, B1); PG8_BAR;
            PG8_LDA(At, 1, 1); PG8_STAGE(PG8_SA(1, 0), a3, voffA);
            PG8_BAR; PG8_WAIT_L(0); PG8_MMA(1, 0, At, B0); PG8_BAR; PG8_SCHED;
            PG8_STAGE(PG8_SB(1, 1), b3 + hstep, voffB);
            PG8_WAIT_V(6); PG8_BAR; PG8_MMA(1, 1, At, B1); PG8_BAR;
            }
        }
        if constexpr (ALIGN_EPI) { if (wr == 0) PG8_BAR; }
        if constexpr (!Epi::AFTER_DRAIN) { E(acc, cur, wr, wc, fr, fq); S.done(cur); }
        if (!has_next) break;
#pragma unroll
        for (int a = 0; a < 2; ++a)
#pragma unroll
            for (int b = 0; b < 2; ++b)
#pragma unroll
                for (int m = 0; m < 4; ++m)
#pragma unroll
                    for (int n = 0; n < 2; ++n) acc[a][b][m][n] = (f32x4){0.f, 0.f, 0.f, 0.f};
        cur = nxt; cA = nA; cB = nB; ++ui;
        if constexpr (ALIGN_EPI) { if (wr == 1) PG8_BAR; }
    }
    PG8_WAIT_V(0);
    if constexpr (!ALIGN_EPI) { if (wr == 0) PG8_BAR; }
    PG8_BAR;
    if constexpr (Epi::AFTER_DRAIN) { E.fused(acc, cur, wr, wc, fr, fq, lds, wid, lane); S.done(cur); }
#undef PG8_SA
#undef PG8_SB
#undef PG8_STAGE
#undef PG8_LDA
#undef PG8_LDB
#undef PG8_MMA
#undef PG8_WAIT_V
#undef PG8_WAIT_L
#undef PG8_BAR
#undef PG8_SCHED
}
constexpr float LOG2E = 1.4426950408889634f;
constexpr float C2 = 0.125f * LOG2E;
struct EpiIn {
    static constexpr bool PERM = true, AFTER_DRAIN = false;
    bf16_t* O; const float* costab; const float* sintab;
    __device__ __forceinline__ void operator()(const f32x4 (&acc)[2][2][4][2], const Unit& u, int wr, int wc, int fr, int fq) const {
        const int pn = u.pn, row0 = u.pm * BM + wr * 64 + fr, col0 = pn * BM + wc * 32 + 8 * fq;
        const bool rope0 = (pn >= 6), rope1 = (pn == 6 || pn == 7);
        const float sc = (pn < 2 || pn == 6 || pn == 7) ? C2 : 1.f;
        const int G4 = 4 * ((wc & 1) * 4 + fq);
#pragma unroll
        for (int ai = 0; ai < 2; ++ai)
#pragma unroll
            for (int m = 0; m < 4; ++m) {
                const int row = row0 + ai * HALF + m * 16, pos = row & 2047;
                f32x4 cs = (f32x4){1.f, 1.f, 1.f, 1.f}, sn = (f32x4){0.f, 0.f, 0.f, 0.f};
                if (rope0) { cs = *(const f32x4*)(costab + pos * 32 + G4); sn = *(const f32x4*)(sintab + pos * 32 + G4); }
                bf16_t* rowp = O + (size_t)row * 2304 + col0;
#pragma unroll
                for (int bj = 0; bj < 2; ++bj) {
                    f32x4 v0 = acc[ai][bj][m][0], v1 = acc[ai][bj][m][1];
                    if (bj == 0 ? rope0 : rope1) { const f32x4 o0 = v0 * cs - v1 * sn, o1 = v1 * cs + v0 * sn; v0 = o0; v1 = o1; }
                    v0 = v0 * sc; v1 = v1 * sc;
                    u32x4 w; w.x = cvt_pk_bf16(v0[0], v0[1]); w.y = cvt_pk_bf16(v0[2], v0[3]); w.z = cvt_pk_bf16(v1[0], v1[1]); w.w = cvt_pk_bf16(v1[2], v1[3]);
                    store16_wt(rowp + bj * HALF, w);
                }
            }
    }
};
struct EpiRes {
    static constexpr bool PERM = false, AFTER_DRAIN = false;
    const float* base; float* out; const float* gate;
    __device__ __forceinline__ void operator()(const f32x4 (&acc)[2][2][4][2], const Unit& u, int wr, int wc, int fr, int fq) const {
        const int col0 = u.pn * BM + wc * 32 + 4 * fq, b = u.pm >> 3;
        f32x4 gv[2][2];
#pragma unroll
        for (int bj = 0; bj < 2; ++bj)
#pragma unroll
            for (int n = 0; n < 2; ++n) gv[bj][n] = *(const f32x4*)(gate + b * 6144 + col0 + bj * HALF + n * 16);
#pragma unroll
        for (int ai = 0; ai < 2; ++ai)
#pragma unroll
            for (int mp = 0; mp < 2; ++mp) {
                f32x4 bs[2][2][2];
#pragma unroll
                for (int mm = 0; mm < 2; ++mm) { const size_t off = (size_t)(u.pm * BM + ai * HALF + wr * 64 + (2 * mp + mm) * 16 + fr) * 1024 + col0;
#pragma unroll
                    for (int bj = 0; bj < 2; ++bj)
#pragma unroll
                        for (int n = 0; n < 2; ++n) bs[mm][bj][n] = *(const f32x4*)(base + off + bj * HALF + n * 16); }
                asm volatile("" ::: "memory");
#pragma unroll
                for (int mm = 0; mm < 2; ++mm) { const size_t off = (size_t)(u.pm * BM + ai * HALF + wr * 64 + (2 * mp + mm) * 16 + fr) * 1024 + col0;
#pragma unroll
                    for (int bj = 0; bj < 2; ++bj)
#pragma unroll
                        for (int n = 0; n < 2; ++n) *(f32x4*)(out + off + bj * HALF + n * 16) = bs[mm][bj][n] + gv[bj][n] * acc[ai][bj][2 * mp + mm][n]; }
                asm volatile("" ::: "memory");
            }
    }
};
template <bool BASE_B16> struct EpiResB {
    static constexpr bool PERM = false, AFTER_DRAIN = false;
    const void* base; bf16_t* outb; const float* gate;
    __device__ __forceinline__ void operator()(const f32x4 (&acc)[2][2][4][2], const Unit& u, int wr, int wc, int fr, int fq) const {
        typedef unsigned u32x2v __attribute__((ext_vector_type(2)));
        const int col0 = u.pn * BM + wc * 32 + 4 * fq, b = u.pm >> 3;
        f32x4 gv[2][2];
#pragma unroll
        for (int bj = 0; bj < 2; ++bj)
#pragma unroll
            for (int n = 0; n < 2; ++n) gv[bj][n] = *(const f32x4*)(gate + b * 6144 + col0 + bj * HALF + n * 16);
#pragma unroll
        for (int ai = 0; ai < 2; ++ai)
#pragma unroll
            for (int mp = 0; mp < 2; ++mp) {
                f32x4 bs[2][2][2];
#pragma unroll
                for (int mm = 0; mm < 2; ++mm) { const size_t off = (size_t)(u.pm * BM + ai * HALF + wr * 64 + (2 * mp + mm) * 16 + fr) * 1024 + col0;
#pragma unroll
                    for (int bj = 0; bj < 2; ++bj)
#pragma unroll
                        for (int n = 0; n < 2; ++n) {
                            if (BASE_B16) { const u32x2v w = *(const u32x2v*)((const bf16_t*)base + off + bj * HALF + n * 16);
                                bs[mm][bj][n] = (f32x4){__builtin_bit_cast(float, w.x << 16), __builtin_bit_cast(float, w.x & 0xffff0000u), __builtin_bit_cast(float, w.y << 16), __builtin_bit_cast(float, w.y & 0xffff0000u)}; }
                            else bs[mm][bj][n] = *(const f32x4*)((const float*)base + off + bj * HALF + n * 16); } }
                asm volatile("" ::: "memory");
#pragma unroll
                for (int mm = 0; mm < 2; ++mm) { const size_t off = (size_t)(u.pm * BM + ai * HALF + wr * 64 + (2 * mp + mm) * 16 + fr) * 1024 + col0;
#pragma unroll
                    for (int bj = 0; bj < 2; ++bj)
#pragma unroll
                        for (int n = 0; n < 2; ++n) { const f32x4 v = bs[mm][bj][n] + gv[bj][n] * acc[ai][bj][2 * mp + mm][n];
                            u32x2v w; w.x = cvt_pk_bf16(v[0], v[1]); w.y = cvt_pk_bf16(v[2], v[3]); *(u32x2v*)(outb + off + bj * HALF + n * 16) = w; } }
                asm volatile("" ::: "memory");
            }
    }
};
__device__ __forceinline__ float dpp_ror1(float v) { return __builtin_bit_cast(float, __builtin_amdgcn_update_dpp(0, __builtin_bit_cast(int, v), 0x121, 0xf, 0xf, false)); }
__device__ __forceinline__ float dpp_shr1z(float v) { return __builtin_bit_cast(float, __builtin_amdgcn_update_dpp(0, __builtin_bit_cast(int, v), 0x111, 0xf, 0xf, true)); }
__device__ __forceinline__ float dpp_shl1z(float v) { return __builtin_bit_cast(float, __builtin_amdgcn_update_dpp(0, __builtin_bit_cast(int, v), 0x101, 0xf, 0xf, true)); }
__device__ __forceinline__ float dpp_rol1(float v) { return __builtin_bit_cast(float, __builtin_amdgcn_update_dpp(0, __builtin_bit_cast(int, v), 0x12f, 0xf, 0xf, false)); }
struct EpiUp {
    static constexpr bool PERM = true, AFTER_DRAIN = false;
    bf16_t* ACT; float* SB; const float* cw; const float* cb;
    __device__ __forceinline__ void operator()(const f32x4 (&acc)[2][2][4][2], const Unit& u, int wr, int wc, int fr, int fq) const {
        const int ff0 = u.pn * 128 + wc * 32 + 8 * fq;
        f32x4 w0a[2], w1a[2], w2a[2], bba[2];
#pragma unroll
        for (int n = 0; n < 2; ++n) { w0a[n] = *(const f32x4*)(cw + ff0 + 4 * n); w1a[n] = *(const f32x4*)(cw + 2816 + ff0 + 4 * n); w2a[n] = *(const f32x4*)(cw + 5632 + ff0 + 4 * n); bba[n] = *(const f32x4*)(cb + ff0 + 4 * n); }
#pragma unroll
        for (int ai = 0; ai < 2; ++ai) {
            const int chunk = 4 * u.pm + 2 * ai + wr, row0 = chunk * 64;
            unsigned pk[4][4];
            float bG[8], bV[8], bC[8];
#pragma unroll
            for (int n = 0; n < 2; ++n) {
                const f32x4 w0 = w0a[n], w1 = w1a[n], w2 = w2a[n], bb = bba[n];
#pragma unroll
                for (int jp = 0; jp < 2; ++jp) {
                    float av[4][2];
#pragma unroll
                    for (int jj = 0; jj < 2; ++jj) {
                        const int j = 2 * jp + jj;
                        const float pm0 = dpp_shr1z(acc[ai][1][3][n][j]), nm3 = dpp_shl1z(acc[ai][1][0][n][j]);
#pragma unroll
                        for (int m = 0; m < 4; ++m) {
                            const float cur = acc[ai][1][m][n][j], val = acc[ai][0][m][n][j];
                            const float pv = (m > 0) ? acc[ai][1][m > 0 ? m - 1 : 0][n][j] : pm0, nx = (m < 3) ? acc[ai][1][m < 3 ? m + 1 : 3][n][j] : nm3;
                            const float gc = w0[j] * pv + w1[j] * cur + w2[j] * nx + bb[j];
                            av[m][jj] = gc * val * __builtin_amdgcn_rcpf(1.f + __builtin_amdgcn_exp2f(-LOG2E * gc));
                            if (m == 0) { bG[4 * n + j] = gc; bV[4 * n + j] = val; bC[4 * n + j] = cur; }
                            if (m == 3) { const bool l = (fr == 15); bG[4 * n + j] = l ? gc : bG[4 * n + j]; bV[4 * n + j] = l ? val : bV[4 * n + j]; bC[4 * n + j] = l ? cur : bC[4 * n + j]; }
                        }
                    }
#pragma unroll
                    for (int m = 0; m < 4; ++m) pk[m][2 * n + jp] = cvt_pk_bf16(av[m][0], av[m][1]);
                }
            }
#pragma unroll
            for (int m = 0; m < 4; ++m) { u32x4 w; w.x = pk[m][0]; w.y = pk[m][1]; w.z = pk[m][2]; w.w = pk[m][3]; store16_wt(ACT + (size_t)(row0 + 4 * fr + m) * 2816 + ff0, w); }
            if (fr == 0 || fr == 15) {
                float* sb = SB + ((size_t)(chunk * 2 + (fr == 15 ? 1 : 0)) * 3) * 2816 + ff0;
#pragma unroll
                for (int n = 0; n < 2; ++n) { *(f32x4*)(sb + 4 * n) = (f32x4){bG[4 * n], bG[4 * n + 1], bG[4 * n + 2], bG[4 * n + 3]}; *(f32x4*)(sb + 2816 + 4 * n) = (f32x4){bV[4 * n], bV[4 * n + 1], bV[4 * n + 2], bV[4 * n + 3]};
                    *(f32x4*)(sb + 5632 + 4 * n) = (f32x4){bC[4 * n], bC[4 * n + 1], bC[4 * n + 2], bC[4 * n + 3]}; }
            }
        }
    }
};
}
using namespace pg8;
#define LAS PG8_LAS
typedef float f32x16 __attribute__((ext_vector_type(16)));
typedef short s16x4 __attribute__((ext_vector_type(4)));
typedef short v4i16_t __attribute__((ext_vector_type(4)));
typedef unsigned u32x2 __attribute__((ext_vector_type(2)));

constexpr int NB = 16, SEQ = 2048, DM = 1024, MTOK = NB * SEQ, NIN = 2304, DFF = 2816, NUP = 5632;
constexpr float EPS = 1e-6f;
constexpr size_t MiB = 1u << 20;
constexpr size_t WS_BAR = 0, BAR_ZERO_BYTES = 16384;
constexpr size_t WS_MOD = 1 * MiB, WS_COS = 2 * MiB, WS_SIN = 2 * MiB + 512 * 1024, WS_WIN = 4 * MiB, WS_WOUT = 10 * MiB, WS_WUP = 12 * MiB, WS_WDN = 24 * MiB;
constexpr size_t WS_H = 32 * MiB, WS_PROJ = 96 * MiB, WS_AO = 240 * MiB, WS_ACT = 96 * MiB  , WS_SB = 304 * MiB, WS_X1B = 346 * MiB, WS_END = 410 * MiB;
static_assert(WS_ACT + (size_t)MTOK * DFF * 2 <= WS_SB && WS_SB + (size_t)512 * 2 * 3 * DFF * 4 <= WS_END, "ws map");
constexpr int LDS_BYTES = 147456, LDS_BARST_OFF = 131072;
constexpr int ATT_BIAS_OFF = 0, ATT_BSTR = 640, ATT_V_OFF = 20480, ATT_VROW = 192, ATT_VBUF = 32 * ATT_VROW, ATT_RED_OFF = ATT_V_OFF + 8 * 2 * ATT_VBUF;
static_assert(ATT_RED_OFF + 2 * 8 * 64 * 4 <= LDS_BYTES, "attention LDS");

__device__ __forceinline__ float wave_sum(float v) {
#pragma unroll
    for (int o = 1; o < 64; o <<= 1) v += __shfl_xor(v, o);
    return v;
}
__device__ __forceinline__ s16x4 vtr(unsigned a) { return __builtin_bit_cast(s16x4, __builtin_amdgcn_ds_read_tr16_b64_v4i16((LAS v4i16_t*)(a))); }
__device__ __forceinline__ f32x16 mfma32(bf16x8 a, bf16x8 b, f32x16 c) { return __builtin_amdgcn_mfma_f32_32x32x16_bf16(a, b, c, 0, 0, 0); }
__device__ __forceinline__ bf16x8 pack8(float a0, float a1, float a2, float a3, float a4, float a5, float a6, float a7) {
    u32x4 w; w.x = cvt_pk_bf16(a0, a1); w.y = cvt_pk_bf16(a2, a3); w.z = cvt_pk_bf16(a4, a5); w.w = cvt_pk_bf16(a6, a7); return __builtin_bit_cast(bf16x8, w);
}
struct NaXf {
    const LAS float* bt; int kc0;
    template <int QUAD> __device__ __forceinline__ void apply(f32x16& s) const {
#pragma unroll
        for (int i = 0; i < 16; ++i) { const int a = i >> 2, b = i & 3, ap = QUAD ? 0 : a, ra = QUAD ? a : 0;
            const float bias = bt[ra * 31 + 8 * ap + b]; const bool ok = (unsigned)(kc0 + 8 * ap + b) < 16u; s[i] = ok ? s[i] + bias : -1e30f; }
    }
};
struct SwXf {
    int mode, ql, h, dq;
    __device__ __forceinline__ void apply(f32x16& s) const {
        {
#pragma unroll
            for (int i = 0; i < 16; ++i) { const int kb = 8 * (i >> 2) + 4 * h + (i & 3); const int d = dq + kb - ql; const bool ok = (d >= -128) && (d <= 128); s[i] = ok ? s[i] : -1e30f; }
        }
    }
};
struct AttnSt { f32x16 o0, o1; float m, l; };
__device__ __forceinline__ void attn_softmax_pv(f32x16& s, AttnSt& st, unsigned vaddr) {
    float mx = s[0];
#pragma unroll
    for (int i = 1; i < 16; ++i) mx = fmaxf(mx, s[i]);
    mx = fmaxf(mx, __shfl_xor(mx, 32));
    const float mn = fmaxf(st.m, mx), al = __builtin_amdgcn_exp2f(st.m - mn); st.m = mn;
    float ps = 0.f;
#pragma unroll
    for (int i = 0; i < 16; ++i) { s[i] = __builtin_amdgcn_exp2f(s[i] - mn); ps += s[i]; }
    st.l = st.l * al + ps; st.o0 = st.o0 * al; st.o1 = st.o1 * al;
    const bf16x8 p0 = pack8(s[0], s[1], s[2], s[3], s[4], s[5], s[6], s[7]), p1 = pack8(s[8], s[9], s[10], s[11], s[12], s[13], s[14], s[15]);
    bf16x8 a[2][2];
#pragma unroll
    for (int db = 0; db < 2; ++db)
#pragma unroll
        for (int ks = 0; ks < 2; ++ks) { const s16x4 lo = vtr(vaddr + ks * 16 * ATT_VROW + db * 64), hi = vtr(vaddr + ks * 16 * ATT_VROW + 8 * ATT_VROW + db * 64);
            a[db][ks] = (bf16x8){lo[0], lo[1], lo[2], lo[3], hi[0], hi[1], hi[2], hi[3]}; }
    st.o0 = mfma32(a[0][0], p0, st.o0); st.o0 = mfma32(a[0][1], p1, st.o0);
    st.o1 = mfma32(a[1][0], p0, st.o1); st.o1 = mfma32(a[1][1], p1, st.o1);
}
struct BlkDesc { int base, hs; };
__device__ __forceinline__ void load_k(bf16x8 (&kf)[4], const bf16_t* proj, int koff, const BlkDesc& d, int ql, int h) {
    const bf16_t* p = proj + (size_t)(d.base + (d.hs ? (ql & 7) + (ql >> 3) * 64 : ql)) * NIN + koff + 32 * h;
#pragma unroll
    for (int kk = 0; kk < 4; ++kk) kf[kk] = *(const bf16x8*)(p + 8 * kk);
}
__device__ __forceinline__ void load_v(u32x4 (&vf)[4], const bf16_t* proj, int voff, const BlkDesc& d, int lane) {
#pragma unroll
    for (int i = 0; i < 4; ++i) { const int x = 8 * i + (lane >> 3); vf[i] = *(const u32x4*)(proj + (size_t)(d.base + (d.hs ? (x & 7) + (x >> 3) * 64 : x)) * NIN + voff + 8 * (lane & 7)); }
}
__device__ __forceinline__ void store_v(LAS unsigned char* vb, const u32x4 (&vf)[4], int lane) {
#pragma unroll
    for (int i = 0; i < 4; ++i) *(LAS u32x4*)(vb + (8 * i + (lane >> 3)) * ATT_VROW + 16 * (lane & 7)) = vf[i];
}

struct UnitId { int valid, swp, b, sub; };
__device__ __forceinline__ UnitId unit_id(int it, int G, int bid) {
    UnitId d; const int u = it * G + bid; d.valid = (u < 1536) ? 1 : 0; const int q3 = u / 3, r3 = u - 3 * q3;
    d.swp = (r3 == 2) ? 1 : 0;
    if (d.swp) { d.b = q3 >> 5; d.sub = q3 & 31; } else { const int idx = q3 * 2 + r3; d.b = idx >> 6; d.sub = idx & 63; }
    return d;
}
struct UnitPre { int valid, tokq, qoff, koff, voff; BlkDesc d0; };
__device__ __forceinline__ UnitPre unit_pre(int it, int G, int bid, int wave, int ql) {
    UnitPre p; const UnitId d = unit_id(it, G, bid); p.valid = d.valid;
    if (!d.swp) { const int r = d.sub >> 1, jp = d.sub & 1, rs = min(max(r - 4, 0), 24);
        p.tokq = d.b * SEQ + r * 64 + 32 * jp + ql; p.qoff = wave * 64; p.koff = 512 + wave * 64; p.voff = 1024 + wave * 64; p.d0.base = d.b * SEQ + rs * 64 + 32 * jp; p.d0.hs = 0; }
    else { const int q0 = 64 * d.sub, kvh = wave >> 2, tlo = max(0, (128 - q0) / 32);
        p.tokq = d.b * SEQ + q0 + ql; p.qoff = 1536 + wave * 64; p.koff = 2048 + kvh * 64; p.voff = 2176 + kvh * 64; p.d0.base = d.b * SEQ + q0 - 128 + 32 * tlo; p.d0.hs = 0; }
    return p;
}
__device__ __forceinline__ f32x16 qk_scores(const bf16x8 (&kf)[4], const bf16x8 (&qf)[4]) {
    f32x16 s;
#pragma unroll
    for (int e = 0; e < 16; ++e) s[e] = 0.f;
#pragma unroll
    for (int kk = 0; kk < 4; ++kk) s = mfma32(kf[kk], qf[kk], s);
    return s;
}
__device__ __forceinline__ float attn_norm_l(AttnSt& st) {
    const float lt = st.l + __shfl_xor(st.l, 32), inv = 1.f / lt;
    float ss = 0.f;
#pragma unroll
    for (int i = 0; i < 16; ++i) { st.o0[i] *= inv; st.o1[i] *= inv; ss += st.o0[i] * st.o0[i] + st.o1[i] * st.o1[i]; }
    return ss + __shfl_xor(ss, 32);
}
__device__ __forceinline__ void attn_store(const AttnSt& st, float rn, bf16_t* op) {
#pragma unroll
    for (int a = 0; a < 4; ++a) {
        u32x2 w0, w1;
        w0.x = cvt_pk_bf16(st.o0[4 * a] * rn, st.o0[4 * a + 1] * rn); w0.y = cvt_pk_bf16(st.o0[4 * a + 2] * rn, st.o0[4 * a + 3] * rn);
        w1.x = cvt_pk_bf16(st.o1[4 * a] * rn, st.o1[4 * a + 1] * rn); w1.y = cvt_pk_bf16(st.o1[4 * a + 2] * rn, st.o1[4 * a + 3] * rn);
        *(u32x2*)(op + 8 * a) = w0; *(u32x2*)(op + 32 + 8 * a) = w1;
    }
}
__device__ __forceinline__ void attn_phase(LAS unsigned char* lds, const bf16_t* __restrict__ proj, bf16_t* __restrict__ ao, const float* __restrict__ rpb, const float* __restrict__ sink) {
    const int tid = threadIdx.x, wave = __builtin_amdgcn_readfirstlane(tid >> 6), lane = tid & 63, ql = lane & 31, h = lane >> 5;
    const int G = gridDim.x, bid = blockIdx.x;
    LAS float* btab = (LAS float*)(lds + ATT_BIAS_OFF);
    LAS unsigned char* vbuf = lds + ATT_V_OFF + wave * 2 * ATT_VBUF;
    LAS float* red = (LAS float*)(lds + ATT_RED_OFF);
    bf16x8 qf[4], kf[4], kn[4]; u32x4 vf[4];
    { const UnitPre p = unit_pre(0, G, bid, wave, ql);
      if (p.valid) {
#pragma unroll
          for (int kk = 0; kk < 4; ++kk) qf[kk] = *(const bf16x8*)(proj + (size_t)p.tokq * NIN + p.qoff + 32 * h + 8 * kk);
          load_k(kf, proj, p.koff, p.d0, ql, h); load_v(vf, proj, p.voff, p.d0, lane); } }
#pragma unroll
    for (int i0 = 0; i0 < 8 * ATT_BSTR; i0 += 512) { const int i = i0 + tid, hh = i / ATT_BSTR, j = i % ATT_BSTR - 64; const bool okb = (j >= 0 && j < 465); const float v = rpb[okb ? hh * 465 + j : 0]; btab[i] = okb ? v * LOG2E : 0.f; }
    __syncthreads();
    const int g4 = lane >> 4, i16 = lane & 15;
    const unsigned trb = (unsigned)((4 * (g4 >> 1) + (i16 >> 2)) * ATT_VROW + (16 * (g4 & 1) + 4 * (i16 & 3)) * 2);
    const unsigned vb0 = (unsigned)(size_t)vbuf;
    for (int it = 0;; ++it) {
        const UnitId ud = unit_id(it, G, bid); if (!ud.valid) break;
        const int b = ud.b, sub = ud.sub;
        AttnSt st, stB;
#pragma unroll
        for (int i = 0; i < 16; ++i) { st.o0[i] = 0.f; st.o1[i] = 0.f; stB.o0[i] = 0.f; stB.o1[i] = 0.f; }
        stB.m = 0.f; stB.l = 1.f;
        int tokq, goff;
        store_v(vbuf, vf, lane);
        if (!ud.swp) {
            const int r = sub >> 1, jp = sub & 1, rs = min(max(r - 4, 0), 24), qcol = 32 * jp + ql, cs = min(max(qcol - 8, 0), 48), cq0 = jp ? 24 : 32;
            tokq = b * SEQ + r * 64 + qcol; goff = 0;
            const int koff = 512 + wave * 64, voff = 1024 + wave * 64;
            st.m = -1e30f; st.l = 0.f;
            const LAS float* bt0 = btab + wave * ATT_BSTR + 64;
            auto desc = [&](int i) { BlkDesc d; if (i < 8) { d.base = b * SEQ + (rs + i) * 64 + 32 * jp; d.hs = 0; } else { d.base = b * SEQ + (rs + 4 * (i - 8)) * 64 + cq0; d.hs = 1; } return d; };
            for (int i = 0; i < 10; ++i) {
                if (i + 1 < 10) { const BlkDesc d = desc(i + 1); load_k(kn, proj, koff, d, ql, h); load_v(vf, proj, voff, d, lane); }
                f32x16 s = qk_scores(kf, qf);
                if (i < 8) { const int R = rs + i, c0 = 32 * jp; NaXf xf{bt0 + (R - r + 7) * 31 + (c0 + 4 * h - qcol + 15), c0 + 4 * h - cs}; xf.apply<0>(s); }
                else { const int R = rs + 4 * (i - 8); NaXf xf{bt0 + (R - r + 7) * 31 + (cq0 + 4 * h - qcol + 15), cq0 + 4 * h - cs}; xf.apply<1>(s); }
                attn_softmax_pv(s, st, vb0 + (unsigned)((i & 1) * ATT_VBUF) + trb);
                if (i + 1 < 10) { store_v(vbuf + ((i + 1) & 1) * ATT_VBUF, vf, lane);
#pragma unroll
                    for (int kk = 0; kk < 4; ++kk) kf[kk] = kn[kk]; }
            }
        } else {
            const int q0 = 64 * sub; tokq = b * SEQ + q0 + ql; goff = 512;
            const int kvh = wave >> 2, koff = 2048 + kvh * 64, voff = 2176 + kvh * 64;
            bf16x8 qB[4];
#pragma unroll
            for (int kk = 0; kk < 4; ++kk) qB[kk] = *(const bf16x8*)(proj + (size_t)(tokq + 32) * NIN + 1536 + wave * 64 + 32 * h + 8 * kk);
            st.m = sink[wave] * LOG2E; st.l = (h == 0) ? 1.f : 0.f; stB.m = st.m; stB.l = st.l;
            const int tlo = max(0, (128 - q0) / 32), thi = min(9, (SEQ - 1 - (q0 - 128)) / 32);
            for (int t = tlo, i = 0; t <= thi; ++t, ++i) {
                if (t + 1 <= thi) { BlkDesc d; d.base = b * SEQ + q0 - 128 + 32 * (t + 1); d.hs = 0; load_k(kn, proj, koff, d, ql, h); load_v(vf, proj, voff, d, lane); }
                const unsigned va = vb0 + (unsigned)((i & 1) * ATT_VBUF) + trb;
                if (t <= 8) { f32x16 s = qk_scores(kf, qf); if (t == 0 || t == 8) { SwXf xf{0, ql, h, 32 * t - 128}; xf.apply(s); } attn_softmax_pv(s, st, va); }
                if (t >= 1) { f32x16 s = qk_scores(kf, qB); if (t == 1 || t == 9) { SwXf xf{0, ql, h, 32 * t - 160}; xf.apply(s); } attn_softmax_pv(s, stB, va); }
                if (t + 1 <= thi) { store_v(vbuf + ((i + 1) & 1) * ATT_VBUF, vf, lane);
#pragma unroll
                    for (int kk = 0; kk < 4; ++kk) kf[kk] = kn[kk]; }
            }
        }
        bf16x8 qn[4];
        const UnitPre pn = unit_pre(it + 1, G, bid, wave, ql);
        if (pn.valid) {
#pragma unroll
            for (int kk = 0; kk < 4; ++kk) qn[kk] = *(const bf16x8*)(proj + (size_t)pn.tokq * NIN + pn.qoff + 32 * h + 8 * kk);
            load_k(kn, proj, pn.koff, pn.d0, ql, h); load_v(vf, proj, pn.voff, pn.d0, lane); }
        const float ssA = attn_norm_l(st), ssB = ud.swp ? attn_norm_l(stB) : 0.f;
        LAS float* rp = red + (it & 1) * 512;
        if (h == 0) { rp[wave * 64 + ql] = ssA; rp[wave * 64 + 32 + ql] = ssB; }
        __syncthreads();
        float totA = 0.f, totB = 0.f;
#pragma unroll
        for (int w = 0; w < 8; ++w) { totA += rp[w * 64 + ql]; totB += rp[w * 64 + 32 + ql]; }
        bf16_t* op = ao + (size_t)tokq * DM + goff + wave * 64 + 4 * h;
        attn_store(st, 1.f / sqrtf(totA * (1.f / 512.f) + EPS), op);
        if (ud.swp) attn_store(stB, 1.f / sqrtf(totB * (1.f / 512.f) + EPS), op + (size_t)32 * DM);
        if (pn.valid) {
#pragma unroll
            for (int kk = 0; kk < 4; ++kk) { qf[kk] = qn[kk]; kf[kk] = kn[kk]; } }
    }
    __syncthreads();
}

#define XB_TMO      128
#define XB_XCNT(j)  (256  + 64 * (j))
#define XB_XSUB(j)  (1280 + 64 * (j))
#define XB_XGEN(j)  (2304 + 64 * (j))
#define XB_TOP      3328
#define XB_TOPGEN   3392
#define XCD_BAR_WORDS 3456
#define XB_SPIN_CAP (1u << 18)

__device__ __forceinline__ unsigned xb_ld(unsigned* p)              { return __hip_atomic_load(p, __ATOMIC_RELAXED, __HIP_MEMORY_SCOPE_AGENT); }
__device__ __forceinline__ unsigned xb_add(unsigned* p, unsigned v) { return __hip_atomic_fetch_add(p, v, __ATOMIC_RELAXED, __HIP_MEMORY_SCOPE_AGENT); }
__device__ __forceinline__ unsigned xb_xcc_id() { return (unsigned)__builtin_amdgcn_s_getreg((3 << 11) | 20) & 0xFu; }
#define XB_SPIN(cond, bar) do { unsigned _sp = 0; while (cond) { __builtin_amdgcn_s_sleep(1); \
    if ((++_sp & 255u) == 0u) { if (xb_ld(&(bar)[XB_TMO])) break; if (_sp > XB_SPIN_CAP) { atomicAdd(&(bar)[XB_TMO], 1u); break; } } } } while (0)

struct XcdBarrier {
    unsigned* bar; unsigned x;
    volatile LAS unsigned* st;
};

__device__ __forceinline__ XcdBarrier xcd_barrier_post(unsigned* bar, volatile LAS unsigned* st) {
    XcdBarrier b; b.bar = bar; b.x = xb_xcc_id(); b.st = st;
    if (threadIdx.x == 0) (void)xb_add(&bar[XB_XCNT(b.x)], 1u);
    return b;
}
__device__ __forceinline__ void xcd_barrier_complete(unsigned* bar, unsigned x, unsigned& nloc, unsigned& nx) {
    const unsigned G = gridDim.x * gridDim.y * gridDim.z;
    unsigned sum, cnt, mine, sp = 0u;
    for (;;) {
        sum = 0u; cnt = 0u; mine = 0u;
#pragma unroll
        for (unsigned j = 0; j < 16; ++j) { const unsigned c = xb_ld(&bar[XB_XCNT(j)]); sum += c; cnt += (c > 0u) ? 1u : 0u; mine = (j == x) ? c : mine; }
        if (sum == G) break;
        __builtin_amdgcn_s_sleep(1);
        if ((++sp & 255u) == 0u) { if (xb_ld(&bar[XB_TMO])) break; if (sp > XB_SPIN_CAP) { atomicAdd(&bar[XB_TMO], 1u); break; } }
    }
    nloc = mine > 0u ? mine : 1u; nx = cnt > 0u ? cnt : 1u;
}

__device__ __forceinline__ void xcd_barrier(const XcdBarrier& b) {
    asm volatile("s_waitcnt vmcnt(0)" ::: "memory");
    __syncthreads();
    if (threadIdx.x == 0) {
        unsigned* bar = b.bar;
        __builtin_amdgcn_s_waitcnt(0);
        unsigned nloc = b.st[0], nx = b.st[1];
        if (nloc == 0u) { xcd_barrier_complete(bar, b.x, nloc, nx); b.st[0] = nloc; b.st[1] = nx; }
        const unsigned old = xb_add(&bar[XB_XSUB(b.x)], 1u);
        const unsigned gen = old / nloc;
        if (old + 1u == (gen + 1u) * nloc) {
            __builtin_amdgcn_fence(__ATOMIC_RELEASE, "agent");
            asm volatile("s_waitcnt vmcnt(0)" ::: "memory");
            const unsigned og = xb_add(&bar[XB_TOP], 1u);
            const unsigned tg = og / nx;
            if (og + 1u == (tg + 1u) * nx) xb_add(&bar[XB_TOPGEN], 1u);
            else XB_SPIN(xb_ld(&bar[XB_TOPGEN]) == tg, bar);
            __builtin_amdgcn_fence(__ATOMIC_ACQUIRE, "agent");
            xb_add(&bar[XB_XGEN(b.x)], 1u);
            asm volatile("s_waitcnt vmcnt(0)" ::: "memory");
        } else {
            XB_SPIN(xb_ld(&bar[XB_XGEN(b.x)]) == gen, bar);
            __builtin_amdgcn_fence(__ATOMIC_ACQUIRE, "agent");
            asm volatile("s_waitcnt vmcnt(0)" ::: "memory");
        }
    }
    __syncthreads();
}


__device__ __forceinline__ unsigned f2bf(float f) { unsigned u = __builtin_bit_cast(unsigned, f); return (u + 0x7fffu + ((u >> 16) & 1u)) >> 16; }
__device__ __forceinline__ unsigned pk2(float lo, float hi) { return f2bf(lo) | (f2bf(hi) << 16); }
template <int MAP> __device__ __forceinline__ int rowmap(int n) {
    if (MAP == 1) { if (n < 1536 || n >= 2176) return n; const int e = n - 1536, hh = e >> 6, d = e & 63, dd = d & 31, Gq = dd >> 2, i = dd & 3; return 1536 + 64 * hh + 8 * Gq + (d >= 32 ? 4 : 0) + i; }
    if (MAP == 2) { const int g = (n >= DFF) ? 1 : 0, ff = n - g * DFF; return 256 * (ff >> 7) + 128 * g + (ff & 127); }
    return n;
}
template <int MAP> __device__ __forceinline__ void transpose_item(const float* __restrict__ W, int K, int N, bf16_t* __restrict__ WT, const float* __restrict__ kscale, LAS float* scr, int item, int lane) {
    const int nblk = N / 32, kb = item / nblk, nb = item % nblk, k0 = 64 * kb, n0 = 32 * nb;
#pragma unroll
    for (int i = 0; i < 32; ++i) { const int kk = 2 * i + (lane >> 5); float v = W[(size_t)(k0 + kk) * N + n0 + (lane & 31)]; if (kscale) v *= kscale[k0 + kk]; scr[kk * 33 + (lane & 31)] = v; }
    asm volatile("s_waitcnt lgkmcnt(0)" ::: "memory");
    const int c = lane & 7;
#pragma unroll
    for (int j = 0; j < 4; ++j) { const int n = (lane >> 3) + 8 * j; const LAS float* s = scr + (8 * c) * 33 + n;
        u32x4 o; o.x = pk2(s[0 * 33], s[1 * 33]); o.y = pk2(s[2 * 33], s[3 * 33]); o.z = pk2(s[4 * 33], s[5 * 33]); o.w = pk2(s[6 * 33], s[7 * 33]);
        *(u32x4*)(WT + (size_t)rowmap<MAP>(n0 + n) * K + k0 + 8 * c) = o; }
    asm volatile("s_waitcnt lgkmcnt(0)" ::: "memory");
}
struct CvItem { const float* W; bf16_t* WT; const float* ks; int K, N, map, item; };
__device__ __forceinline__ void cv_load(float (&v)[32], const CvItem& c, int lane) {
    const int nblk = c.N / 32, kb = c.item / nblk, nb = c.item - kb * nblk, k0 = 64 * kb, n0 = 32 * nb;
    const float* p = c.W + (size_t)(k0 + (lane >> 5)) * c.N + n0 + (lane & 31);
#pragma unroll
    for (int i = 0; i < 32; ++i) v[i] = p[(size_t)(2 * i) * c.N];
}
__device__ __forceinline__ void cv_finish(const float (&v)[32], const CvItem& c, LAS float* scr, int lane) {
    const int nblk = c.N / 32, kb = c.item / nblk, nb = c.item - kb * nblk, k0 = 64 * kb, n0 = 32 * nb;
    if (c.ks) {
#pragma unroll
        for (int i = 0; i < 32; ++i) { const int kk = 2 * i + (lane >> 5); scr[kk * 33 + (lane & 31)] = v[i] * c.ks[k0 + kk]; } }
    else {
#pragma unroll
        for (int i = 0; i < 32; ++i) { const int kk = 2 * i + (lane >> 5); scr[kk * 33 + (lane & 31)] = v[i]; } }
    asm volatile("s_waitcnt lgkmcnt(0)" ::: "memory");
    const int cc = lane & 7;
#pragma unroll
    for (int j = 0; j < 4; ++j) { const int n = (lane >> 3) + 8 * j; const LAS float* sp = scr + (8 * cc) * 33 + n;
        u32x4 o; o.x = pk2(sp[0 * 33], sp[1 * 33]); o.y = pk2(sp[2 * 33], sp[3 * 33]); o.z = pk2(sp[4 * 33], sp[5 * 33]); o.w = pk2(sp[6 * 33], sp[7 * 33]);
        const int nn = n0 + n, row = (c.map == 1) ? rowmap<1>(nn) : ((c.map == 2) ? rowmap<2>(nn) : nn);
        *(u32x4*)(c.WT + (size_t)row * c.K + k0 + 8 * cc) = o; }
    asm volatile("s_waitcnt lgkmcnt(0)" ::: "memory");
}
template <int MODE> __device__ __forceinline__ void row_phase(const float* src, bf16_t* dst, float* io, const float* __restrict__ g, const float* __restrict__ mod, int shift_off, int scale_off) {
    const int lane = threadIdx.x & 63, gw = blockIdx.x * 8 + (threadIdx.x >> 6), NGW = gridDim.x * 8, rpw = MTOK / NGW, m_beg = gw * rpw, m_end = (gw == NGW - 1) ? MTOK : m_beg + rpw;
    const float* base = (MODE == 0) ? src : io;
    for (int m0 = m_beg; m0 < m_end; m0 += 4) {
        f32x4 cur[4][4];
#pragma unroll
        for (int r = 0; r < 4; ++r)
#pragma unroll
            for (int j = 0; j < 4; ++j) cur[r][j] = ((const f32x4*)(base + (size_t)min(m0 + r, MTOK - 1) * DM) + lane)[64 * j];
        const int b = m0 >> 11;
        f32x4 gv[4], sc[4], sh[4];
#pragma unroll
        for (int j = 0; j < 4; ++j) { const int c = 4 * lane + 256 * j; gv[j] = *(const f32x4*)(g + c);
            if (MODE == 0) { sc[j] = *(const f32x4*)(mod + b * 6144 + scale_off + c) + 1.f; sh[j] = *(const f32x4*)(mod + b * 6144 + shift_off + c); } }
        float ss[4];
#pragma unroll
        for (int r = 0; r < 4; ++r) { ss[r] = 0.f;
#pragma unroll
            for (int j = 0; j < 4; ++j) { const f32x4 v = cur[r][j]; ss[r] += (v.x * v.x + v.y * v.y) + (v.z * v.z + v.w * v.w); } }
#pragma unroll
        for (int o = 1; o < 64; o <<= 1) {
#pragma unroll
            for (int r = 0; r < 4; ++r) ss[r] += __shfl_xor(ss[r], o); }
#pragma unroll
        for (int r = 0; r < 4; ++r) {
            const int m = m0 + r; if (m >= m_end) break;
            const float rstd = 1.f / sqrtf(ss[r] * (1.f / DM) + EPS);
            if (MODE == 0) { unsigned long long* o8 = (unsigned long long*)(dst + (size_t)m * DM) + lane;
#pragma unroll
                for (int j = 0; j < 4; ++j) { const f32x4 y = cur[r][j] * rstd * gv[j] * sc[j] + sh[j]; o8[64 * j] = (unsigned long long)(cvt_pk_bf16(y.x, y.y)) | ((unsigned long long)cvt_pk_bf16(y.z, y.w) << 32); } }
            else { f32x4* xr = (f32x4*)(io + (size_t)m * DM) + lane;
#pragma unroll
                for (int j = 0; j < 4; ++j) xr[64 * j] = cur[r][j] * rstd * gv[j]; }
        }
    }
}
template <int MODE> __device__ __forceinline__ void row_phase_b16(const bf16_t* src, bf16_t* dst, float* outf, const float* __restrict__ g, const float* __restrict__ mod, int shift_off, int scale_off) {
    const int lane = threadIdx.x & 63, gw = blockIdx.x * 8 + (threadIdx.x >> 6), NGW = gridDim.x * 8, rpw = MTOK / NGW, m_beg = gw * rpw, m_end = (gw == NGW - 1) ? MTOK : m_beg + rpw;
    for (int m0 = m_beg; m0 < m_end; m0 += 4) {
        u32x4 raw[4][2];
#pragma unroll
        for (int r = 0; r < 4; ++r) { const bf16_t* p = src + (size_t)min(m0 + r, MTOK - 1) * DM + 8 * lane; raw[r][0] = *(const u32x4*)p; raw[r][1] = *(const u32x4*)(p + 512); }
        const int b = m0 >> 11;
        f32x4 gv[4], sc[4], sh[4];
#pragma unroll
        for (int j = 0; j < 4; ++j) { const int c = (j >> 1) * 512 + 8 * lane + 4 * (j & 1); gv[j] = *(const f32x4*)(g + c);
            if (MODE == 0) { sc[j] = *(const f32x4*)(mod + b * 6144 + scale_off + c) + 1.f; sh[j] = *(const f32x4*)(mod + b * 6144 + shift_off + c); } }
        f32x4 cur[4][4]; float ss[4];
#pragma unroll
        for (int r = 0; r < 4; ++r) { ss[r] = 0.f;
#pragma unroll
            for (int j = 0; j < 4; ++j) { const unsigned w0 = raw[r][j >> 1][2 * (j & 1)], w1 = raw[r][j >> 1][2 * (j & 1) + 1];
                const f32x4 v = (f32x4){__builtin_bit_cast(float, w0 << 16), __builtin_bit_cast(float, w0 & 0xffff0000u), __builtin_bit_cast(float, w1 << 16), __builtin_bit_cast(float, w1 & 0xffff0000u)};
                cur[r][j] = v; ss[r] += (v.x * v.x + v.y * v.y) + (v.z * v.z + v.w * v.w); } }
#pragma unroll
        for (int o = 1; o < 64; o <<= 1) {
#pragma unroll
            for (int r = 0; r < 4; ++r) ss[r] += __shfl_xor(ss[r], o); }
#pragma unroll
        for (int r = 0; r < 4; ++r) {
            const int m = m0 + r; if (m >= m_end) break;
            const float rstd = 1.f / sqrtf(ss[r] * (1.f / DM) + EPS);
            if (MODE == 0) {
#pragma unroll
                for (int hf = 0; hf < 2; ++hf) { const f32x4 y0 = cur[r][2 * hf] * rstd * gv[2 * hf] * sc[2 * hf] + sh[2 * hf], y1 = cur[r][2 * hf + 1] * rstd * gv[2 * hf + 1] * sc[2 * hf + 1] + sh[2 * hf + 1];
                    u32x4 w; w.x = cvt_pk_bf16(y0.x, y0.y); w.y = cvt_pk_bf16(y0.z, y0.w); w.z = cvt_pk_bf16(y1.x, y1.y); w.w = cvt_pk_bf16(y1.z, y1.w);
                    *(u32x4*)(dst + (size_t)m * DM + hf * 512 + 8 * lane) = w; } }
            else {
#pragma unroll
                for (int j = 0; j < 4; ++j) *(f32x4*)(outf + (size_t)m * DM + (j >> 1) * 512 + 8 * lane + 4 * (j & 1)) = cur[r][j] * rstd * gv[j]; }
        }
    }
}
__device__ __forceinline__ void fixup_panel(int pm, const float* __restrict__ SB, bf16_t* ACT, const float* __restrict__ cw) {
    constexpr int NITEM = 8 * (DFF / 4);
#pragma unroll 1
    for (int e0 = threadIdx.x; e0 < NITEM; e0 += 4 * 512) {
        f32x4 gc[4], val[4], nbr[4], wv[4];
#pragma unroll
        for (int q = 0; q < 4; ++q) {
            const int e = min(e0 + q * 512, NITEM - 1), rr = e / (DFF / 4), c4 = (e % (DFF / 4)) * 4, chunk = 4 * pm + (rr >> 1), which = rr & 1;
            const float* sb = SB + ((size_t)(chunk * 2 + which) * 3) * DFF + c4;
            gc[q] = *(const f32x4*)sb; val[q] = *(const f32x4*)(sb + DFF);
            const bool has = which == 0 ? ((chunk & 31) != 0) : ((chunk & 31) != 31);
            const int nchunk = has ? (which == 0 ? chunk - 1 : chunk + 1) : chunk;
            nbr[q] = *(const f32x4*)(SB + ((size_t)(nchunk * 2 + (which ^ 1)) * 3 + 2) * DFF + c4);
            wv[q] = *(const f32x4*)(cw + (which == 0 ? 0 : 2 * DFF) + c4);
            if (!has) wv[q] = (f32x4){0.f, 0.f, 0.f, 0.f};
        }
#pragma unroll
        for (int q = 0; q < 4; ++q) {
            const int e = e0 + q * 512; if (e >= NITEM) break;
            const int rr = e / (DFF / 4), c4 = (e % (DFF / 4)) * 4, chunk = 4 * pm + (rr >> 1), which = rr & 1;
            const f32x4 g2 = gc[q] + wv[q] * nbr[q];
            float a[4];
#pragma unroll
            for (int j = 0; j < 4; ++j) a[j] = g2[j] * val[q][j] * __builtin_amdgcn_rcpf(1.f + __builtin_amdgcn_exp2f(-LOG2E * g2[j]));
            u32x2 w; w.x = cvt_pk_bf16(a[0], a[1]); w.y = cvt_pk_bf16(a[2], a[3]);
            *(u32x2*)(ACT + (size_t)(chunk * 64 + which * 63) * DFF + c4) = w;
        }
    }
}

struct Args { const float* in[17]; float* out; unsigned char* ws; int ph_lo, ph_hi; };
static_assert(sizeof(Args) == 17 * 8 + 8 + 8 + 8, "Args has no padding");

__global__ void __launch_bounds__(512, 2) fwd_megakernel(Args args) {
    extern __shared__ __attribute__((aligned(16))) unsigned char lds_raw[];
    LAS unsigned char* lds = (LAS unsigned char*)lds_raw;
    cg::grid_group grid = cg::this_grid();
    const int tid = threadIdx.x, wave = __builtin_amdgcn_readfirstlane(tid >> 6), lane = tid & 63, G = gridDim.x, bid = blockIdx.x;
    const float* x = args.in[0]; const float* cvec = args.in[1]; const float* w_ada = args.in[2]; const float* b_ada = args.in[3]; const float* g_attn = args.in[4];
    const float* w_in = args.in[5]; const float* rpb = args.in[6]; const float* sink = args.in[7]; const float* g_na = args.in[8]; const float* g_sw = args.in[9];
    const float* w_out = args.in[10]; const float* g_ffn = args.in[11]; const float* w_up = args.in[12]; const float* conv_w = args.in[13]; const float* conv_b = args.in[14];
    const float* w_down = args.in[15]; const float* g_final = args.in[16];
    unsigned char* ws = args.ws; float* out = args.out;
    float* mod = (float*)(ws + WS_MOD); float* costab = (float*)(ws + WS_COS); float* sintab = (float*)(ws + WS_SIN);
    bf16_t* Win = (bf16_t*)(ws + WS_WIN); bf16_t* Wout = (bf16_t*)(ws + WS_WOUT); bf16_t* Wup = (bf16_t*)(ws + WS_WUP); bf16_t* Wdn = (bf16_t*)(ws + WS_WDN);
    bf16_t* H = (bf16_t*)(ws + WS_H); bf16_t* PROJ = (bf16_t*)(ws + WS_PROJ); bf16_t* AO = (bf16_t*)(ws + WS_AO); bf16_t* ACT = (bf16_t*)(ws + WS_ACT); float* SB = (float*)(ws + WS_SB); bf16_t* X1B = (bf16_t*)(ws + WS_X1B);
    const int lo = args.ph_lo, hi = args.ph_hi;
    volatile LAS unsigned* barst = (volatile LAS unsigned*)(lds + LDS_BARST_OFF);
    if (tid < 2) barst[tid] = 0u;
    __syncthreads();
    XcdBarrier xbar = xcd_barrier_post((unsigned*)(ws + WS_BAR), barst);
#define IN(k) (lo <= (k) && (k) < hi)
#define SEAM(k) do { if (IN(k) && IN((k) + 1)) { if (args.ph_hi > 1000) grid.sync(); else xcd_barrier(xbar); } } while (0)

    if (IN(0)) {
        {
            const int gi = bid * 512 + tid;
            for (int e = gi; e < SEQ * 32; e += G * 512) { const int pos = e >> 5, f = e & 31;
                const float inv = powf(10000.f, -(float)f / 32.f); const float ang = (float)pos * inv;
                costab[e] = cosf(ang); sintab[e] = sinf(ang); }
        }
        if (bid < 192) {
            LAS float* sc = (LAS float*)lds; LAS float* red = (LAS float*)(lds + 65536);
#pragma unroll 8
            for (int i = tid; i < NB * DM; i += 512) { const float v = cvec[i]; sc[i] = v / (1.f + __expf(-v)); }
            __syncthreads();
            const int n0 = 32 * bid, col = lane & 31, par = lane >> 5;
            float acc[16];
#pragma unroll
            for (int b = 0; b < 16; ++b) acc[b] = 0.f;
            const float* wp = w_ada + n0 + col;
#pragma unroll 8
            for (int kk = 0; kk < 64; ++kk) { const int k = wave * 128 + kk * 2 + par; const float w = wp[(size_t)k * 6144];
#pragma unroll
                for (int b = 0; b < 16; ++b) acc[b] += sc[b * DM + k] * w; }
#pragma unroll
            for (int b = 0; b < 16; ++b) red[((wave * 2 + par) * 16 + b) * 32 + col] = acc[b];
            __syncthreads();
            { const int b = tid >> 5, cc = tid & 31; float s = b_ada[n0 + cc];
#pragma unroll
              for (int g = 0; g < 16; ++g) s += red[(g * 16 + b) * 32 + cc];
              mod[b * 6144 + n0 + cc] = s; }
            __syncthreads();
        }
        {
            LAS float* scr = (LAS float*)(lds + wave * 16384);
            constexpr int I_IN = (DM / 64) * (NIN / 32), I_OUT = (DM / 64) * (DM / 32), I_UP = (DM / 64) * (NUP / 32), I_DN = (DFF / 64) * (DM / 32);
            const bool late_up = (G == 256);
            const int nit = I_IN + I_OUT + I_DN + (late_up ? 0 : I_UP);
            int first, step, lim;
            if (late_up) { if (bid >= 192) { first = (bid - 192) * 8 + wave; step = 512; lim = nit; } else { first = 0; step = 1; lim = 0; } }
            else { first = bid * 8 + wave; step = G * 8; lim = nit; }
            auto mk = [&](int it) { CvItem c; int r = it;
                if (r < I_IN) { c.W = w_in; c.WT = Win; c.ks = nullptr; c.K = DM; c.N = NIN; c.map = 1; c.item = r; return c; } r -= I_IN;
                if (r < I_OUT) { const int kb = r / (DM / 32); c.W = w_out; c.WT = Wout; c.ks = (kb < 8) ? g_na : (g_sw - 512); c.K = DM; c.N = DM; c.map = 0; c.item = r; return c; } r -= I_OUT;
                if (r < I_DN) { c.W = w_down; c.WT = Wdn; c.ks = nullptr; c.K = DFF; c.N = DM; c.map = 0; c.item = r; return c; } r -= I_DN;
                c.W = w_up; c.WT = Wup; c.ks = nullptr; c.K = DM; c.N = NUP; c.map = 2; c.item = r; return c; };
            if (first < lim) {
                float va[32], vb[32];
                CvItem ca = mk(first), cb = ca; cv_load(va, ca, lane);
#pragma unroll 1
                for (int it = first;;) {
                    const int i1 = it + step; const bool m1 = i1 < lim;
                    if (m1) { cb = mk(i1); cv_load(vb, cb, lane); }
                    cv_finish(va, ca, scr, lane);
                    if (!m1) break;
                    const int i2 = i1 + step; const bool m2 = i2 < lim;
                    if (m2) { ca = mk(i2); cv_load(va, ca, lane); }
                    cv_finish(vb, cb, scr, lane);
                    if (!m2) break;
                    it = i2;
                }
            }
        }
    }
    SEAM(0);
    if (IN(1)) row_phase<0>(x, H, nullptr, g_attn, mod, 0, 1024);
    SEAM(1);
    if (IN(2)) {
        Gemm g{H, Win, MTOK, NIN, DM}; StaticOrder S; S.init(MTOK, NIN, G, bid);
        EpiIn E{PROJ, costab, sintab};
        gemm_phase<EpiIn, StaticOrder, true, true>(lds, g, S, E);
        if (G == 256 && bid >= 128) {
            __syncthreads();
            LAS float* scr = (LAS float*)(lds + wave * 16384);
            constexpr int I_UPc = (DM / 64) * (NUP / 32);
            float va[32], vb[32];
            CvItem ca{w_up, Wup, nullptr, DM, NUP, 2, (bid - 128) * 8 + wave}, cb = ca;
            cv_load(va, ca, lane);
#pragma unroll 1
            for (;;) {
                const bool m1 = ca.item + 1024 < I_UPc;
                if (m1) { cb.item = ca.item + 1024; cv_load(vb, cb, lane); }
                cv_finish(va, ca, scr, lane);
                if (!m1) break;
                const bool m2 = cb.item + 1024 < I_UPc;
                if (m2) { ca.item = cb.item + 1024; cv_load(va, ca, lane); }
                cv_finish(vb, cb, scr, lane);
                if (!m2) break;
            }
        }
    }
    SEAM(2);
    if (IN(3)) attn_phase(lds, PROJ, AO, rpb, sink);
    SEAM(3);
    if (IN(4)) {
        Gemm g{AO, Wout, MTOK, DM, DM}; StaticOrder S; S.init(MTOK, DM, G, bid);
        EpiResB<false> E{x, X1B, mod + 2048};
        gemm_phase<EpiResB<false>, StaticOrder, true, true>(lds, g, S, E);
    }
    SEAM(4);
    if (IN(5)) row_phase_b16<0>(X1B, H, nullptr, g_ffn, mod, 3072, 4096);
    SEAM(5);
    if (IN(6)) {
        Gemm g{H, Wup, MTOK, NUP, DM}; StaticOrder S; S.init(MTOK, NUP, G, bid);
        EpiUp E{ACT, SB, conv_w, conv_b};
        gemm_phase<EpiUp, StaticOrder, true, true, true>(lds, g, S, E);
    }
    SEAM(6);
    if (IN(7)) {
        StaticOrder S; S.init(MTOK, DM, G, bid);
        { Unit u; for (int i = 0; S.next(i, u); ++i) fixup_panel(u.pm, SB, ACT, conv_w); }
        __threadfence(); __syncthreads();
        Gemm g{ACT, Wdn, MTOK, DM, DFF};
        EpiResB<true> E{X1B, X1B, mod + 5120};
        gemm_phase<EpiResB<true>, StaticOrder, true, true>(lds, g, S, E);
    }
    SEAM(7);
    if (IN(8)) row_phase_b16<1>(X1B, nullptr, out, g_final, nullptr, 0, 0);
#undef IN
#undef SEAM
}

#ifndef N_LAUNCH_SPLIT
#define N_LAUNCH_SPLIT 0
#endif
extern "C" void kernel_launch(void* const* d_in, const int* in_sizes, int n_in, void* d_out, int out_size, void* d_ws, size_t ws_size, hipStream_t stream) {
    static int grid_blocks = 0;
    if (grid_blocks == 0) {
        if (n_in != 17 || out_size != MTOK * DM || ws_size < WS_END) { fprintf(stderr, "kernel_launch: unexpected shapes (n_in %d out %d ws %zu)\n", n_in, out_size, ws_size); grid_blocks = -1; return; }
        int dev = 0, cus = 0, per_cu = 0;
        hipGetDevice(&dev); hipDeviceGetAttribute(&cus, hipDeviceAttributeMultiprocessorCount, dev);
        if (hipFuncSetAttribute((const void*)fwd_megakernel, hipFuncAttributeMaxDynamicSharedMemorySize, LDS_BYTES) != hipSuccess) { fprintf(stderr, "kernel_launch: hipFuncSetAttribute failed\n"); grid_blocks = -1; return; }
        if (hipOccupancyMaxActiveBlocksPerMultiprocessor(&per_cu, (const void*)fwd_megakernel, 512, LDS_BYTES) != hipSuccess || per_cu < 1) { fprintf(stderr, "kernel_launch: occupancy query failed (%d)\n", per_cu); per_cu = 1; (void)hipGetLastError(); }
        grid_blocks = cus * per_cu; if (grid_blocks > 256) grid_blocks = 256;
        fprintf(stderr, "kernel_launch: %d CUs x %d blocks -> grid %d\n", cus, per_cu, grid_blocks);
    }
    if (grid_blocks < 0) return;
    if (hipMemsetAsync((char*)d_ws + WS_BAR, 0, BAR_ZERO_BYTES, stream) != hipSuccess) { fprintf(stderr, "kernel_launch: memset failed\n"); return; }
    Args a{};
    for (int i = 0; i < 17; ++i) a.in[i] = (const float*)d_in[i];
    a.out = (float*)d_out; a.ws = (unsigned char*)d_ws;
#if N_LAUNCH_SPLIT
    for (int p = 0; p < 9; ++p) { a.ph_lo = p; a.ph_hi = p + 1; void* kargs[] = {&a};
        hipError_t e = hipLaunchCooperativeKernel((const void*)fwd_megakernel, dim3(grid_blocks), dim3(512), kargs, LDS_BYTES, stream);
        if (e != hipSuccess) { fprintf(stderr, "cooperative launch (phase %d) failed: %s\n", p, hipGetErrorString(e)); return; } }
#else
    a.ph_lo = 0; a.ph_hi = 9; void* kargs[] = {&a};
    hipError_t e = hipLaunchCooperativeKernel((const void*)fwd_megakernel, dim3(grid_blocks), dim3(512), kargs, LDS_BYTES, stream);
    if (e != hipSuccess) fprintf(stderr, "cooperative launch failed: %s (grid %d)\n", hipGetErrorString(e), grid_blocks);
#endif
}
```

```cpp
#include <hip/hip_runtime.h>
#include <hip/hip_cooperative_groups.h>
#include <cstdio>
#include <cstdint>
namespace cg = cooperative_groups;
namespace pg8 {
#define PG8_LAS __attribute__((address_space(3)))
typedef unsigned short bf16_t;
typedef short bf16x8 __attribute__((ext_vector_type(8)));
typedef float f32x4 __attribute__((ext_vector_type(4)));
typedef unsigned u32x4 __attribute__((ext_vector_type(4)));
constexpr int BM = 256, BK = 64, HALF = 128, HTB = HALF * BK * 2  , STAGE_BYTES = 8 * HTB, NXCD = 8, WGM = 8;

__host__ __device__ __forceinline__ int lds_byte(int r, int c) { const int st = (r >> 4) * 2 + (c >> 5), rr = r & 15, cc = c & 31, ob = rr * 64 + cc * 2; return st * 1024 + (ob ^ (((ob >> 9) & 1) << 5)); }
__host__ __device__ __forceinline__ void stage_rc(int b, int& R, int& C) { const int st = b / 1024, sb = b % 1024, swz = sb ^ (((sb >> 9) & 1) << 5); R = (st >> 1) * 16 + swz / 64; C = (st & 1) * 32 + (swz % 64) / 2; }
__host__ __device__ __forceinline__ int perm32(int rho) { const int n = rho >> 4, i = rho & 15; return 8 * (i >> 2) + 4 * n + (i & 3); }

struct Unit { int pm, pn; };
struct Gemm { const bf16_t* A; const bf16_t* Bt; int M, N, K; };

struct StaticOrder {
    int nM, nN, nwg, G, c;
    __host__ __device__ void init(int M, int N, int G_, int c_) { nM = M / BM; nN = N / BM; nwg = nM * nN; G = G_; c = c_; }
    __host__ __device__ bool next(int i, Unit& u) const {
        const long L = (long)i * G + c; if (L >= nwg) return false;
        int wgid = (int)L; { const int q = nwg / NXCD, r = nwg % NXCD, xcd = wgid % NXCD, off = wgid / NXCD; wgid = (xcd < r ? xcd * (q + 1) : r * (q + 1) + (xcd - r) * q) + off; }
        const int nig = WGM * nN, gid = wgid / nig, fm = gid * WGM, gsz = (nM - fm) < WGM ? (nM - fm) : WGM;
        u.pm = fm + ((wgid % nig) % gsz); u.pn = (wgid % nig) / gsz; return true;
    }
    __device__ __forceinline__ void a_ready(const Unit&) const {}
    __device__ __forceinline__ void done(const Unit&) const {}
};

__device__ __forceinline__ unsigned cvt_pk_bf16(float lo, float hi) { unsigned r; asm volatile("v_cvt_pk_bf16_f32 %0, %1, %2" : "=v"(r) : "v"(lo), "v"(hi)); return r; }
__device__ __forceinline__ void store16_wt(void* p, u32x4 v) { asm volatile("global_store_dwordx4 %0, %1, off sc1\n\ts_nop 2" :: "v"(p), "v"(v) : "memory");     }
typedef float f32x2 __attribute__((ext_vector_type(2)));
template <class Epi, class Sched, bool ALIGN_EPI = false, bool SP2 = false, bool ROWPERM = false>
__device__ __forceinline__ void gemm_phase(PG8_LAS unsigned char* lds, const Gemm g, const Sched& S, const Epi& E) {
    const int tid = threadIdx.x, wid = __builtin_amdgcn_readfirstlane(tid >> 6), lane = tid & 63, wr = wid >> 2, wc = wid & 3, fr = lane & 15, fq = lane >> 4;
    const int K = g.K, nt = K / BK;
    unsigned voffA[2], voffB[2];
#pragma unroll
    for (int i = 0; i < 2; ++i) { int R, C; stage_rc(tid * 16 + i * 8192, R, C); const int Rb = Epi::PERM ? ((R & ~31) + perm32(R & 31)) : R;
        const int Ra = ROWPERM ? ((R & ~63) + 4 * (R & 15) + ((R >> 4) & 3)) : R;
        voffA[i] = (unsigned)(Ra * K + C) * 2u; voffB[i] = (unsigned)(Rb * K + C) * 2u; }
    const size_t kstep = (size_t)(BK * 2);
    const size_t hstep = (size_t)HALF * K * 2;
    const size_t tstep = 2 * hstep;
    const unsigned ldsw = (unsigned)wid * 1024u;
    const int aoff = lds_byte(wr * 64 + fr, fq * 8), boff = lds_byte(wc * 32 + fr, fq * 8);
#define PG8_SA(b, h) (((b) * 2 + (h)) * HTB)
#define PG8_SB(b, h) ((4 + (b) * 2 + (h)) * HTB)
#define PG8_STAGE(bufoff, gbase, voff) do { _Pragma("unroll") for (int _i = 0; _i < 2; ++_i) \
        __builtin_amdgcn_global_load_lds((const unsigned*)((const char*)(gbase) + (voff)[_i]), (PG8_LAS unsigned*)(lds + (bufoff) + ldsw + _i * 8192), 16, 0, 0); } while (0)
#define PG8_LDA(dst, b, h) do { _Pragma("unroll") for (int m = 0; m < 4; ++m) _Pragma("unroll") for (int k = 0; k < 2; ++k) dst[m][k] = *(const PG8_LAS bf16x8*)(lds + PG8_SA(b, h) + aoff + m * 2048 + k * 1024); } while (0)
#define PG8_LDB(dst, b, h) do { _Pragma("unroll") for (int n = 0; n < 2; ++n) _Pragma("unroll") for (int k = 0; k < 2; ++k) dst[n][k] = *(const PG8_LAS bf16x8*)(lds + PG8_SB(b, h) + boff + n * 2048 + k * 1024); } while (0)
#define PG8_MMA(ai, bj, At, Bt) do { __builtin_amdgcn_s_setprio(1); _Pragma("unroll") for (int m = 0; m < 4; ++m) _Pragma("unroll") for (int n = 0; n < 2; ++n) _Pragma("unroll") for (int k = 0; k < 2; ++k) \
        acc[ai][bj][m][n] = __builtin_amdgcn_mfma_f32_16x16x32_bf16(Bt[n][k], At[m][k], acc[ai][bj][m][n], 0, 0, 0); __builtin_amdgcn_s_setprio(0); } while (0)
#define PG8_WAIT_V(n) asm volatile("s_waitcnt vmcnt(" #n ")" ::: "memory")
#define PG8_WAIT_L(n) asm volatile("s_waitcnt lgkmcnt(" #n ")" ::: "memory")
#define PG8_BAR __builtin_amdgcn_s_barrier()
#define PG8_SCHED __builtin_amdgcn_sched_barrier(0)
    Unit cur, nxt; int ui = 0;
    if (!S.next(0, cur)) return;
    f32x4 acc[2][2][4][2];
#pragma unroll
    for (int a = 0; a < 2; ++a)
#pragma unroll
        for (int b = 0; b < 2; ++b)
#pragma unroll
            for (int m = 0; m < 4; ++m)
#pragma unroll
                for (int n = 0; n < 2; ++n) acc[a][b][m][n] = (f32x4){0.f, 0.f, 0.f, 0.f};
    bf16x8 At[4][2], B0[2][2], B1[2][2];
    const char* cA = (const char*)g.A + (size_t)cur.pm * tstep; const char* cB = (const char*)g.Bt + (size_t)cur.pn * tstep;
    S.a_ready(cur);
    if constexpr (SP2) {
        PG8_STAGE(PG8_SB(0, 0), cB, voffB); PG8_STAGE(PG8_SB(0, 1), cB + hstep, voffB); PG8_STAGE(PG8_SA(0, 0), cA, voffA); PG8_STAGE(PG8_SA(0, 1), cA + hstep, voffA);
        if (wr == 1) PG8_BAR;
        PG8_WAIT_V(2); PG8_BAR;
        PG8_STAGE(PG8_SB(1, 0), cB + kstep, voffB); PG8_STAGE(PG8_SA(1, 0), cA + kstep, voffA); PG8_STAGE(PG8_SB(1, 1), cB + hstep + kstep, voffB);
        PG8_WAIT_V(6); PG8_BAR;
    } else {
        PG8_STAGE(PG8_SB(0, 0), cB, voffB); PG8_STAGE(PG8_SA(0, 0), cA, voffA); PG8_STAGE(PG8_SB(0, 1), cB + hstep, voffB); PG8_STAGE(PG8_SA(0, 1), cA + hstep, voffA);
        if (wr == 1) PG8_BAR;
        PG8_WAIT_V(4); PG8_BAR;
        PG8_STAGE(PG8_SB(1, 0), cB + kstep, voffB); PG8_STAGE(PG8_SA(1, 0), cA + kstep, voffA); PG8_STAGE(PG8_SB(1, 1), cB + hstep + kstep, voffB);
        PG8_WAIT_V(6); PG8_BAR;
    }
    for (;;) {
        const bool has_next = S.next(ui + 1, nxt);
        const char* nA = has_next ? (const char*)g.A + (size_t)nxt.pm * tstep : cA; const char* nB = has_next ? (const char*)g.Bt + (size_t)nxt.pn * tstep : cB;
        for (int t = 0; t < nt; t += 2) {
            const bool last = (t == nt - 2);
            const char* a1 = cA + (size_t)(t + 1) * kstep;
            const char* a2 = last ? nA : cA + (size_t)(t + 2) * kstep; const char* b2 = last ? nB : cB + (size_t)(t + 2) * kstep;
            const char* a3 = a2 + kstep; const char* b3 = b2 + kstep;
            if (last && has_next) S.a_ready(nxt);
            if constexpr (SP2) {
            PG8_LDB(B0, 0, 0); PG8_LDB(B1, 0, 1); PG8_SCHED; PG8_LDA(At, 0, 0); PG8_STAGE(PG8_SA(1, 1), a1 + hstep, voffA);
            PG8_WAIT_V(8); PG8_WAIT_L(0); PG8_BAR; PG8_MMA(0, 0, At, B0); PG8_MMA(0, 1, At, B1); PG8_BAR; PG8_SCHED;
            PG8_LDA(At, 0, 1); PG8_STAGE(PG8_SB(0, 0), b2, voffB); PG8_STAGE(PG8_SB(0, 1), b2 + hstep, voffB); PG8_STAGE(PG8_SA(0, 0), a2, voffA);
            PG8_WAIT_V(8); PG8_WAIT_L(0); PG8_BAR; PG8_MMA(1, 0, At, B0); PG8_MMA(1, 1, At, B1); PG8_BAR; PG8_SCHED;
            PG8_LDB(B0, 1, 0); PG8_LDB(B1, 1, 1); PG8_SCHED; PG8_LDA(At, 1, 0); PG8_STAGE(PG8_SA(0, 1), a2 + hstep, voffA);
            PG8_WAIT_V(8); PG8_WAIT_L(0); PG8_BAR; PG8_MMA(0, 0, At, B0); PG8_MMA(0, 1, At, B1); PG8_BAR; PG8_SCHED;
            PG8_LDA(At, 1, 1); PG8_STAGE(PG8_SB(1, 0), b3, voffB); PG8_STAGE(PG8_SB(1, 1), b3 + hstep, voffB); PG8_STAGE(PG8_SA(1, 0), a3, voffA);
            PG8_WAIT_V(8); PG8_WAIT_L(0); PG8_BAR; PG8_MMA(1, 0, At, B0); PG8_MMA(1, 1, At, B1); PG8_BAR; PG8_SCHED;
            } else {
            PG8_LDB(B0, 0, 0); PG8_SCHED; PG8_LDA(At, 0, 0); PG8_STAGE(PG8_SA(1, 1), a1 + hstep, voffA);
            PG8_WAIT_L(8); PG8_BAR; PG8_WAIT_L(0); PG8_MMA(0, 0, At, B0); PG8_BAR; PG8_SCHED;
            PG8_LDB(B1, 0, 1); PG8_STAGE(PG8_SB(0, 0), b2, voffB);
            PG8_BAR; PG8_WAIT_L(0); PG8_MMA(0, 1, At, B1); PG8_BAR;
            PG8_LDA(At, 0, 1); PG8_STAGE(PG8_SA(0, 0), a2, voffA);
            PG8_BAR; PG8_WAIT_L(0); PG8_MMA(1, 0, At, B0); PG8_BAR; PG8_SCHED;
            PG8_STAGE(PG8_SB(0, 1), b2 + hstep, voffB);
            PG8_WAIT_V(6); PG8_BAR; PG8_MMA(1, 1, At, B1); PG8_BAR;
            PG8_LDB(B0, 1, 0); PG8_SCHED; PG8_LDA(At, 1, 0); PG8_STAGE(PG8_SA(0, 1), a2 + hstep, voffA);
            PG8_WAIT_L(8); PG8_BAR; PG8_WAIT_L(0); PG8_MMA(0, 0, At, B0); PG8_BAR; PG8_SCHED;
            PG8_LDB(B1, 1, 1); PG8_STAGE(PG8_SB(1, 0), b3, voffB);
            PG8_BAR; PG8_WAIT_L(0); PG8_MMA(0, 1, At, B1); PG8_BAR;
            PG8_LDA(At, 1, 1); PG8_STAGE(PG8_SA(1, 0), a3, voffA);
            PG8_BAR; PG8_WAIT_L(0); PG8_MMA(1, 0, At, B0); PG8_BAR; PG8_SCHED;
            PG8_STAGE(PG8_SB(1, 1), b3 + hstep, voffB);
            PG8_WAIT_V(6); PG8_BAR; PG8_MMA(1, 1, At, B1); PG8_BAR;
            }
        }
        if constexpr (ALIGN_EPI) { if (wr == 0) PG8_BAR; }
        if constexpr (!Epi::AFTER_DRAIN) { E(acc, cur, wr, wc, fr, fq); S.done(cur); }
        if (!has_next) break;
#pragma unroll
        for (int a = 0; a < 2; ++a)
#pragma unroll
            for (int b = 0; b < 2; ++b)
#pragma unroll
                for (int m = 0; m < 4; ++m)
#pragma unroll
                    for (int n = 0; n < 2; ++n) acc[a][b][m][n] = (f32x4){0.f, 0.f, 0.f, 0.f};
        cur = nxt; cA = nA; cB = nB; ++ui;
        if constexpr (ALIGN_EPI) { if (wr == 1) PG8_BAR; }
    }
    PG8_WAIT_V(0);
    if constexpr (!ALIGN_EPI) { if (wr == 0) PG8_BAR; }
    PG8_BAR;
    if constexpr (Epi::AFTER_DRAIN) { E.fused(acc, cur, wr, wc, fr, fq, lds, wid, lane); S.done(cur); }
#undef PG8_SA
#undef PG8_SB
#undef PG8_STAGE
#undef PG8_LDA
#undef PG8_LDB
#undef PG8_MMA
#undef PG8_WAIT_V
#undef PG8_WAIT_L
#undef PG8_BAR
#undef PG8_SCHED
}
constexpr float LOG2E = 1.4426950408889634f;
constexpr float C2 = 0.125f * LOG2E;
struct EpiIn {
    static constexpr bool PERM = true, AFTER_DRAIN = false;
    bf16_t* O; const float* costab; const float* sintab;
    __device__ __forceinline__ void operator()(const f32x4 (&acc)[2][2][4][2], const Unit& u, int wr, int wc, int fr, int fq) const {
        const int pn = u.pn, row0 = u.pm * BM + wr * 64 + fr, col0 = pn * BM + wc * 32 + 8 * fq;
        const bool rope0 = (pn >= 6), rope1 = (pn == 6 || pn == 7);
        const float sc = (pn < 2 || pn == 6 || pn == 7) ? C2 : 1.f;
        const int G4 = 4 * ((wc & 1) * 4 + fq);
#pragma unroll
        for (int ai = 0; ai < 2; ++ai)
#pragma unroll
            for (int m = 0; m < 4; ++m) {
                const int row = row0 + ai * HALF + m * 16, pos = row & 2047;
                f32x4 cs = (f32x4){1.f, 1.f, 1.f, 1.f}, sn = (f32x4){0.f, 0.f, 0.f, 0.f};
                if (rope0) { cs = *(const f32x4*)(costab + pos * 32 + G4); sn = *(const f32x4*)(sintab + pos * 32 + G4); }
                bf16_t* rowp = O + (size_t)row * 2304 + col0;
#pragma unroll
                for (int bj = 0; bj < 2; ++bj) {
                    f32x4 v0 = acc[ai][bj][m][0], v1 = acc[ai][bj][m][1];
                    if (bj == 0 ? rope0 : rope1) { const f32x4 o0 = v0 * cs - v1 * sn, o1 = v1 * cs + v0 * sn; v0 = o0; v1 = o1; }
                    v0 = v0 * sc; v1 = v1 * sc;
                    u32x4 w; w.x = cvt_pk_bf16(v0[0], v0[1]); w.y = cvt_pk_bf16(v0[2], v0[3]); w.z = cvt_pk_bf16(v1[0], v1[1]); w.w = cvt_pk_bf16(v1[2], v1[3]);
                    store16_wt(rowp + bj * HALF, w);
                }
            }
    }
};
struct EpiRes {
    static constexpr bool PERM = false, AFTER_DRAIN = false;
    const float* base; float* out; const float* gate;
    __device__ __forceinline__ void operator()(const f32x4 (&acc)[2][2][4][2], const Unit& u, int wr, int wc, int fr, int fq) const {
        const int col0 = u.pn * BM + wc * 32 + 4 * fq, b = u.pm >> 3;
        f32x4 gv[2][2];
#pragma unroll
        for (int bj = 0; bj < 2; ++bj)
#pragma unroll
            for (int n = 0; n < 2; ++n) gv[bj][n] = *(const f32x4*)(gate + b * 6144 + col0 + bj * HALF + n * 16);
#pragma unroll
        for (int ai = 0; ai < 2; ++ai)
#pragma unroll
            for (int mp = 0; mp < 2; ++mp) {
                f32x4 bs[2][2][2];
#pragma unroll
                for (int mm = 0; mm < 2; ++mm) { const size_t off = (size_t)(u.pm * BM + ai * HALF + wr * 64 + (2 * mp + mm) * 16 + fr) * 1024 + col0;
#pragma unroll
                    for (int bj = 0; bj < 2; ++bj)
#pragma unroll
                        for (int n = 0; n < 2; ++n) bs[mm][bj][n] = *(const f32x4*)(base + off + bj * HALF + n * 16); }
                asm volatile("" ::: "memory");
#pragma unroll
                for (int mm = 0; mm < 2; ++mm) { const size_t off = (size_t)(u.pm * BM + ai * HALF + wr * 64 + (2 * mp + mm) * 16 + fr) * 1024 + col0;
#pragma unroll
                    for (int bj = 0; bj < 2; ++bj)
#pragma unroll
                        for (int n = 0; n < 2; ++n) *(f32x4*)(out + off + bj * HALF + n * 16) = bs[mm][bj][n] + gv[bj][n] * acc[ai][bj][2 * mp + mm][n]; }
                asm volatile("" ::: "memory");
            }
    }
};
template <bool BASE_B16> struct EpiResB {
    static constexpr bool PERM = true, AFTER_DRAIN = false;
    const void* base; bf16_t* outb; const float* gate;
    __device__ __forceinline__ void operator()(const f32x4 (&acc)[2][2][4][2], const Unit& u, int wr, int wc, int fr, int fq) const {
        const int col0 = u.pn * BM + wc * 32 + 8 * fq, b = u.pm >> 3;
        f32x4 gv[2][2];
#pragma unroll
        for (int bj = 0; bj < 2; ++bj)
#pragma unroll
            for (int n = 0; n < 2; ++n) gv[bj][n] = *(const f32x4*)(gate + b * 6144 + col0 + bj * HALF + n * 4);
#pragma unroll
        for (int ai = 0; ai < 2; ++ai)
#pragma unroll
            for (int mp = 0; mp < 2; ++mp) {
                f32x4 bs[2][2][2];
#pragma unroll
                for (int mm = 0; mm < 2; ++mm) { const size_t off = (size_t)(u.pm * BM + ai * HALF + wr * 64 + (2 * mp + mm) * 16 + fr) * 1024 + col0;
#pragma unroll
                    for (int bj = 0; bj < 2; ++bj) {
                        if (BASE_B16) { const u32x4 w = *(const u32x4*)((const bf16_t*)base + off + bj * HALF);
                            bs[mm][bj][0] = (f32x4){__builtin_bit_cast(float, w.x << 16), __builtin_bit_cast(float, w.x & 0xffff0000u), __builtin_bit_cast(float, w.y << 16), __builtin_bit_cast(float, w.y & 0xffff0000u)};
                            bs[mm][bj][1] = (f32x4){__builtin_bit_cast(float, w.z << 16), __builtin_bit_cast(float, w.z & 0xffff0000u), __builtin_bit_cast(float, w.w << 16), __builtin_bit_cast(float, w.w & 0xffff0000u)}; }
                        else { bs[mm][bj][0] = *(const f32x4*)((const float*)base + off + bj * HALF); bs[mm][bj][1] = *(const f32x4*)((const float*)base + off + bj * HALF + 4); } } }
                asm volatile("" ::: "memory");
#pragma unroll
                for (int mm = 0; mm < 2; ++mm) { const size_t off = (size_t)(u.pm * BM + ai * HALF + wr * 64 + (2 * mp + mm) * 16 + fr) * 1024 + col0;
#pragma unroll
                    for (int bj = 0; bj < 2; ++bj) { const f32x4 v0 = bs[mm][bj][0] + gv[bj][0] * acc[ai][bj][2 * mp + mm][0], v1 = bs[mm][bj][1] + gv[bj][1] * acc[ai][bj][2 * mp + mm][1];
                        u32x4 w; w.x = cvt_pk_bf16(v0[0], v0[1]); w.y = cvt_pk_bf16(v0[2], v0[3]); w.z = cvt_pk_bf16(v1[0], v1[1]); w.w = cvt_pk_bf16(v1[2], v1[3]);
                        store16_wt(outb + off + bj * HALF, w); } }
                asm volatile("" ::: "memory");
            }
    }
};
__device__ __forceinline__ float dpp_ror1(float v) { return __builtin_bit_cast(float, __builtin_amdgcn_update_dpp(0, __builtin_bit_cast(int, v), 0x121, 0xf, 0xf, false)); }
__device__ __forceinline__ float dpp_shr1z(float v) { return __builtin_bit_cast(float, __builtin_amdgcn_update_dpp(0, __builtin_bit_cast(int, v), 0x111, 0xf, 0xf, true)); }
__device__ __forceinline__ float dpp_shl1z(float v) { return __builtin_bit_cast(float, __builtin_amdgcn_update_dpp(0, __builtin_bit_cast(int, v), 0x101, 0xf, 0xf, true)); }
__device__ __forceinline__ float dpp_rol1(float v) { return __builtin_bit_cast(float, __builtin_amdgcn_update_dpp(0, __builtin_bit_cast(int, v), 0x12f, 0xf, 0xf, false)); }
struct EpiUp {
    static constexpr bool PERM = true, AFTER_DRAIN = false;
    bf16_t* ACT; float* SB; const float* cw; const float* cb;
    __device__ __forceinline__ void operator()(const f32x4 (&acc)[2][2][4][2], const Unit& u, int wr, int wc, int fr, int fq) const {
        const int ff0 = u.pn * 128 + wc * 32 + 8 * fq;
        f32x4 w0a[2], w1a[2], w2a[2], bba[2];
#pragma unroll
        for (int n = 0; n < 2; ++n) { w0a[n] = *(const f32x4*)(cw + ff0 + 4 * n); w1a[n] = *(const f32x4*)(cw + 2816 + ff0 + 4 * n); w2a[n] = *(const f32x4*)(cw + 5632 + ff0 + 4 * n); bba[n] = *(const f32x4*)(cb + ff0 + 4 * n); }
#pragma unroll
        for (int ai = 0; ai < 2; ++ai) {
            const int chunk = 4 * u.pm + 2 * ai + wr, row0 = chunk * 64;
            unsigned pk[4][4];
            float bG[8], bV[8], bC[8];
#pragma unroll
            for (int n = 0; n < 2; ++n) {
                const f32x4 w0 = w0a[n], w1 = w1a[n], w2 = w2a[n], bb = bba[n];
#pragma unroll
                for (int jp = 0; jp < 2; ++jp) {
                    float av[4][2];
#pragma unroll
                    for (int jj = 0; jj < 2; ++jj) {
                        const int j = 2 * jp + jj;
                        const float pm0 = dpp_shr1z(acc[ai][1][3][n][j]), nm3 = dpp_shl1z(acc[ai][1][0][n][j]);
#pragma unroll
                        for (int m = 0; m < 4; ++m) {
                            const float cur = acc[ai][1][m][n][j], val = acc[ai][0][m][n][j];
                            const float pv = (m > 0) ? acc[ai][1][m > 0 ? m - 1 : 0][n][j] : pm0, nx = (m < 3) ? acc[ai][1][m < 3 ? m + 1 : 3][n][j] : nm3;
                            const float gc = w0[j] * pv + w1[j] * cur + w2[j] * nx + bb[j];
                            av[m][jj] = gc * val * __builtin_amdgcn_rcpf(1.f + __builtin_amdgcn_exp2f(-LOG2E * gc));
                            if (m == 0) { bG[4 * n + j] = gc; bV[4 * n + j] = val; bC[4 * n + j] = cur; }
                            if (m == 3) { const bool l = (fr == 15); bG[4 * n + j] = l ? gc : bG[4 * n + j]; bV[4 * n + j] = l ? val : bV[4 * n + j]; bC[4 * n + j] = l ? cur : bC[4 * n + j]; }
                        }
                    }
#pragma unroll
                    for (int m = 0; m < 4; ++m) pk[m][2 * n + jp] = cvt_pk_bf16(av[m][0], av[m][1]);
                }
            }
#pragma unroll
            for (int m = 0; m < 4; ++m) { u32x4 w; w.x = pk[m][0]; w.y = pk[m][1]; w.z = pk[m][2]; w.w = pk[m][3]; store16_wt(ACT + (size_t)(row0 + 4 * fr + m) * 2816 + ff0, w); }
            if (fr == 0 || fr == 15) {
                float* sb = SB + ((size_t)(chunk * 2 + (fr == 15 ? 1 : 0)) * 3) * 2816 + ff0;
#pragma unroll
                for (int n = 0; n < 2; ++n) { *(f32x4*)(sb + 4 * n) = (f32x4){bG[4 * n], bG[4 * n + 1], bG[4 * n + 2], bG[4 * n + 3]}; *(f32x4*)(sb + 2816 + 4 * n) = (f32x4){bV[4 * n], bV[4 * n + 1], bV[4 * n + 2], bV[4 * n + 3]};
                    *(f32x4*)(sb + 5632 + 4 * n) = (f32x4){bC[4 * n], bC[4 * n + 1], bC[4 * n + 2], bC[4 * n + 3]}; }
            }
        }
    }
};
}
using namespace pg8;
#define LAS PG8_LAS
typedef float f32x16 __attribute__((ext_vector_type(16)));
typedef short s16x4 __attribute__((ext_vector_type(4)));
typedef short v4i16_t __attribute__((ext_vector_type(4)));
typedef unsigned u32x2 __attribute__((ext_vector_type(2)));

constexpr int NB = 16, SEQ = 2048, DM = 1024, MTOK = NB * SEQ, NIN = 2304, DFF = 2816, NUP = 5632;
constexpr float EPS = 1e-6f;
constexpr size_t MiB = 1u << 20;
constexpr size_t WS_BAR = 0, BAR_ZERO_BYTES = 16384;
constexpr size_t WS_MOD = 1 * MiB, WS_COS = 2 * MiB, WS_SIN = 2 * MiB + 512 * 1024, WS_WIN = 4 * MiB, WS_WOUT = 10 * MiB, WS_WUP = 12 * MiB, WS_WDN = 24 * MiB;
constexpr size_t WS_H = 32 * MiB, WS_PROJ = 96 * MiB, WS_AO = 240 * MiB, WS_ACT = 96 * MiB  , WS_SB = 304 * MiB, WS_X1B = 346 * MiB, WS_END = 410 * MiB;
static_assert(WS_ACT + (size_t)MTOK * DFF * 2 <= WS_SB && WS_SB + (size_t)512 * 2 * 3 * DFF * 4 <= WS_END, "ws map");
constexpr int LDS_BYTES = 147456, LDS_BARST_OFF = 131072;
constexpr int ATT_BIAS_OFF = 0, ATT_BSTR = 640, ATT_V_OFF = 20480, ATT_VROW = 192, ATT_VBUF = 32 * ATT_VROW, ATT_RED_OFF = ATT_V_OFF + 8 * 2 * ATT_VBUF;
static_assert(ATT_RED_OFF + 2 * 8 * 64 * 4 <= LDS_BYTES, "attention LDS");

__device__ __forceinline__ float wave_sum(float v) {
#pragma unroll
    for (int o = 1; o < 64; o <<= 1) v += __shfl_xor(v, o);
    return v;
}
__device__ __forceinline__ s16x4 vtr(unsigned a) { return __builtin_bit_cast(s16x4, __builtin_amdgcn_ds_read_tr16_b64_v4i16((LAS v4i16_t*)(a))); }
__device__ __forceinline__ f32x16 mfma32(bf16x8 a, bf16x8 b, f32x16 c) { return __builtin_amdgcn_mfma_f32_32x32x16_bf16(a, b, c, 0, 0, 0); }
__device__ __forceinline__ bf16x8 pack8(float a0, float a1, float a2, float a3, float a4, float a5, float a6, float a7) {
    u32x4 w; w.x = cvt_pk_bf16(a0, a1); w.y = cvt_pk_bf16(a2, a3); w.z = cvt_pk_bf16(a4, a5); w.w = cvt_pk_bf16(a6, a7); return __builtin_bit_cast(bf16x8, w);
}
struct NaXf {
    const LAS float* bt; int kc0;
    template <int QUAD> __device__ __forceinline__ void apply(f32x16& s) const {
#pragma unroll
        for (int i = 0; i < 16; ++i) { const int a = i >> 2, b = i & 3, ap = QUAD ? 0 : a, ra = QUAD ? a : 0;
            const float bias = bt[ra * 31 + 8 * ap + b]; const bool ok = (unsigned)(kc0 + 8 * ap + b) < 16u; s[i] = ok ? s[i] + bias : -1e30f; }
    }
};
struct SwXf {
    int mode, ql, h, dq;
    __device__ __forceinline__ void apply(f32x16& s) const {
        {
#pragma unroll
            for (int i = 0; i < 16; ++i) { const int kb = 8 * (i >> 2) + 4 * h + (i & 3); const int d = dq + kb - ql; const bool ok = (d >= -128) && (d <= 128); s[i] = ok ? s[i] : -1e30f; }
        }
    }
};
struct AttnSt { f32x16 o0, o1; float m, l; };
__device__ __forceinline__ void attn_softmax_pv(f32x16& s, AttnSt& st, unsigned vaddr) {
    float mx = s[0];
#pragma unroll
    for (int i = 1; i < 16; ++i) mx = fmaxf(mx, s[i]);
    mx = fmaxf(mx, __shfl_xor(mx, 32));
    const float mn = fmaxf(st.m, mx), al = __builtin_amdgcn_exp2f(st.m - mn); st.m = mn;
    float ps = 0.f;
#pragma unroll
    for (int i = 0; i < 16; ++i) { s[i] = __builtin_amdgcn_exp2f(s[i] - mn); ps += s[i]; }
    st.l = st.l * al + ps; st.o0 = st.o0 * al; st.o1 = st.o1 * al;
    const bf16x8 p0 = pack8(s[0], s[1], s[2], s[3], s[4], s[5], s[6], s[7]), p1 = pack8(s[8], s[9], s[10], s[11], s[12], s[13], s[14], s[15]);
    bf16x8 a[2][2];
#pragma unroll
    for (int db = 0; db < 2; ++db)
#pragma unroll
        for (int ks = 0; ks < 2; ++ks) { const s16x4 lo = vtr(vaddr + ks * 16 * ATT_VROW + db * 64), hi = vtr(vaddr + ks * 16 * ATT_VROW + 8 * ATT_VROW + db * 64);
            a[db][ks] = (bf16x8){lo[0], lo[1], lo[2], lo[3], hi[0], hi[1], hi[2], hi[3]}; }
    st.o0 = mfma32(a[0][0], p0, st.o0); st.o0 = mfma32(a[0][1], p1, st.o0);
    st.o1 = mfma32(a[1][0], p0, st.o1); st.o1 = mfma32(a[1][1], p1, st.o1);
}
struct BlkDesc { int base, hs; };
__device__ __forceinline__ void load_k(bf16x8 (&kf)[4], const bf16_t* proj, int koff, const BlkDesc& d, int ql, int h) {
    const bf16_t* p = proj + (size_t)(d.base + (d.hs ? (ql & 7) + (ql >> 3) * 64 : ql)) * NIN + koff + 32 * h;
#pragma unroll
    for (int kk = 0; kk < 4; ++kk) kf[kk] = *(const bf16x8*)(p + 8 * kk);
}
__device__ __forceinline__ void load_v(u32x4 (&vf)[4], const bf16_t* proj, int voff, const BlkDesc& d, int lane) {
#pragma unroll
    for (int i = 0; i < 4; ++i) { const int x = 8 * i + (lane >> 3); vf[i] = *(const u32x4*)(proj + (size_t)(d.base + (d.hs ? (x & 7) + (x >> 3) * 64 : x)) * NIN + voff + 8 * (lane & 7)); }
}
__device__ __forceinline__ void store_v(LAS unsigned char* vb, const u32x4 (&vf)[4], int lane) {
#pragma unroll
    for (int i = 0; i < 4; ++i) *(LAS u32x4*)(vb + (8 * i + (lane >> 3)) * ATT_VROW + 16 * (lane & 7)) = vf[i];
}

struct UnitId { int valid, swp, b, sub; };
__device__ __forceinline__ UnitId unit_id(int it, int G, int bid) {
    UnitId d; const int u = it * G + bid; d.valid = (u < 1536) ? 1 : 0; const int q3 = u / 3, r3 = u - 3 * q3;
    d.swp = (r3 == 2) ? 1 : 0;
    if (d.swp) { d.b = q3 >> 5; d.sub = q3 & 31; } else { const int idx = q3 * 2 + r3; d.b = idx >> 6; d.sub = idx & 63; }
    return d;
}
struct UnitPre { int valid, tokq, qoff, koff, voff; BlkDesc d0; };
__device__ __forceinline__ UnitPre unit_pre(int it, int G, int bid, int wave, int ql) {
    UnitPre p; const UnitId d = unit_id(it, G, bid); p.valid = d.valid;
    if (!d.swp) { const int r = d.sub >> 1, jp = d.sub & 1, rs = min(max(r - 4, 0), 24);
        p.tokq = d.b * SEQ + r * 64 + 32 * jp + ql; p.qoff = wave * 64; p.koff = 512 + wave * 64; p.voff = 1024 + wave * 64; p.d0.base = d.b * SEQ + rs * 64 + 32 * jp; p.d0.hs = 0; }
    else { const int q0 = 64 * d.sub, kvh = wave >> 2, tlo = max(0, (128 - q0) / 32);
        p.tokq = d.b * SEQ + q0 + ql; p.qoff = 1536 + wave * 64; p.koff = 2048 + kvh * 64; p.voff = 2176 + kvh * 64; p.d0.base = d.b * SEQ + q0 - 128 + 32 * tlo; p.d0.hs = 0; }
    return p;
}
__device__ __forceinline__ f32x16 qk_scores(const bf16x8 (&kf)[4], const bf16x8 (&qf)[4]) {
    f32x16 s;
#pragma unroll
    for (int e = 0; e < 16; ++e) s[e] = 0.f;
#pragma unroll
    for (int kk = 0; kk < 4; ++kk) s = mfma32(kf[kk], qf[kk], s);
    return s;
}
__device__ __forceinline__ float attn_norm_l(AttnSt& st) {
    const float lt = st.l + __shfl_xor(st.l, 32), inv = 1.f / lt;
    float ss = 0.f;
#pragma unroll
    for (int i = 0; i < 16; ++i) { st.o0[i] *= inv; st.o1[i] *= inv; ss += st.o0[i] * st.o0[i] + st.o1[i] * st.o1[i]; }
    return ss + __shfl_xor(ss, 32);
}
__device__ __forceinline__ void attn_store(const AttnSt& st, float rn, bf16_t* op) {
#pragma unroll
    for (int a = 0; a < 4; ++a) {
        u32x2 w0, w1;
        w0.x = cvt_pk_bf16(st.o0[4 * a] * rn, st.o0[4 * a + 1] * rn); w0.y = cvt_pk_bf16(st.o0[4 * a + 2] * rn, st.o0[4 * a + 3] * rn);
        w1.x = cvt_pk_bf16(st.o1[4 * a] * rn, st.o1[4 * a + 1] * rn); w1.y = cvt_pk_bf16(st.o1[4 * a + 2] * rn, st.o1[4 * a + 3] * rn);
        *(u32x2*)(op + 8 * a) = w0; *(u32x2*)(op + 32 + 8 * a) = w1;
    }
}
__device__ __forceinline__ void attn_phase(LAS unsigned char* lds, const bf16_t* __restrict__ proj, bf16_t* __restrict__ ao, const float* __restrict__ rpb, const float* __restrict__ sink) {
    const int tid = threadIdx.x, wave = __builtin_amdgcn_readfirstlane(tid >> 6), lane = tid & 63, ql = lane & 31, h = lane >> 5;
    const int G = gridDim.x, bid = blockIdx.x;
    LAS float* btab = (LAS float*)(lds + ATT_BIAS_OFF);
    LAS unsigned char* vbuf = lds + ATT_V_OFF + wave * 2 * ATT_VBUF;
    LAS float* red = (LAS float*)(lds + ATT_RED_OFF);
    bf16x8 qf[4], kf[4], kn[4]; u32x4 vf[4];
    { const UnitPre p = unit_pre(0, G, bid, wave, ql);
      if (p.valid) {
#pragma unroll
          for (int kk = 0; kk < 4; ++kk) qf[kk] = *(const bf16x8*)(proj + (size_t)p.tokq * NIN + p.qoff + 32 * h + 8 * kk);
          load_k(kf, proj, p.koff, p.d0, ql, h); load_v(vf, proj, p.voff, p.d0, lane); } }
#pragma unroll
    for (int i0 = 0; i0 < 8 * ATT_BSTR; i0 += 512) { const int i = i0 + tid, hh = i / ATT_BSTR, j = i % ATT_BSTR - 64; const bool okb = (j >= 0 && j < 465); const float v = rpb[okb ? hh * 465 + j : 0]; btab[i] = okb ? v * LOG2E : 0.f; }
    __syncthreads();
    const int g4 = lane >> 4, i16 = lane & 15;
    const unsigned trb = (unsigned)((4 * (g4 >> 1) + (i16 >> 2)) * ATT_VROW + (16 * (g4 & 1) + 4 * (i16 & 3)) * 2);
    const unsigned vb0 = (unsigned)(size_t)vbuf;
    for (int it = 0;; ++it) {
        const UnitId ud = unit_id(it, G, bid); if (!ud.valid) break;
        const int b = ud.b, sub = ud.sub;
        AttnSt st, stB;
#pragma unroll
        for (int i = 0; i < 16; ++i) { st.o0[i] = 0.f; st.o1[i] = 0.f; stB.o0[i] = 0.f; stB.o1[i] = 0.f; }
        stB.m = 0.f; stB.l = 1.f;
        int tokq, goff;
        store_v(vbuf, vf, lane);
        if (!ud.swp) {
            const int r = sub >> 1, jp = sub & 1, rs = min(max(r - 4, 0), 24), qcol = 32 * jp + ql, cs = min(max(qcol - 8, 0), 48), cq0 = jp ? 24 : 32;
            tokq = b * SEQ + r * 64 + qcol; goff = 0;
            const int koff = 512 + wave * 64, voff = 1024 + wave * 64;
            st.m = -1e30f; st.l = 0.f;
            const LAS float* bt0 = btab + wave * ATT_BSTR + 64;
            auto desc = [&](int i) { BlkDesc d; if (i < 8) { d.base = b * SEQ + (rs + i) * 64 + 32 * jp; d.hs = 0; } else { d.base = b * SEQ + (rs + 4 * (i - 8)) * 64 + cq0; d.hs = 1; } return d; };
            for (int i = 0; i < 10; ++i) {
                if (i + 1 < 10) { const BlkDesc d = desc(i + 1); load_k(kn, proj, koff, d, ql, h); load_v(vf, proj, voff, d, lane); }
                f32x16 s = qk_scores(kf, qf);
                if (i < 8) { const int R = rs + i, c0 = 32 * jp; NaXf xf{bt0 + (R - r + 7) * 31 + (c0 + 4 * h - qcol + 15), c0 + 4 * h - cs}; xf.apply<0>(s); }
                else { const int R = rs + 4 * (i - 8); NaXf xf{bt0 + (R - r + 7) * 31 + (cq0 + 4 * h - qcol + 15), cq0 + 4 * h - cs}; xf.apply<1>(s); }
                attn_softmax_pv(s, st, vb0 + (unsigned)((i & 1) * ATT_VBUF) + trb);
                if (i + 1 < 10) { store_v(vbuf + ((i + 1) & 1) * ATT_VBUF, vf, lane);
#pragma unroll
                    for (int kk = 0; kk < 4; ++kk) kf[kk] = kn[kk]; }
            }
        } else {
            const int q0 = 64 * sub; tokq = b * SEQ + q0 + ql; goff = 512;
            const int kvh = wave >> 2, koff = 2048 + kvh * 64, voff = 2176 + kvh * 64;
            bf16x8 qB[4];
#pragma unroll
            for (int kk = 0; kk < 4; ++kk) qB[kk] = *(const bf16x8*)(proj + (size_t)(tokq + 32) * NIN + 1536 + wave * 64 + 32 * h + 8 * kk);
            st.m = sink[wave] * LOG2E; st.l = (h == 0) ? 1.f : 0.f; stB.m = st.m; stB.l = st.l;
            const int tlo = max(0, (128 - q0) / 32), thi = min(9, (SEQ - 1 - (q0 - 128)) / 32);
            for (int t = tlo, i = 0; t <= thi; ++t, ++i) {
                if (t + 1 <= thi) { BlkDesc d; d.base = b * SEQ + q0 - 128 + 32 * (t + 1); d.hs = 0; load_k(kn, proj, koff, d, ql, h); load_v(vf, proj, voff, d, lane); }
                const unsigned va = vb0 + (unsigned)((i & 1) * ATT_VBUF) + trb;
                if (t <= 8) { f32x16 s = qk_scores(kf, qf); if (t == 0 || t == 8) { SwXf xf{0, ql, h, 32 * t - 128}; xf.apply(s); } attn_softmax_pv(s, st, va); }
                if (t >= 1) { f32x16 s = qk_scores(kf, qB); if (t == 1 || t == 9) { SwXf xf{0, ql, h, 32 * t - 160}; xf.apply(s); } attn_softmax_pv(s, stB, va); }
                if (t + 1 <= thi) { store_v(vbuf + ((i + 1) & 1) * ATT_VBUF, vf, lane);
#pragma unroll
                    for (int kk = 0; kk < 4; ++kk) kf[kk] = kn[kk]; }
            }
        }
        bf16x8 qn[4];
        const UnitPre pn = unit_pre(it + 1, G, bid, wave, ql);
        if (pn.valid) {
#pragma unroll
            for (int kk = 0; kk < 4; ++kk) qn[kk] = *(const bf16x8*)(proj + (size_t)pn.tokq * NIN + pn.qoff + 32 * h + 8 * kk);
            load_k(kn, proj, pn.koff, pn.d0, ql, h); load_v(vf, proj, pn.voff, pn.d0, lane); }
        const float ssA = attn_norm_l(st), ssB = ud.swp ? attn_norm_l(stB) : 0.f;
        LAS float* rp = red + (it & 1) * 512;
        if (h == 0) { rp[wave * 64 + ql] = ssA; rp[wave * 64 + 32 + ql] = ssB; }
        __syncthreads();
        float totA = 0.f, totB = 0.f;
#pragma unroll
        for (int w = 0; w < 8; ++w) { totA += rp[w * 64 + ql]; totB += rp[w * 64 + 32 + ql]; }
        bf16_t* op = ao + (size_t)tokq * DM + goff + wave * 64 + 4 * h;
        attn_store(st, 1.f / sqrtf(totA * (1.f / 512.f) + EPS), op);
        if (ud.swp) attn_store(stB, 1.f / sqrtf(totB * (1.f / 512.f) + EPS), op + (size_t)32 * DM);
        if (pn.valid) {
#pragma unroll
            for (int kk = 0; kk < 4; ++kk) { qf[kk] = qn[kk]; kf[kk] = kn[kk]; } }
    }
    __syncthreads();
}

#define XB_TMO      128
#define XB_XCNT(j)  (256  + 64 * (j))
#define XB_XSUB(j)  (1280 + 64 * (j))
#define XB_XGEN(j)  (2304 + 64 * (j))
#define XB_TOP      3328
#define XB_TOPGEN   3392
#define XCD_BAR_WORDS 3456
#define XB_SPIN_CAP (1u << 18)

__device__ __forceinline__ unsigned xb_ld(unsigned* p)              { return __hip_atomic_load(p, __ATOMIC_RELAXED, __HIP_MEMORY_SCOPE_AGENT); }
__device__ __forceinline__ unsigned xb_add(unsigned* p, unsigned v) { return __hip_atomic_fetch_add(p, v, __ATOMIC_RELAXED, __HIP_MEMORY_SCOPE_AGENT); }
__device__ __forceinline__ unsigned xb_xcc_id() { return (unsigned)__builtin_amdgcn_s_getreg((3 << 11) | 20) & 0xFu; }
#define XB_SPIN(cond, bar) do { unsigned _sp = 0; while (cond) { __builtin_amdgcn_s_sleep(1); \
    if ((++_sp & 255u) == 0u) { if (xb_ld(&(bar)[XB_TMO])) break; if (_sp > XB_SPIN_CAP) { atomicAdd(&(bar)[XB_TMO], 1u); break; } } } } while (0)

struct XcdBarrier {
    unsigned* bar; unsigned x;
    volatile LAS unsigned* st;
};

__device__ __forceinline__ XcdBarrier xcd_barrier_post(unsigned* bar, volatile LAS unsigned* st) {
    XcdBarrier b; b.bar = bar; b.x = xb_xcc_id(); b.st = st;
    if (threadIdx.x == 0) (void)xb_add(&bar[XB_XCNT(b.x)], 1u);
    return b;
}
__device__ __forceinline__ void xcd_barrier_complete(unsigned* bar, unsigned x, unsigned& nloc, unsigned& nx) {
    const unsigned G = gridDim.x * gridDim.y * gridDim.z;
    unsigned sum, cnt, mine, sp = 0u;
    for (;;) {
        sum = 0u; cnt = 0u; mine = 0u;
#pragma unroll
        for (unsigned j = 0; j < 16; ++j) { const unsigned c = xb_ld(&bar[XB_XCNT(j)]); sum += c; cnt += (c > 0u) ? 1u : 0u; mine = (j == x) ? c : mine; }
        if (sum == G) break;
        __builtin_amdgcn_s_sleep(1);
        if ((++sp & 255u) == 0u) { if (xb_ld(&bar[XB_TMO])) break; if (sp > XB_SPIN_CAP) { atomicAdd(&bar[XB_TMO], 1u); break; } }
    }
    nloc = mine > 0u ? mine : 1u; nx = cnt > 0u ? cnt : 1u;
}

__device__ __forceinline__ void xcd_barrier(const XcdBarrier& b) {
    asm volatile("s_waitcnt vmcnt(0)" ::: "memory");
    __syncthreads();
    if (threadIdx.x == 0) {
        unsigned* bar = b.bar;
        __builtin_amdgcn_s_waitcnt(0);
        unsigned nloc = b.st[0], nx = b.st[1];
        if (nloc == 0u) { xcd_barrier_complete(bar, b.x, nloc, nx); b.st[0] = nloc; b.st[1] = nx; }
        const unsigned old = xb_add(&bar[XB_XSUB(b.x)], 1u);
        const unsigned gen = old / nloc;
        if (old + 1u == (gen + 1u) * nloc) {
            __builtin_amdgcn_fence(__ATOMIC_RELEASE, "agent");
            asm volatile("s_waitcnt vmcnt(0)" ::: "memory");
            const unsigned og = xb_add(&bar[XB_TOP], 1u);
            const unsigned tg = og / nx;
            if (og + 1u == (tg + 1u) * nx) xb_add(&bar[XB_TOPGEN], 1u);
            else XB_SPIN(xb_ld(&bar[XB_TOPGEN]) == tg, bar);
            __builtin_amdgcn_fence(__ATOMIC_ACQUIRE, "agent");
            xb_add(&bar[XB_XGEN(b.x)], 1u);
            asm volatile("s_waitcnt vmcnt(0)" ::: "memory");
        } else {
            XB_SPIN(xb_ld(&bar[XB_XGEN(b.x)]) == gen, bar);
            __builtin_amdgcn_fence(__ATOMIC_ACQUIRE, "agent");
            asm volatile("s_waitcnt vmcnt(0)" ::: "memory");
        }
    }
    __syncthreads();
}


__device__ __forceinline__ unsigned f2bf(float f) { unsigned u = __builtin_bit_cast(unsigned, f); return (u + 0x7fffu + ((u >> 16) & 1u)) >> 16; }
__device__ __forceinline__ unsigned pk2(float lo, float hi) { return f2bf(lo) | (f2bf(hi) << 16); }
template <int MAP> __device__ __forceinline__ int rowmap(int n) {
    if (MAP == 1) { if (n < 1536 || n >= 2176) return n; const int e = n - 1536, hh = e >> 6, d = e & 63, dd = d & 31, Gq = dd >> 2, i = dd & 3; return 1536 + 64 * hh + 8 * Gq + (d >= 32 ? 4 : 0) + i; }
    if (MAP == 2) { const int g = (n >= DFF) ? 1 : 0, ff = n - g * DFF; return 256 * (ff >> 7) + 128 * g + (ff & 127); }
    return n;
}
template <int MAP> __device__ __forceinline__ void transpose_item(const float* __restrict__ W, int K, int N, bf16_t* __restrict__ WT, const float* __restrict__ kscale, LAS float* scr, int item, int lane) {
    const int nblk = N / 32, kb = item / nblk, nb = item % nblk, k0 = 64 * kb, n0 = 32 * nb;
#pragma unroll
    for (int i = 0; i < 32; ++i) { const int kk = 2 * i + (lane >> 5); float v = W[(size_t)(k0 + kk) * N + n0 + (lane & 31)]; if (kscale) v *= kscale[k0 + kk]; scr[kk * 33 + (lane & 31)] = v; }
    asm volatile("s_waitcnt lgkmcnt(0)" ::: "memory");
    const int c = lane & 7;
#pragma unroll
    for (int j = 0; j < 4; ++j) { const int n = (lane >> 3) + 8 * j; const LAS float* s = scr + (8 * c) * 33 + n;
        u32x4 o; o.x = pk2(s[0 * 33], s[1 * 33]); o.y = pk2(s[2 * 33], s[3 * 33]); o.z = pk2(s[4 * 33], s[5 * 33]); o.w = pk2(s[6 * 33], s[7 * 33]);
        *(u32x4*)(WT + (size_t)rowmap<MAP>(n0 + n) * K + k0 + 8 * c) = o; }
    asm volatile("s_waitcnt lgkmcnt(0)" ::: "memory");
}
struct CvItem { const float* W; bf16_t* WT; const float* ks; int K, N, map, item; };
__device__ __forceinline__ void cv_load(float (&v)[32], const CvItem& c, int lane) {
    const int nblk = c.N / 32, kb = c.item / nblk, nb = c.item - kb * nblk, k0 = 64 * kb, n0 = 32 * nb;
    const float* p = c.W + (size_t)(k0 + (lane >> 5)) * c.N + n0 + (lane & 31);
#pragma unroll
    for (int i = 0; i < 32; ++i) v[i] = p[(size_t)(2 * i) * c.N];
}
__device__ __forceinline__ void cv_finish(const float (&v)[32], const CvItem& c, LAS float* scr, int lane) {
    const int nblk = c.N / 32, kb = c.item / nblk, nb = c.item - kb * nblk, k0 = 64 * kb, n0 = 32 * nb;
    if (c.ks) {
#pragma unroll
        for (int i = 0; i < 32; ++i) { const int kk = 2 * i + (lane >> 5); scr[kk * 33 + (lane & 31)] = v[i] * c.ks[k0 + kk]; } }
    else {
#pragma unroll
        for (int i = 0; i < 32; ++i) { const int kk = 2 * i + (lane >> 5); scr[kk * 33 + (lane & 31)] = v[i]; } }
    asm volatile("s_waitcnt lgkmcnt(0)" ::: "memory");
    const int cc = lane & 7;
#pragma unroll
    for (int j = 0; j < 4; ++j) { const int n = (lane >> 3) + 8 * j; const LAS float* sp = scr + (8 * cc) * 33 + n;
        u32x4 o; o.x = pk2(sp[0 * 33], sp[1 * 33]); o.y = pk2(sp[2 * 33], sp[3 * 33]); o.z = pk2(sp[4 * 33], sp[5 * 33]); o.w = pk2(sp[6 * 33], sp[7 * 33]);
        const int nn = n0 + n, row = (c.map == 1) ? rowmap<1>(nn) : ((c.map == 2) ? rowmap<2>(nn) : nn);
        *(u32x4*)(c.WT + (size_t)row * c.K + k0 + 8 * cc) = o; }
    asm volatile("s_waitcnt lgkmcnt(0)" ::: "memory");
}
template <int MODE> __device__ __forceinline__ void row_phase(const float* src, bf16_t* dst, float* io, const float* __restrict__ g, const float* __restrict__ mod, int shift_off, int scale_off) {
    const int lane = threadIdx.x & 63, gw = blockIdx.x * 8 + (threadIdx.x >> 6), NGW = gridDim.x * 8, rpw = MTOK / NGW, m_beg = gw * rpw, m_end = (gw == NGW - 1) ? MTOK : m_beg + rpw;
    const float* base = (MODE == 0) ? src : io;
    for (int m0 = m_beg; m0 < m_end; m0 += 4) {
        f32x4 cur[4][4];
#pragma unroll
        for (int r = 0; r < 4; ++r)
#pragma unroll
            for (int j = 0; j < 4; ++j) cur[r][j] = ((const f32x4*)(base + (size_t)min(m0 + r, MTOK - 1) * DM) + lane)[64 * j];
        const int b = m0 >> 11;
        f32x4 gv[4], sc[4], sh[4];
#pragma unroll
        for (int j = 0; j < 4; ++j) { const int c = 4 * lane + 256 * j; gv[j] = *(const f32x4*)(g + c);
            if (MODE == 0) { sc[j] = *(const f32x4*)(mod + b * 6144 + scale_off + c) + 1.f; sh[j] = *(const f32x4*)(mod + b * 6144 + shift_off + c); } }
        float ss[4];
#pragma unroll
        for (int r = 0; r < 4; ++r) { ss[r] = 0.f;
#pragma unroll
            for (int j = 0; j < 4; ++j) { const f32x4 v = cur[r][j]; ss[r] += (v.x * v.x + v.y * v.y) + (v.z * v.z + v.w * v.w); } }
#pragma unroll
        for (int o = 1; o < 64; o <<= 1) {
#pragma unroll
            for (int r = 0; r < 4; ++r) ss[r] += __shfl_xor(ss[r], o); }
#pragma unroll
        for (int r = 0; r < 4; ++r) {
            const int m = m0 + r; if (m >= m_end) break;
            const float rstd = 1.f / sqrtf(ss[r] * (1.f / DM) + EPS);
            if (MODE == 0) { unsigned long long* o8 = (unsigned long long*)(dst + (size_t)m * DM) + lane;
#pragma unroll
                for (int j = 0; j < 4; ++j) { const f32x4 y = cur[r][j] * rstd * gv[j] * sc[j] + sh[j]; o8[64 * j] = (unsigned long long)(cvt_pk_bf16(y.x, y.y)) | ((unsigned long long)cvt_pk_bf16(y.z, y.w) << 32); } }
            else { f32x4* xr = (f32x4*)(io + (size_t)m * DM) + lane;
#pragma unroll
                for (int j = 0; j < 4; ++j) xr[64 * j] = cur[r][j] * rstd * gv[j]; }
        }
    }
}
template <int MODE> __device__ __forceinline__ void row_phase_b16(const bf16_t* src, bf16_t* dst, float* outf, const float* __restrict__ g, const float* __restrict__ mod, int shift_off, int scale_off) {
    const int lane = threadIdx.x & 63, gw = blockIdx.x * 8 + (threadIdx.x >> 6), NGW = gridDim.x * 8, rpw = MTOK / NGW, m_beg = gw * rpw, m_end = (gw == NGW - 1) ? MTOK : m_beg + rpw;
    for (int m0 = m_beg; m0 < m_end; m0 += 4) {
        u32x4 raw[4][2];
#pragma unroll
        for (int r = 0; r < 4; ++r) { const bf16_t* p = src + (size_t)min(m0 + r, MTOK - 1) * DM + 8 * lane; raw[r][0] = *(const u32x4*)p; raw[r][1] = *(const u32x4*)(p + 512); }
        const int b = m0 >> 11;
        f32x4 gv[4], sc[4], sh[4];
#pragma unroll
        for (int j = 0; j < 4; ++j) { const int c = (j >> 1) * 512 + 8 * lane + 4 * (j & 1); gv[j] = *(const f32x4*)(g + c);
            if (MODE == 0) { sc[j] = *(const f32x4*)(mod + b * 6144 + scale_off + c) + 1.f; sh[j] = *(const f32x4*)(mod + b * 6144 + shift_off + c); } }
        f32x4 cur[4][4]; float ss[4];
#pragma unroll
        for (int r = 0; r < 4; ++r) { ss[r] = 0.f;
#pragma unroll
            for (int j = 0; j < 4; ++j) { const unsigned w0 = raw[r][j >> 1][2 * (j & 1)], w1 = raw[r][j >> 1][2 * (j & 1) + 1];
                const f32x4 v = (f32x4){__builtin_bit_cast(float, w0 << 16), __builtin_bit_cast(float, w0 & 0xffff0000u), __builtin_bit_cast(float, w1 << 16), __builtin_bit_cast(float, w1 & 0xffff0000u)};
                cur[r][j] = v; ss[r] += (v.x * v.x + v.y * v.y) + (v.z * v.z + v.w * v.w); } }
#pragma unroll
        for (int o = 1; o < 64; o <<= 1) {
#pragma unroll
            for (int r = 0; r < 4; ++r) ss[r] += __shfl_xor(ss[r], o); }
#pragma unroll
        for (int r = 0; r < 4; ++r) {
            const int m = m0 + r; if (m >= m_end) break;
            const float rstd = 1.f / sqrtf(ss[r] * (1.f / DM) + EPS);
            if (MODE == 0) {
#pragma unroll
                for (int hf = 0; hf < 2; ++hf) { const f32x4 y0 = cur[r][2 * hf] * rstd * gv[2 * hf] * sc[2 * hf] + sh[2 * hf], y1 = cur[r][2 * hf + 1] * rstd * gv[2 * hf + 1] * sc[2 * hf + 1] + sh[2 * hf + 1];
                    u32x4 w; w.x = cvt_pk_bf16(y0.x, y0.y); w.y = cvt_pk_bf16(y0.z, y0.w); w.z = cvt_pk_bf16(y1.x, y1.y); w.w = cvt_pk_bf16(y1.z, y1.w);
                    *(u32x4*)(dst + (size_t)m * DM + hf * 512 + 8 * lane) = w; } }
            else {
#pragma unroll
                for (int j = 0; j < 4; ++j) *(f32x4*)(outf + (size_t)m * DM + (j >> 1) * 512 + 8 * lane + 4 * (j & 1)) = cur[r][j] * rstd * gv[j]; }
        }
    }
}
__device__ __forceinline__ void fixup_panel(int pm, const float* __restrict__ SB, bf16_t* ACT, const float* __restrict__ cw) {
    constexpr int NITEM = 8 * (DFF / 4);
#pragma unroll 1
    for (int e0 = threadIdx.x; e0 < NITEM; e0 += 4 * 512) {
        f32x4 gc[4], val[4], nbr[4], wv[4];
#pragma unroll
        for (int q = 0; q < 4; ++q) {
            const int e = min(e0 + q * 512, NITEM - 1), rr = e / (DFF / 4), c4 = (e % (DFF / 4)) * 4, chunk = 4 * pm + (rr >> 1), which = rr & 1;
            const float* sb = SB + ((size_t)(chunk * 2 + which) * 3) * DFF + c4;
            gc[q] = *(const f32x4*)sb; val[q] = *(const f32x4*)(sb + DFF);
            const bool has = which == 0 ? ((chunk & 31) != 0) : ((chunk & 31) != 31);
            const int nchunk = has ? (which == 0 ? chunk - 1 : chunk + 1) : chunk;
            nbr[q] = *(const f32x4*)(SB + ((size_t)(nchunk * 2 + (which ^ 1)) * 3 + 2) * DFF + c4);
            wv[q] = *(const f32x4*)(cw + (which == 0 ? 0 : 2 * DFF) + c4);
            if (!has) wv[q] = (f32x4){0.f, 0.f, 0.f, 0.f};
        }
#pragma unroll
        for (int q = 0; q < 4; ++q) {
            const int e = e0 + q * 512; if (e >= NITEM) break;
            const int rr = e / (DFF / 4), c4 = (e % (DFF / 4)) * 4, chunk = 4 * pm + (rr >> 1), which = rr & 1;
            const f32x4 g2 = gc[q] + wv[q] * nbr[q];
            float a[4];
#pragma unroll
            for (int j = 0; j < 4; ++j) a[j] = g2[j] * val[q][j] * __builtin_amdgcn_rcpf(1.f + __builtin_amdgcn_exp2f(-LOG2E * g2[j]));
            u32x2 w; w.x = cvt_pk_bf16(a[0], a[1]); w.y = cvt_pk_bf16(a[2], a[3]);
            *(u32x2*)(ACT + (size_t)(chunk * 64 + which * 63) * DFF + c4) = w;
        }
    }
}

struct Args { const float* in[17]; float* out; unsigned char* ws; int ph_lo, ph_hi; };
static_assert(sizeof(Args) == 17 * 8 + 8 + 8 + 8, "Args has no padding");

__global__ void __launch_bounds__(512, 2) fwd_megakernel(Args args) {
    extern __shared__ __attribute__((aligned(16))) unsigned char lds_raw[];
    LAS unsigned char* lds = (LAS unsigned char*)lds_raw;
    cg::grid_group grid = cg::this_grid();
    const int tid = threadIdx.x, wave = __builtin_amdgcn_readfirstlane(tid >> 6), lane = tid & 63, G = gridDim.x, bid = blockIdx.x;
    const float* x = args.in[0]; const float* cvec = args.in[1]; const float* w_ada = args.in[2]; const float* b_ada = args.in[3]; const float* g_attn = args.in[4];
    const float* w_in = args.in[5]; const float* rpb = args.in[6]; const float* sink = args.in[7]; const float* g_na = args.in[8]; const float* g_sw = args.in[9];
    const float* w_out = args.in[10]; const float* g_ffn = args.in[11]; const float* w_up = args.in[12]; const float* conv_w = args.in[13]; const float* conv_b = args.in[14];
    const float* w_down = args.in[15]; const float* g_final = args.in[16];
    unsigned char* ws = args.ws; float* out = args.out;
    float* mod = (float*)(ws + WS_MOD); float* costab = (float*)(ws + WS_COS); float* sintab = (float*)(ws + WS_SIN);
    bf16_t* Win = (bf16_t*)(ws + WS_WIN); bf16_t* Wout = (bf16_t*)(ws + WS_WOUT); bf16_t* Wup = (bf16_t*)(ws + WS_WUP); bf16_t* Wdn = (bf16_t*)(ws + WS_WDN);
    bf16_t* H = (bf16_t*)(ws + WS_H); bf16_t* PROJ = (bf16_t*)(ws + WS_PROJ); bf16_t* AO = (bf16_t*)(ws + WS_AO); bf16_t* ACT = (bf16_t*)(ws + WS_ACT); float* SB = (float*)(ws + WS_SB); bf16_t* X1B = (bf16_t*)(ws + WS_X1B);
    const int lo = args.ph_lo, hi = args.ph_hi;
    volatile LAS unsigned* barst = (volatile LAS unsigned*)(lds + LDS_BARST_OFF);
    if (tid < 2) barst[tid] = 0u;
    __syncthreads();
    XcdBarrier xbar = xcd_barrier_post((unsigned*)(ws + WS_BAR), barst);
#define IN(k) (lo <= (k) && (k) < hi)
#define SEAM(k) do { if (IN(k) && IN((k) + 1)) { if (args.ph_hi > 1000) grid.sync(); else xcd_barrier(xbar); } } while (0)

    if (IN(0)) {
        {
            const int gi = bid * 512 + tid;
            for (int e = gi; e < SEQ * 32; e += G * 512) { const int pos = e >> 5, f = e & 31;
                const float inv = powf(10000.f, -(float)f / 32.f); const float ang = (float)pos * inv;
                costab[e] = cosf(ang); sintab[e] = sinf(ang); }
        }
        if (bid < 192) {
            LAS float* sc = (LAS float*)lds; LAS float* red = (LAS float*)(lds + 65536);
#pragma unroll 8
            for (int i = tid; i < NB * DM; i += 512) { const float v = cvec[i]; sc[i] = v / (1.f + __expf(-v)); }
            __syncthreads();
            const int n0 = 32 * bid, col = lane & 31, par = lane >> 5;
            float acc[16];
#pragma unroll
            for (int b = 0; b < 16; ++b) acc[b] = 0.f;
            const float* wp = w_ada + n0 + col;
#pragma unroll 8
            for (int kk = 0; kk < 64; ++kk) { const int k = wave * 128 + kk * 2 + par; const float w = wp[(size_t)k * 6144];
#pragma unroll
                for (int b = 0; b < 16; ++b) acc[b] += sc[b * DM + k] * w; }
#pragma unroll
            for (int b = 0; b < 16; ++b) red[((wave * 2 + par) * 16 + b) * 32 + col] = acc[b];
            __syncthreads();
            { const int b = tid >> 5, cc = tid & 31; float s = b_ada[n0 + cc];
#pragma unroll
              for (int g = 0; g < 16; ++g) s += red[(g * 16 + b) * 32 + cc];
              mod[b * 6144 + n0 + cc] = s; }
            __syncthreads();
        }
        {
            LAS float* scr = (LAS float*)(lds + wave * 16384);
            constexpr int I_IN = (DM / 64) * (NIN / 32), I_OUT = (DM / 64) * (DM / 32), I_UP = (DM / 64) * (NUP / 32), I_DN = (DFF / 64) * (DM / 32);
            const bool late_up = (G == 256);
            const int nit = I_IN + I_OUT + I_DN + (late_up ? 0 : I_UP);
            int first, step, lim;
            if (late_up) { if (bid >= 192) { first = (bid - 192) * 8 + wave; step = 512; lim = nit; } else { first = 0; step = 1; lim = 0; } }
            else { first = bid * 8 + wave; step = G * 8; lim = nit; }
            auto mk = [&](int it) { CvItem c; int r = it;
                if (r < I_IN) { c.W = w_in; c.WT = Win; c.ks = nullptr; c.K = DM; c.N = NIN; c.map = 1; c.item = r; return c; } r -= I_IN;
                if (r < I_OUT) { const int kb = r / (DM / 32); c.W = w_out; c.WT = Wout; c.ks = (kb < 8) ? g_na : (g_sw - 512); c.K = DM; c.N = DM; c.map = 0; c.item = r; return c; } r -= I_OUT;
                if (r < I_DN) { c.W = w_down; c.WT = Wdn; c.ks = nullptr; c.K = DFF; c.N = DM; c.map = 0; c.item = r; return c; } r -= I_DN;
                c.W = w_up; c.WT = Wup; c.ks = nullptr; c.K = DM; c.N = NUP; c.map = 2; c.item = r; return c; };
            if (first < lim) {
                float va[32], vb[32];
                CvItem ca = mk(first), cb = ca; cv_load(va, ca, lane);
#pragma unroll 1
                for (int it = first;;) {
                    const int i1 = it + step; const bool m1 = i1 < lim;
                    if (m1) { cb = mk(i1); cv_load(vb, cb, lane); }
                    cv_finish(va, ca, scr, lane);
                    if (!m1) break;
                    const int i2 = i1 + step; const bool m2 = i2 < lim;
                    if (m2) { ca = mk(i2); cv_load(va, ca, lane); }
                    cv_finish(vb, cb, scr, lane);
                    if (!m2) break;
                    it = i2;
                }
            }
        }
    }
    SEAM(0);
    if (IN(1)) row_phase<0>(x, H, nullptr, g_attn, mod, 0, 1024);
    SEAM(1);
    if (IN(2)) {
        Gemm g{H, Win, MTOK, NIN, DM}; StaticOrder S; S.init(MTOK, NIN, G, bid);
        EpiIn E{PROJ, costab, sintab};
        gemm_phase<EpiIn, StaticOrder, true, true>(lds, g, S, E);
        if (G == 256 && bid >= 128) {
            __syncthreads();
            LAS float* scr = (LAS float*)(lds + wave * 16384);
            constexpr int I_UPc = (DM / 64) * (NUP / 32);
            float va[32], vb[32];
            CvItem ca{w_up, Wup, nullptr, DM, NUP, 2, (bid - 128) * 8 + wave}, cb = ca;
            cv_load(va, ca, lane);
#pragma unroll 1
            for (;;) {
                const bool m1 = ca.item + 1024 < I_UPc;
                if (m1) { cb.item = ca.item + 1024; cv_load(vb, cb, lane); }
                cv_finish(va, ca, scr, lane);
                if (!m1) break;
                const bool m2 = cb.item + 1024 < I_UPc;
                if (m2) { ca.item = cb.item + 1024; cv_load(va, ca, lane); }
                cv_finish(vb, cb, scr, lane);
                if (!m2) break;
            }
        }
    }
    SEAM(2);
    if (IN(3)) attn_phase(lds, PROJ, AO, rpb, sink);
    SEAM(3);
    if (IN(4)) {
        Gemm g{AO, Wout, MTOK, DM, DM}; StaticOrder S; S.init(MTOK, DM, G, bid);
        EpiResB<false> E{x, X1B, mod + 2048};
        gemm_phase<EpiResB<false>, StaticOrder, true, true>(lds, g, S, E);
    }
    SEAM(4);
    if (IN(5)) row_phase_b16<0>(X1B, H, nullptr, g_ffn, mod, 3072, 4096);
    SEAM(5);
    if (IN(6)) {
        Gemm g{H, Wup, MTOK, NUP, DM}; StaticOrder S; S.init(MTOK, NUP, G, bid);
        EpiUp E{ACT, SB, conv_w, conv_b};
        gemm_phase<EpiUp, StaticOrder, true, true, true>(lds, g, S, E);
    }
    SEAM(6);
    if (IN(7)) {
        StaticOrder S; S.init(MTOK, DM, G, bid);
        { Unit u; for (int i = 0; S.next(i, u); ++i) fixup_panel(u.pm, SB, ACT, conv_w); }
        __threadfence(); __syncthreads();
        Gemm g{ACT, Wdn, MTOK, DM, DFF};
        EpiResB<true> E{X1B, X1B, mod + 5120};
        gemm_phase<EpiResB<true>, StaticOrder, true, true>(lds, g, S, E);
    }
    SEAM(7);
    if (IN(8)) row_phase_b16<1>(X1B, nullptr, out, g_final, nullptr, 0, 0);
#undef IN
#undef SEAM
}

#ifndef N_LAUNCH_SPLIT
#define N_LAUNCH_SPLIT 0
#endif
extern "C" void kernel_launch(void* const* d_in, const int* in_sizes, int n_in, void* d_out, int out_size, void* d_ws, size_t ws_size, hipStream_t stream) {
    static int grid_blocks = 0;
    if (grid_blocks == 0) {
        if (n_in != 17 || out_size != MTOK * DM || ws_size < WS_END) { fprintf(stderr, "kernel_launch: unexpected shapes (n_in %d out %d ws %zu)\n", n_in, out_size, ws_size); grid_blocks = -1; return; }
        int dev = 0, cus = 0, per_cu = 0;
        hipGetDevice(&dev); hipDeviceGetAttribute(&cus, hipDeviceAttributeMultiprocessorCount, dev);
        if (hipFuncSetAttribute((const void*)fwd_megakernel, hipFuncAttributeMaxDynamicSharedMemorySize, LDS_BYTES) != hipSuccess) { fprintf(stderr, "kernel_launch: hipFuncSetAttribute failed\n"); grid_blocks = -1; return; }
        if (hipOccupancyMaxActiveBlocksPerMultiprocessor(&per_cu, (const void*)fwd_megakernel, 512, LDS_BYTES) != hipSuccess || per_cu < 1) { fprintf(stderr, "kernel_launch: occupancy query failed (%d)\n", per_cu); per_cu = 1; (void)hipGetLastError(); }
        grid_blocks = cus * per_cu; if (grid_blocks > 256) grid_blocks = 256;
        fprintf(stderr, "kernel_launch: %d CUs x %d blocks -> grid %d\n", cus, per_cu, grid_blocks);
    }
    if (grid_blocks < 0) return;
    if (hipMemsetAsync((char*)d_ws + WS_BAR, 0, BAR_ZERO_BYTES, stream) != hipSuccess) { fprintf(stderr, "kernel_launch: memset failed\n"); return; }
    Args a{};
    for (int i = 0; i < 17; ++i) a.in[i] = (const float*)d_in[i];
    a.out = (float*)d_out; a.ws = (unsigned char*)d_ws;
#if N_LAUNCH_SPLIT
    for (int p = 0; p < 9; ++p) { a.ph_lo = p; a.ph_hi = p + 1; void* kargs[] = {&a};
        hipError_t e = hipLaunchCooperativeKernel((const void*)fwd_megakernel, dim3(grid_blocks), dim3(512), kargs, LDS_BYTES, stream);
        if (e != hipSuccess) { fprintf(stderr, "cooperative launch (phase %d) failed: %s\n", p, hipGetErrorString(e)); return; } }
#else
    a.ph_lo = 0; a.ph_hi = 9; void* kargs[] = {&a};
    hipError_t e = hipLaunchCooperativeKernel((const void*)fwd_megakernel, dim3(grid_blocks), dim3(512), kargs, LDS_BYTES, stream);
    if (e != hipSuccess) fprintf(stderr, "cooperative launch failed: %s (grid %d)\n", hipGetErrorString(e), grid_blocks);
#endif
}
```

```cpp
#include <hip/hip_runtime.h>
#include <hip/hip_cooperative_groups.h>
#include <cstdio>
#include <cstdint>
namespace cg = cooperative_groups;
namespace pg8 {
#define PG8_LAS __attribute__((address_space(3)))
typedef unsigned short bf16_t;
typedef short bf16x8 __attribute__((ext_vector_type(8)));
typedef float f32x4 __attribute__((ext_vector_type(4)));
typedef unsigned u32x4 __attribute__((ext_vector_type(4)));
constexpr int BM = 256, BK = 64, HALF = 128, HTB = HALF * BK * 2  , STAGE_BYTES = 8 * HTB, NXCD = 8, WGM = 8;

__host__ __device__ __forceinline__ int lds_byte(int r, int c) { const int st = (r >> 4) * 2 + (c >> 5), rr = r & 15, cc = c & 31, ob = rr * 64 + cc * 2; return st * 1024 + (ob ^ (((ob >> 9) & 1) << 5)); }
__host__ __device__ __forceinline__ void stage_rc(int b, int& R, int& C) { const int st = b / 1024, sb = b % 1024, swz = sb ^ (((sb >> 9) & 1) << 5); R = (st >> 1) * 16 + swz / 64; C = (st & 1) * 32 + (swz % 64) / 2; }
__host__ __device__ __forceinline__ int perm32(int rho) { const int n = rho >> 4, i = rho & 15; return 8 * (i >> 2) + 4 * n + (i & 3); }

struct Unit { int pm, pn; };
struct Gemm { const bf16_t* A; const bf16_t* Bt; int M, N, K; };

struct StaticOrder {
    int nM, nN, nwg, G, c;
    __host__ __device__ void init(int M, int N, int G_, int c_) { nM = M / BM; nN = N / BM; nwg = nM * nN; G = G_; c = c_; }
    __host__ __device__ bool next(int i, Unit& u) const {
        const long L = (long)i * G + c; if (L >= nwg) return false;
        int wgid = (int)L; { const int q = nwg / NXCD, r = nwg % NXCD, xcd = wgid % NXCD, off = wgid / NXCD; wgid = (xcd < r ? xcd * (q + 1) : r * (q + 1) + (xcd - r) * q) + off; }
        const int nig = WGM * nN, gid = wgid / nig, fm = gid * WGM, gsz = (nM - fm) < WGM ? (nM - fm) : WGM;
        u.pm = fm + ((wgid % nig) % gsz); u.pn = (wgid % nig) / gsz; return true;
    }
    __device__ __forceinline__ void a_ready(const Unit&) const {}
    __device__ __forceinline__ void done(const Unit&) const {}
};

__device__ __forceinline__ unsigned cvt_pk_bf16(float lo, float hi) { unsigned r; asm volatile("v_cvt_pk_bf16_f32 %0, %1, %2" : "=v"(r) : "v"(lo), "v"(hi)); return r; }
__device__ __forceinline__ void store16_wt(void* p, u32x4 v) { asm volatile("global_store_dwordx4 %0, %1, off sc1\n\ts_nop 2" :: "v"(p), "v"(v) : "memory");     }
typedef float f32x2 __attribute__((ext_vector_type(2)));
template <class Epi, class Sched, bool ALIGN_EPI = false, bool SP2 = false, bool ROWPERM = false>
__device__ __forceinline__ void gemm_phase(PG8_LAS unsigned char* lds, const Gemm g, const Sched& S, const Epi& E) {
    const int tid = threadIdx.x, wid = __builtin_amdgcn_readfirstlane(tid >> 6), lane = tid & 63, wr = wid >> 2, wc = wid & 3, fr = lane & 15, fq = lane >> 4;
    const int K = g.K, nt = K / BK;
    unsigned voffA[2], voffB[2];
#pragma unroll
    for (int i = 0; i < 2; ++i) { int R, C; stage_rc(tid * 16 + i * 8192, R, C); const int Rb = Epi::PERM ? ((R & ~31) + perm32(R & 31)) : R;
        const int Ra = ROWPERM ? ((R & ~63) + 4 * (R & 15) + ((R >> 4) & 3)) : R;
        voffA[i] = (unsigned)(Ra * K + C) * 2u; voffB[i] = (unsigned)(Rb * K + C) * 2u; }
    const size_t kstep = (size_t)(BK * 2);
    const size_t hstep = (size_t)HALF * K * 2;
    const size_t tstep = 2 * hstep;
    const unsigned ldsw = (unsigned)wid * 1024u;
    const int aoff = lds_byte(wr * 64 + fr, fq * 8), boff = lds_byte(wc * 32 + fr, fq * 8);
#define PG8_SA(b, h) (((b) * 2 + (h)) * HTB)
#define PG8_SB(b, h) ((4 + (b) * 2 + (h)) * HTB)
#define PG8_STAGE(bufoff, gbase, voff) do { _Pragma("unroll") for (int _i = 0; _i < 2; ++_i) \
        __builtin_amdgcn_global_load_lds((const unsigned*)((const char*)(gbase) + (voff)[_i]), (PG8_LAS unsigned*)(lds + (bufoff) + ldsw + _i * 8192), 16, 0, 0); } while (0)
#define PG8_LDA(dst, b, h) do { _Pragma("unroll") for (int m = 0; m < 4; ++m) _Pragma("unroll") for (int k = 0; k < 2; ++k) dst[m][k] = *(const PG8_LAS bf16x8*)(lds + PG8_SA(b, h) + aoff + m * 2048 + k * 1024); } while (0)
#define PG8_LDB(dst, b, h) do { _Pragma("unroll") for (int n = 0; n < 2; ++n) _Pragma("unroll") for (int k = 0; k < 2; ++k) dst[n][k] = *(const PG8_LAS bf16x8*)(lds + PG8_SB(b, h) + boff + n * 2048 + k * 1024); } while (0)
#define PG8_MMA(ai, bj, At, Bt) do { __builtin_amdgcn_s_setprio(1); _Pragma("unroll") for (int m = 0; m < 4; ++m) _Pragma("unroll") for (int n = 0; n < 2; ++n) _Pragma("unroll") for (int k = 0; k < 2; ++k) \
        acc[ai][bj][m][n] = __builtin_amdgcn_mfma_f32_16x16x32_bf16(Bt[n][k], At[m][k], acc[ai][bj][m][n], 0, 0, 0); __builtin_amdgcn_s_setprio(0); } while (0)
#define PG8_WAIT_V(n) asm volatile("s_waitcnt vmcnt(" #n ")" ::: "memory")
#define PG8_WAIT_L(n) asm volatile("s_waitcnt lgkmcnt(" #n ")" ::: "memory")
#define PG8_BAR __builtin_amdgcn_s_barrier()
#define PG8_SCHED __builtin_amdgcn_sched_barrier(0)
    Unit cur, nxt; int ui = 0;
    if (!S.next(0, cur)) return;
    f32x4 acc[2][2][4][2];
#pragma unroll
    for (int a = 0; a < 2; ++a)
#pragma unroll
        for (int b = 0; b < 2; ++b)
#pragma unroll
            for (int m = 0; m < 4; ++m)
#pragma unroll
                for (int n = 0; n < 2; ++n) acc[a][b][m][n] = (f32x4){0.f, 0.f, 0.f, 0.f};
    bf16x8 At[4][2], B0[2][2], B1[2][2];
    const char* cA = (const char*)g.A + (size_t)cur.pm * tstep; const char* cB = (const char*)g.Bt + (size_t)cur.pn * tstep;
    S.a_ready(cur);
    if constexpr (SP2) {
        PG8_STAGE(PG8_SB(0, 0), cB, voffB); PG8_STAGE(PG8_SB(0, 1), cB + hstep, voffB); PG8_STAGE(PG8_SA(0, 0), cA, voffA); PG8_STAGE(PG8_SA(0, 1), cA + hstep, voffA);
        if (wr == 1) PG8_BAR;
        PG8_WAIT_V(2); PG8_BAR;
        PG8_STAGE(PG8_SB(1, 0), cB + kstep, voffB); PG8_STAGE(PG8_SA(1, 0), cA + kstep, voffA); PG8_STAGE(PG8_SB(1, 1), cB + hstep + kstep, voffB);
        PG8_WAIT_V(6); PG8_BAR;
    } else {
        PG8_STAGE(PG8_SB(0, 0), cB, voffB); PG8_STAGE(PG8_SA(0, 0), cA, voffA); PG8_STAGE(PG8_SB(0, 1), cB + hstep, voffB); PG8_STAGE(PG8_SA(0, 1), cA + hstep, voffA);
        if (wr == 1) PG8_BAR;
        PG8_WAIT_V(4); PG8_BAR;
        PG8_STAGE(PG8_SB(1, 0), cB + kstep, voffB); PG8_STAGE(PG8_SA(1, 0), cA + kstep, voffA); PG8_STAGE(PG8_SB(1, 1), cB + hstep + kstep, voffB);
        PG8_WAIT_V(6); PG8_BAR;
    }
    for (;;) {
        const bool has_next = S.next(ui + 1, nxt);
        const char* nA = has_next ? (const char*)g.A + (size_t)nxt.pm * tstep : cA; const char* nB = has_next ? (const char*)g.Bt + (size_t)nxt.pn * tstep : cB;
        for (int t = 0; t < nt; t += 2) {
            const bool last = (t == nt - 2);
            const char* a1 = cA + (size_t)(t + 1) * kstep;
            const char* a2 = last ? nA : cA + (size_t)(t + 2) * kstep; const char* b2 = last ? nB : cB + (size_t)(t + 2) * kstep;
            const char* a3 = a2 + kstep; const char* b3 = b2 + kstep;
            if (last && has_next) S.a_ready(nxt);
            if constexpr (SP2) {
            PG8_LDB(B0, 0, 0); PG8_LDB(B1, 0, 1); PG8_SCHED; PG8_LDA(At, 0, 0); PG8_STAGE(PG8_SA(1, 1), a1 + hstep, voffA);
            PG8_WAIT_V(8); PG8_WAIT_L(0); PG8_BAR; PG8_MMA(0, 0, At, B0); PG8_MMA(0, 1, At, B1); PG8_BAR; PG8_SCHED;
            PG8_LDA(At, 0, 1); PG8_STAGE(PG8_SB(0, 0), b2, voffB); PG8_STAGE(PG8_SB(0, 1), b2 + hstep, voffB); PG8_STAGE(PG8_SA(0, 0), a2, voffA);
            PG8_WAIT_V(8); PG8_WAIT_L(0); PG8_BAR; PG8_MMA(1, 0, At, B0); PG8_MMA(1, 1, At, B1); PG8_BAR; PG8_SCHED;
            PG8_LDB(B0, 1, 0); PG8_LDB(B1, 1, 1); PG8_SCHED; PG8_LDA(At, 1, 0); PG8_STAGE(PG8_SA(0, 1), a2 + hstep, voffA);
            PG8_WAIT_V(8); PG8_WAIT_L(0); PG8_BAR; PG8_MMA(0, 0, At, B0); PG8_MMA(0, 1, At, B1); PG8_BAR; PG8_SCHED;
            PG8_LDA(At, 1, 1); PG8_STAGE(PG8_SB(1, 0), b3, voffB); PG8_STAGE(PG8_SB(1, 1), b3 + hstep, voffB); PG8_STAGE(PG8_SA(1, 0), a3, voffA);
            PG8_WAIT_V(8); PG8_WAIT_L(0); PG8_BAR; PG8_MMA(1, 0, At, B0); PG8_MMA(1, 1, At, B1); PG8_BAR; PG8_SCHED;
            } else {
            PG8_LDB(B0, 0, 0); PG8_SCHED; PG8_LDA(At, 0, 0); PG8_STAGE(PG8_SA(1, 1), a1 + hstep, voffA);
            PG8_WAIT_L(8); PG8_BAR; PG8_WAIT_L(0); PG8_MMA(0, 0, At, B0); PG8_BAR; PG8_SCHED;
            PG8_LDB(B1, 0, 1); PG8_STAGE(PG8_SB(0, 0), b2, voffB);
            PG8_BAR; PG8_WAIT_L(0); PG8_MMA(0, 1, At, B1); PG8_BAR;
            PG8_LDA(At, 0, 1); PG8_STAGE(PG8_SA(0, 0), a2, voffA);
            PG8_BAR; PG8_WAIT_L(0); PG8_MMA(1, 0, At, B0); PG8_BAR; PG8_SCHED;
            PG8_STAGE(PG8_SB(0, 1), b2 + hstep, voffB);
            PG8_WAIT_V(6); PG8_BAR; PG8_MMA(1, 1, At, B1); PG8_BAR;
            PG8_LDB(B0, 1, 0); PG8_SCHED; PG8_LDA(At, 1, 0); PG8_STAGE(PG8_SA(0, 1), a2 + hstep, voffA);
            PG8_WAIT_L(8); PG8_BAR; PG8_WAIT_L(0); PG8_MMA(0, 0, At, B0); PG8_BAR; PG8_SCHED;
            PG8_LDB(B1, 1, 1); PG8_STAGE(PG8_SB(1, 0), b3, voffB);
            PG8_BAR; PG8_WAIT_L(0); PG8_MMA(0, 1, At, B1); PG8_BAR;
            PG8_LDA(At, 1, 1); PG8_STAGE(PG8_SA(1, 0), a3, voffA);
            PG8_BAR; PG8_WAIT_L(0); PG8_MMA(1, 0, At, B0); PG8_BAR; PG8_SCHED;
            PG8_STAGE(PG8_SB(1, 1), b3 + hstep, voffB);
            PG8_WAIT_V(6); PG8_BAR; PG8_MMA(1, 1, At, B1); PG8_BAR;
            }
        }
        if constexpr (ALIGN_EPI) { if (wr == 0) PG8_BAR; }
        if constexpr (!Epi::AFTER_DRAIN) { E(acc, cur, wr, wc, fr, fq); S.done(cur); }
        if (!has_next) break;
#pragma unroll
        for (int a = 0; a < 2; ++a)
#pragma unroll
            for (int b = 0; b < 2; ++b)
#pragma unroll
                for (int m = 0; m < 4; ++m)
#pragma unroll
                    for (int n = 0; n < 2; ++n) acc[a][b][m][n] = (f32x4){0.f, 0.f, 0.f, 0.f};
        cur = nxt; cA = nA; cB = nB; ++ui;
        if constexpr (ALIGN_EPI) { if (wr == 1) PG8_BAR; }
    }
    PG8_WAIT_V(0);
    if constexpr (!ALIGN_EPI) { if (wr == 0) PG8_BAR; }
    PG8_BAR;
    if constexpr (Epi::AFTER_DRAIN) { E.fused(acc, cur, wr, wc, fr, fq, lds, wid, lane); S.done(cur); }
#undef PG8_SA
#undef PG8_SB
#undef PG8_STAGE
#undef PG8_LDA
#undef PG8_LDB
#undef PG8_MMA
#undef PG8_WAIT_V
#undef PG8_WAIT_L
#undef PG8_BAR
#undef PG8_SCHED
}
constexpr float LOG2E = 1.4426950408889634f;
constexpr float C2 = 0.125f * LOG2E;
struct EpiIn {
    static constexpr bool PERM = true, AFTER_DRAIN = false;
    bf16_t* O; const float* costab; const float* sintab;
    __device__ __forceinline__ void operator()(const f32x4 (&acc)[2][2][4][2], const Unit& u, int wr, int wc, int fr, int fq) const {
        const int pn = u.pn, row0 = u.pm * BM + wr * 64 + fr, col0 = pn * BM + wc * 32 + 8 * fq;
        const bool rope0 = (pn >= 6), rope1 = (pn == 6 || pn == 7);
        const float sc = (pn < 2 || pn == 6 || pn == 7) ? C2 : 1.f;
        const int G4 = 4 * ((wc & 1) * 4 + fq);
#pragma unroll
        for (int ai = 0; ai < 2; ++ai)
#pragma unroll
            for (int m = 0; m < 4; ++m) {
                const int row = row0 + ai * HALF + m * 16, pos = row & 2047;
                f32x4 cs = (f32x4){1.f, 1.f, 1.f, 1.f}, sn = (f32x4){0.f, 0.f, 0.f, 0.f};
                if (rope0) { cs = *(const f32x4*)(costab + pos * 32 + G4); sn = *(const f32x4*)(sintab + pos * 32 + G4); }
                bf16_t* rowp = O + (size_t)row * 2304 + col0;
#pragma unroll
                for (int bj = 0; bj < 2; ++bj) {
                    f32x4 v0 = acc[ai][bj][m][0], v1 = acc[ai][bj][m][1];
                    if (bj == 0 ? rope0 : rope1) { const f32x4 o0 = v0 * cs - v1 * sn, o1 = v1 * cs + v0 * sn; v0 = o0; v1 = o1; }
                    v0 = v0 * sc; v1 = v1 * sc;
                    u32x4 w; w.x = cvt_pk_bf16(v0[0], v0[1]); w.y = cvt_pk_bf16(v0[2], v0[3]); w.z = cvt_pk_bf16(v1[0], v1[1]); w.w = cvt_pk_bf16(v1[2], v1[3]);
                    store16_wt(rowp + bj * HALF, w);
                }
            }
    }
};
struct EpiRes {
    static constexpr bool PERM = false, AFTER_DRAIN = false;
    const float* base; float* out; const float* gate;
    __device__ __forceinline__ void operator()(const f32x4 (&acc)[2][2][4][2], const Unit& u, int wr, int wc, int fr, int fq) const {
        const int col0 = u.pn * BM + wc * 32 + 4 * fq, b = u.pm >> 3;
        f32x4 gv[2][2];
#pragma unroll
        for (int bj = 0; bj < 2; ++bj)
#pragma unroll
            for (int n = 0; n < 2; ++n) gv[bj][n] = *(const f32x4*)(gate + b * 6144 + col0 + bj * HALF + n * 16);
#pragma unroll
        for (int ai = 0; ai < 2; ++ai)
#pragma unroll
            for (int mp = 0; mp < 2; ++mp) {
                f32x4 bs[2][2][2];
#pragma unroll
                for (int mm = 0; mm < 2; ++mm) { const size_t off = (size_t)(u.pm * BM + ai * HALF + wr * 64 + (2 * mp + mm) * 16 + fr) * 1024 + col0;
#pragma unroll
                    for (int bj = 0; bj < 2; ++bj)
#pragma unroll
                        for (int n = 0; n < 2; ++n) bs[mm][bj][n] = *(const f32x4*)(base + off + bj * HALF + n * 16); }
                asm volatile("" ::: "memory");
#pragma unroll
                for (int mm = 0; mm < 2; ++mm) { const size_t off = (size_t)(u.pm * BM + ai * HALF + wr * 64 + (2 * mp + mm) * 16 + fr) * 1024 + col0;
#pragma unroll
                    for (int bj = 0; bj < 2; ++bj)
#pragma unroll
                        for (int n = 0; n < 2; ++n) *(f32x4*)(out + off + bj * HALF + n * 16) = bs[mm][bj][n] + gv[bj][n] * acc[ai][bj][2 * mp + mm][n]; }
                asm volatile("" ::: "memory");
            }
    }
};
template <bool BASE_B16> struct EpiResB {
    static constexpr bool PERM = true, AFTER_DRAIN = false;
    const void* base; bf16_t* outb; const float* gate;
    __device__ __forceinline__ void operator()(const f32x4 (&acc)[2][2][4][2], const Unit& u, int wr, int wc, int fr, int fq) const {
        const int col0 = u.pn * BM + wc * 32 + 8 * fq, b = u.pm >> 3;
        f32x4 gv[2][2];
#pragma unroll
        for (int bj = 0; bj < 2; ++bj)
#pragma unroll
            for (int n = 0; n < 2; ++n) gv[bj][n] = *(const f32x4*)(gate + b * 6144 + col0 + bj * HALF + n * 4);
#pragma unroll
        for (int ai = 0; ai < 2; ++ai)
#pragma unroll
            for (int mp = 0; mp < 2; ++mp) {
                f32x4 bs[2][2][2];
#pragma unroll
                for (int mm = 0; mm < 2; ++mm) { const size_t off = (size_t)(u.pm * BM + ai * HALF + wr * 64 + (2 * mp + mm) * 16 + fr) * 1024 + col0;
#pragma unroll
                    for (int bj = 0; bj < 2; ++bj) {
                        if (BASE_B16) { const u32x4 w = *(const u32x4*)((const bf16_t*)base + off + bj * HALF);
                            bs[mm][bj][0] = (f32x4){__builtin_bit_cast(float, w.x << 16), __builtin_bit_cast(float, w.x & 0xffff0000u), __builtin_bit_cast(float, w.y << 16), __builtin_bit_cast(float, w.y & 0xffff0000u)};
                            bs[mm][bj][1] = (f32x4){__builtin_bit_cast(float, w.z << 16), __builtin_bit_cast(float, w.z & 0xffff0000u), __builtin_bit_cast(float, w.w << 16), __builtin_bit_cast(float, w.w & 0xffff0000u)}; }
                        else { bs[mm][bj][0] = *(const f32x4*)((const float*)base + off + bj * HALF); bs[mm][bj][1] = *(const f32x4*)((const float*)base + off + bj * HALF + 4); } } }
                asm volatile("" ::: "memory");
#pragma unroll
                for (int mm = 0; mm < 2; ++mm) { const size_t off = (size_t)(u.pm * BM + ai * HALF + wr * 64 + (2 * mp + mm) * 16 + fr) * 1024 + col0;
#pragma unroll
                    for (int bj = 0; bj < 2; ++bj) { const f32x4 v0 = bs[mm][bj][0] + gv[bj][0] * acc[ai][bj][2 * mp + mm][0], v1 = bs[mm][bj][1] + gv[bj][1] * acc[ai][bj][2 * mp + mm][1];
                        u32x4 w; w.x = cvt_pk_bf16(v0[0], v0[1]); w.y = cvt_pk_bf16(v0[2], v0[3]); w.z = cvt_pk_bf16(v1[0], v1[1]); w.w = cvt_pk_bf16(v1[2], v1[3]);
                        store16_wt(outb + off + bj * HALF, w); } }
                asm volatile("" ::: "memory");
            }
    }
};
__device__ __forceinline__ float dpp_ror1(float v) { return __builtin_bit_cast(float, __builtin_amdgcn_update_dpp(0, __builtin_bit_cast(int, v), 0x121, 0xf, 0xf, false)); }
__device__ __forceinline__ float dpp_shr1z(float v) { return __builtin_bit_cast(float, __builtin_amdgcn_update_dpp(0, __builtin_bit_cast(int, v), 0x111, 0xf, 0xf, true)); }
__device__ __forceinline__ float dpp_shl1z(float v) { return __builtin_bit_cast(float, __builtin_amdgcn_update_dpp(0, __builtin_bit_cast(int, v), 0x101, 0xf, 0xf, true)); }
__device__ __forceinline__ float dpp_rol1(float v) { return __builtin_bit_cast(float, __builtin_amdgcn_update_dpp(0, __builtin_bit_cast(int, v), 0x12f, 0xf, 0xf, false)); }
struct EpiUp {
    static constexpr bool PERM = true, AFTER_DRAIN = false;
    bf16_t* ACT; float* SB; const float* cw; const float* cb;
    __device__ __forceinline__ void operator()(const f32x4 (&acc)[2][2][4][2], const Unit& u, int wr, int wc, int fr, int fq) const {
        const int ff0 = u.pn * 128 + wc * 32 + 8 * fq;
        f32x4 w0a[2], w1a[2], w2a[2], bba[2];
#pragma unroll
        for (int n = 0; n < 2; ++n) { w0a[n] = *(const f32x4*)(cw + ff0 + 4 * n); w1a[n] = *(const f32x4*)(cw + 2816 + ff0 + 4 * n); w2a[n] = *(const f32x4*)(cw + 5632 + ff0 + 4 * n); bba[n] = *(const f32x4*)(cb + ff0 + 4 * n); }
#pragma unroll
        for (int ai = 0; ai < 2; ++ai) {
            const int chunk = 4 * u.pm + 2 * ai + wr, row0 = chunk * 64;
            unsigned pk[4][4];
            float bG[8], bV[8], bC[8];
#pragma unroll
            for (int n = 0; n < 2; ++n) {
                const f32x4 w0 = w0a[n], w1 = w1a[n], w2 = w2a[n], bb = bba[n];
#pragma unroll
                for (int jp = 0; jp < 2; ++jp) {
                    float av[4][2];
#pragma unroll
                    for (int jj = 0; jj < 2; ++jj) {
                        const int j = 2 * jp + jj;
                        const float pm0 = dpp_shr1z(acc[ai][1][3][n][j]), nm3 = dpp_shl1z(acc[ai][1][0][n][j]);
#pragma unroll
                        for (int m = 0; m < 4; ++m) {
                            const float cur = acc[ai][1][m][n][j], val = acc[ai][0][m][n][j];
                            const float pv = (m > 0) ? acc[ai][1][m > 0 ? m - 1 : 0][n][j] : pm0, nx = (m < 3) ? acc[ai][1][m < 3 ? m + 1 : 3][n][j] : nm3;
                            const float gc = w0[j] * pv + w1[j] * cur + w2[j] * nx + bb[j];
                            av[m][jj] = gc * val * __builtin_amdgcn_rcpf(1.f + __builtin_amdgcn_exp2f(-LOG2E * gc));
                            if (m == 0) { bG[4 * n + j] = gc; bV[4 * n + j] = val; bC[4 * n + j] = cur; }
                            if (m == 3) { const bool l = (fr == 15); bG[4 * n + j] = l ? gc : bG[4 * n + j]; bV[4 * n + j] = l ? val : bV[4 * n + j]; bC[4 * n + j] = l ? cur : bC[4 * n + j]; }
                        }
                    }
#pragma unroll
                    for (int m = 0; m < 4; ++m) pk[m][2 * n + jp] = cvt_pk_bf16(av[m][0], av[m][1]);
                }
            }
#pragma unroll
            for (int m = 0; m < 4; ++m) { u32x4 w; w.x = pk[m][0]; w.y = pk[m][1]; w.z = pk[m][2]; w.w = pk[m][3]; store16_wt(ACT + (size_t)(row0 + 4 * fr + m) * 2816 + ff0, w); }
            if (fr == 0 || fr == 15) {
                float* sb = SB + ((size_t)(chunk * 2 + (fr == 15 ? 1 : 0)) * 3) * 2816 + ff0;
#pragma unroll
                for (int n = 0; n < 2; ++n) { *(f32x4*)(sb + 4 * n) = (f32x4){bG[4 * n], bG[4 * n + 1], bG[4 * n + 2], bG[4 * n + 3]}; *(f32x4*)(sb + 2816 + 4 * n) = (f32x4){bV[4 * n], bV[4 * n + 1], bV[4 * n + 2], bV[4 * n + 3]};
                    *(f32x4*)(sb + 5632 + 4 * n) = (f32x4){bC[4 * n], bC[4 * n + 1], bC[4 * n + 2], bC[4 * n + 3]}; }
            }
        }
    }
};
}
using namespace pg8;
#define LAS PG8_LAS
typedef float f32x16 __attribute__((ext_vector_type(16)));
typedef short s16x4 __attribute__((ext_vector_type(4)));
typedef short v4i16_t __attribute__((ext_vector_type(4)));
typedef unsigned u32x2 __attribute__((ext_vector_type(2)));

constexpr int NB = 16, SEQ = 2048, DM = 1024, MTOK = NB * SEQ, NIN = 2304, DFF = 2816, NUP = 5632;
constexpr float EPS = 1e-6f;
constexpr size_t MiB = 1u << 20;
constexpr size_t WS_BAR = 0, BAR_ZERO_BYTES = 16384;
constexpr size_t WS_MOD = 1 * MiB, WS_COS = 2 * MiB, WS_SIN = 2 * MiB + 512 * 1024, WS_WIN = 4 * MiB, WS_WOUT = 10 * MiB, WS_WUP = 12 * MiB, WS_WDN = 24 * MiB;
constexpr size_t WS_H = 32 * MiB, WS_PROJ = 96 * MiB, WS_AO = 240 * MiB, WS_ACT = 96 * MiB  , WS_SB = 304 * MiB, WS_X1B = 346 * MiB, WS_END = 410 * MiB;
static_assert(WS_ACT + (size_t)MTOK * DFF * 2 <= WS_SB && WS_SB + (size_t)512 * 2 * 3 * DFF * 4 <= WS_END, "ws map");
constexpr int LDS_BYTES = 147456, LDS_BARST_OFF = 131072;
constexpr int ATT_BIAS_OFF = 0, ATT_BSTR = 640, ATT_V_OFF = 20480, ATT_VROW = 192, ATT_VBUF = 32 * ATT_VROW, ATT_RED_OFF = ATT_V_OFF + 8 * 2 * ATT_VBUF;
static_assert(ATT_RED_OFF + 2 * 8 * 64 * 4 <= LDS_BYTES, "attention LDS");

__device__ __forceinline__ float wave_sum(float v) {
#pragma unroll
    for (int o = 1; o < 64; o <<= 1) v += __shfl_xor(v, o);
    return v;
}
__device__ __forceinline__ s16x4 vtr(unsigned a) { return __builtin_bit_cast(s16x4, __builtin_amdgcn_ds_read_tr16_b64_v4i16((LAS v4i16_t*)(a))); }
__device__ __forceinline__ f32x16 mfma32(bf16x8 a, bf16x8 b, f32x16 c) { return __builtin_amdgcn_mfma_f32_32x32x16_bf16(a, b, c, 0, 0, 0); }
__device__ __forceinline__ bf16x8 pack8(float a0, float a1, float a2, float a3, float a4, float a5, float a6, float a7) {
    u32x4 w; w.x = cvt_pk_bf16(a0, a1); w.y = cvt_pk_bf16(a2, a3); w.z = cvt_pk_bf16(a4, a5); w.w = cvt_pk_bf16(a6, a7); return __builtin_bit_cast(bf16x8, w);
}
struct NaXf {
    const LAS float* bt; int kc0;
    template <int QUAD> __device__ __forceinline__ void apply(f32x16& s) const {
#pragma unroll
        for (int i = 0; i < 16; ++i) { const int a = i >> 2, b = i & 3, ap = QUAD ? 0 : a, ra = QUAD ? a : 0;
            const float bias = bt[ra * 31 + 8 * ap + b]; const bool ok = (unsigned)(kc0 + 8 * ap + b) < 16u; s[i] = ok ? s[i] + bias : -1e30f; }
    }
};
struct SwXf {
    int mode, ql, h, dq;
    __device__ __forceinline__ void apply(f32x16& s) const {
        {
#pragma unroll
            for (int i = 0; i < 16; ++i) { const int kb = 8 * (i >> 2) + 4 * h + (i & 3); const int d = dq + kb - ql; const bool ok = (d >= -128) && (d <= 128); s[i] = ok ? s[i] : -1e30f; }
        }
    }
};
struct AttnSt { f32x16 o0, o1; float m, l; };
__device__ __forceinline__ void attn_softmax_pv(f32x16& s, AttnSt& st, unsigned vaddr) {
    float mx = s[0];
#pragma unroll
    for (int i = 1; i < 16; ++i) mx = fmaxf(mx, s[i]);
    mx = fmaxf(mx, __shfl_xor(mx, 32));
    const float mn = fmaxf(st.m, mx), al = __builtin_amdgcn_exp2f(st.m - mn); st.m = mn;
    float ps = 0.f;
#pragma unroll
    for (int i = 0; i < 16; ++i) { s[i] = __builtin_amdgcn_exp2f(s[i] - mn); ps += s[i]; }
    st.l = st.l * al + ps; st.o0 = st.o0 * al; st.o1 = st.o1 * al;
    const bf16x8 p0 = pack8(s[0], s[1], s[2], s[3], s[4], s[5], s[6], s[7]), p1 = pack8(s[8], s[9], s[10], s[11], s[12], s[13], s[14], s[15]);
    bf16x8 a[2][2];
#pragma unroll
    for (int db = 0; db < 2; ++db)
#pragma unroll
        for (int ks = 0; ks < 2; ++ks) { const s16x4 lo = vtr(vaddr + ks * 16 * ATT_VROW + db * 64), hi = vtr(vaddr + ks * 16 * ATT_VROW + 8 * ATT_VROW + db * 64);
            a[db][ks] = (bf16x8){lo[0], lo[1], lo[2], lo[3], hi[0], hi[1], hi[2], hi[3]}; }
    st.o0 = mfma32(a[0][0], p0, st.o0); st.o0 = mfma32(a[0][1], p1, st.o0);
    st.o1 = mfma32(a[1][0], p0, st.o1); st.o1 = mfma32(a[1][1], p1, st.o1);
}
struct BlkDesc { int base, hs; };
__device__ __forceinline__ void load_k(bf16x8 (&kf)[4], const bf16_t* proj, int koff, const BlkDesc& d, int ql, int h) {
    const bf16_t* p = proj + (size_t)(d.base + (d.hs ? (ql & 7) + (ql >> 3) * 64 : ql)) * NIN + koff + 32 * h;
#pragma unroll
    for (int kk = 0; kk < 4; ++kk) kf[kk] = *(const bf16x8*)(p + 8 * kk);
}
__device__ __forceinline__ void load_v(u32x4 (&vf)[4], const bf16_t* proj, int voff, const BlkDesc& d, int lane) {
#pragma unroll
    for (int i = 0; i < 4; ++i) { const int x = 8 * i + (lane >> 3); vf[i] = *(const u32x4*)(proj + (size_t)(d.base + (d.hs ? (x & 7) + (x >> 3) * 64 : x)) * NIN + voff + 8 * (lane & 7)); }
}
__device__ __forceinline__ void store_v(LAS unsigned char* vb, const u32x4 (&vf)[4], int lane) {
#pragma unroll
    for (int i = 0; i < 4; ++i) *(LAS u32x4*)(vb + (8 * i + (lane >> 3)) * ATT_VROW + 16 * (lane & 7)) = vf[i];
}

struct UnitId { int valid, swp, b, sub; };
__device__ __forceinline__ UnitId unit_id(int it, int G, int bid) {
    UnitId d; const int u = it * G + bid; d.valid = (u < 1536) ? 1 : 0; const int q3 = u / 3, r3 = u - 3 * q3;
    d.swp = (r3 == 2) ? 1 : 0;
    if (d.swp) { d.b = q3 >> 5; d.sub = q3 & 31; } else { const int idx = q3 * 2 + r3; d.b = idx >> 6; d.sub = idx & 63; }
    return d;
}
struct UnitPre { int valid, tokq, qoff, koff, voff; BlkDesc d0; };
__device__ __forceinline__ UnitPre unit_pre(int it, int G, int bid, int wave, int ql) {
    UnitPre p; const UnitId d = unit_id(it, G, bid); p.valid = d.valid;
    if (!d.swp) { const int r = d.sub >> 1, jp = d.sub & 1, rs = min(max(r - 4, 0), 24);
        p.tokq = d.b * SEQ + r * 64 + 32 * jp + ql; p.qoff = wave * 64; p.koff = 512 + wave * 64; p.voff = 1024 + wave * 64; p.d0.base = d.b * SEQ + rs * 64 + 32 * jp; p.d0.hs = 0; }
    else { const int q0 = 64 * d.sub, kvh = wave >> 2, tlo = max(0, (128 - q0) / 32);
        p.tokq = d.b * SEQ + q0 + ql; p.qoff = 1536 + wave * 64; p.koff = 2048 + kvh * 64; p.voff = 2176 + kvh * 64; p.d0.base = d.b * SEQ + q0 - 128 + 32 * tlo; p.d0.hs = 0; }
    return p;
}
__device__ __forceinline__ f32x16 qk_scores(const bf16x8 (&kf)[4], const bf16x8 (&qf)[4]) {
    f32x16 s;
#pragma unroll
    for (int e = 0; e < 16; ++e) s[e] = 0.f;
#pragma unroll
    for (int kk = 0; kk < 4; ++kk) s = mfma32(kf[kk], qf[kk], s);
    return s;
}
__device__ __forceinline__ float attn_norm_l(AttnSt& st) {
    const float lt = st.l + __shfl_xor(st.l, 32), inv = 1.f / lt;
    float ss = 0.f;
#pragma unroll
    for (int i = 0; i < 16; ++i) { st.o0[i] *= inv; st.o1[i] *= inv; ss += st.o0[i] * st.o0[i] + st.o1[i] * st.o1[i]; }
    return ss + __shfl_xor(ss, 32);
}
__device__ __forceinline__ void attn_store(const AttnSt& st, float rn, bf16_t* op) {
#pragma unroll
    for (int a = 0; a < 4; ++a) {
        u32x2 w0, w1;
        w0.x = cvt_pk_bf16(st.o0[4 * a] * rn, st.o0[4 * a + 1] * rn); w0.y = cvt_pk_bf16(st.o0[4 * a + 2] * rn, st.o0[4 * a + 3] * rn);
        w1.x = cvt_pk_bf16(st.o1[4 * a] * rn, st.o1[4 * a + 1] * rn); w1.y = cvt_pk_bf16(st.o1[4 * a + 2] * rn, st.o1[4 * a + 3] * rn);
        *(u32x2*)(op + 8 * a) = w0; *(u32x2*)(op + 32 + 8 * a) = w1;
    }
}
__device__ __forceinline__ void attn_phase(LAS unsigned char* lds, const bf16_t* __restrict__ proj, bf16_t* __restrict__ ao, const float* __restrict__ rpb, const float* __restrict__ sink) {
    const int tid = threadIdx.x, wave = __builtin_amdgcn_readfirstlane(tid >> 6), lane = tid & 63, ql = lane & 31, h = lane >> 5;
    const int G = gridDim.x, bid = blockIdx.x;
    LAS float* btab = (LAS float*)(lds + ATT_BIAS_OFF);
    LAS unsigned char* vbuf = lds + ATT_V_OFF + wave * 2 * ATT_VBUF;
    LAS float* red = (LAS float*)(lds + ATT_RED_OFF);
    bf16x8 qf[4], kf[4], kn[4]; u32x4 vf[4];
    { const UnitPre p = unit_pre(0, G, bid, wave, ql);
      if (p.valid) {
#pragma unroll
          for (int kk = 0; kk < 4; ++kk) qf[kk] = *(const bf16x8*)(proj + (size_t)p.tokq * NIN + p.qoff + 32 * h + 8 * kk);
          load_k(kf, proj, p.koff, p.d0, ql, h); load_v(vf, proj, p.voff, p.d0, lane); } }
#pragma unroll
    for (int i0 = 0; i0 < 8 * ATT_BSTR; i0 += 512) { const int i = i0 + tid, hh = i / ATT_BSTR, j = i % ATT_BSTR - 64; const bool okb = (j >= 0 && j < 465); const float v = rpb[okb ? hh * 465 + j : 0]; btab[i] = okb ? v * LOG2E : 0.f; }
    __syncthreads();
    const int g4 = lane >> 4, i16 = lane & 15;
    const unsigned trb = (unsigned)((4 * (g4 >> 1) + (i16 >> 2)) * ATT_VROW + (16 * (g4 & 1) + 4 * (i16 & 3)) * 2);
    const unsigned vb0 = (unsigned)(size_t)vbuf;
    for (int it = 0;; ++it) {
        const UnitId ud = unit_id(it, G, bid); if (!ud.valid) break;
        const int b = ud.b, sub = ud.sub;
        AttnSt st, stB;
#pragma unroll
        for (int i = 0; i < 16; ++i) { st.o0[i] = 0.f; st.o1[i] = 0.f; stB.o0[i] = 0.f; stB.o1[i] = 0.f; }
        stB.m = 0.f; stB.l = 1.f;
        int tokq, goff;
        store_v(vbuf, vf, lane);
        if (!ud.swp) {
            const int r = sub >> 1, jp = sub & 1, rs = min(max(r - 4, 0), 24), qcol = 32 * jp + ql, cs = min(max(qcol - 8, 0), 48), cq0 = jp ? 24 : 32;
            tokq = b * SEQ + r * 64 + qcol; goff = 0;
            const int koff = 512 + wave * 64, voff = 1024 + wave * 64;
            st.m = -1e30f; st.l = 0.f;
            const LAS float* bt0 = btab + wave * ATT_BSTR + 64;
            auto desc = [&](int i) { BlkDesc d; if (i < 8) { d.base = b * SEQ + (rs + i) * 64 + 32 * jp; d.hs = 0; } else { d.base = b * SEQ + (rs + 4 * (i - 8)) * 64 + cq0; d.hs = 1; } return d; };
            for (int i = 0; i < 10; ++i) {
                if (i + 1 < 10) { const BlkDesc d = desc(i + 1); load_k(kn, proj, koff, d, ql, h); load_v(vf, proj, voff, d, lane); }
                f32x16 s = qk_scores(kf, qf);
                if (i < 8) { const int R = rs + i, c0 = 32 * jp; NaXf xf{bt0 + (R - r + 7) * 31 + (c0 + 4 * h - qcol + 15), c0 + 4 * h - cs}; xf.apply<0>(s); }
                else { const int R = rs + 4 * (i - 8); NaXf xf{bt0 + (R - r + 7) * 31 + (cq0 + 4 * h - qcol + 15), cq0 + 4 * h - cs}; xf.apply<1>(s); }
                attn_softmax_pv(s, st, vb0 + (unsigned)((i & 1) * ATT_VBUF) + trb);
                if (i + 1 < 10) { store_v(vbuf + ((i + 1) & 1) * ATT_VBUF, vf, lane);
#pragma unroll
                    for (int kk = 0; kk < 4; ++kk) kf[kk] = kn[kk]; }
            }
        } else {
            const int q0 = 64 * sub; tokq = b * SEQ + q0 + ql; goff = 512;
            const int kvh = wave >> 2, koff = 2048 + kvh * 64, voff = 2176 + kvh * 64;
            bf16x8 qB[4];
#pragma unroll
            for (int kk = 0; kk < 4; ++kk) qB[kk] = *(const bf16x8*)(proj + (size_t)(tokq + 32) * NIN + 1536 + wave * 64 + 32 * h + 8 * kk);
            st.m = sink[wave] * LOG2E; st.l = (h == 0) ? 1.f : 0.f; stB.m = st.m; stB.l = st.l;
            const int tlo = max(0, (128 - q0) / 32), thi = min(9, (SEQ - 1 - (q0 - 128)) / 32);
            for (int t = tlo, i = 0; t <= thi; ++t, ++i) {
                if (t + 1 <= thi) { BlkDesc d; d.base = b * SEQ + q0 - 128 + 32 * (t + 1); d.hs = 0; load_k(kn, proj, koff, d, ql, h); load_v(vf, proj, voff, d, lane); }
                const unsigned va = vb0 + (unsigned)((i & 1) * ATT_VBUF) + trb;
                if (t <= 8) { f32x16 s = qk_scores(kf, qf); if (t == 0 || t == 8) { SwXf xf{0, ql, h, 32 * t - 128}; xf.apply(s); } attn_softmax_pv(s, st, va); }
                if (t >= 1) { f32x16 s = qk_scores(kf, qB); if (t == 1 || t == 9) { SwXf xf{0, ql, h, 32 * t - 160}; xf.apply(s); } attn_softmax_pv(s, stB, va); }
                if (t + 1 <= thi) { store_v(vbuf + ((i + 1) & 1) * ATT_VBUF, vf, lane);
#pragma unroll
                    for (int kk = 0; kk < 4; ++kk) kf[kk] = kn[kk]; }
            }
        }
        bf16x8 qn[4];
        const UnitPre pn = unit_pre(it + 1, G, bid, wave, ql);
        if (pn.valid) {
#pragma unroll
            for (int kk = 0; kk < 4; ++kk) qn[kk] = *(const bf16x8*)(proj + (size_t)pn.tokq * NIN + pn.qoff + 32 * h + 8 * kk);
            load_k(kn, proj, pn.koff, pn.d0, ql, h); load_v(vf, proj, pn.voff, pn.d0, lane); }
        const float ssA = attn_norm_l(st), ssB = ud.swp ? attn_norm_l(stB) : 0.f;
        LAS float* rp = red + (it & 1) * 512;
        if (h == 0) { rp[wave * 64 + ql] = ssA; rp[wave * 64 + 32 + ql] = ssB; }
        __syncthreads();
        float totA = 0.f, totB = 0.f;
#pragma unroll
        for (int w = 0; w < 8; ++w) { totA += rp[w * 64 + ql]; totB += rp[w * 64 + 32 + ql]; }
        bf16_t* op = ao + (size_t)tokq * DM + goff + wave * 64 + 4 * h;
        attn_store(st, 1.f / sqrtf(totA * (1.f / 512.f) + EPS), op);
        if (ud.swp) attn_store(stB, 1.f / sqrtf(totB * (1.f / 512.f) + EPS), op + (size_t)32 * DM);
        if (pn.valid) {
#pragma unroll
            for (int kk = 0; kk < 4; ++kk) { qf[kk] = qn[kk]; kf[kk] = kn[kk]; } }
    }
    __syncthreads();
}

#define XB_TMO      128
#define XB_XCNT(j)  (256  + 64 * (j))
#define XB_XSUB(j)  (1280 + 64 * (j))
#define XB_XGEN(j)  (2304 + 64 * (j))
#define XB_TOP      3328
#define XB_TOPGEN   3392
#define XCD_BAR_WORDS 3456
#define XB_SPIN_CAP (1u << 18)

__device__ __forceinline__ unsigned xb_ld(unsigned* p)              { return __hip_atomic_load(p, __ATOMIC_RELAXED, __HIP_MEMORY_SCOPE_AGENT); }
__device__ __forceinline__ unsigned xb_add(unsigned* p, unsigned v) { return __hip_atomic_fetch_add(p, v, __ATOMIC_RELAXED, __HIP_MEMORY_SCOPE_AGENT); }
__device__ __forceinline__ unsigned xb_xcc_id() { return (unsigned)__builtin_amdgcn_s_getreg((3 << 11) | 20) & 0xFu; }
#define XB_SPIN(cond, bar) do { unsigned _sp = 0; while (cond) { __builtin_amdgcn_s_sleep(1); \
    if ((++_sp & 255u) == 0u) { if (xb_ld(&(bar)[XB_TMO])) break; if (_sp > XB_SPIN_CAP) { atomicAdd(&(bar)[XB_TMO], 1u); break; } } } } while (0)

struct XcdBarrier {
    unsigned* bar; unsigned x;
    volatile LAS unsigned* st;
};

__device__ __forceinline__ XcdBarrier xcd_barrier_post(unsigned* bar, volatile LAS unsigned* st) {
    XcdBarrier b; b.bar = bar; b.x = xb_xcc_id(); b.st = st;
    if (threadIdx.x == 0) (void)xb_add(&bar[XB_XCNT(b.x)], 1u);
    return b;
}
__device__ __forceinline__ void xcd_barrier_complete(unsigned* bar, unsigned x, unsigned& nloc, unsigned& nx) {
    const unsigned G = gridDim.x * gridDim.y * gridDim.z;
    unsigned sum, cnt, mine, sp = 0u;
    for (;;) {
        sum = 0u; cnt = 0u; mine = 0u;
#pragma unroll
        for (unsigned j = 0; j < 16; ++j) { const unsigned c = xb_ld(&bar[XB_XCNT(j)]); sum += c; cnt += (c > 0u) ? 1u : 0u; mine = (j == x) ? c : mine; }
        if (sum == G) break;
        __builtin_amdgcn_s_sleep(1);
        if ((++sp & 255u) == 0u) { if (xb_ld(&bar[XB_TMO])) break; if (sp > XB_SPIN_CAP) { atomicAdd(&bar[XB_TMO], 1u); break; } }
    }
    nloc = mine > 0u ? mine : 1u; nx = cnt > 0u ? cnt : 1u;
}

__device__ __forceinline__ void xcd_barrier(const XcdBarrier& b) {
    asm volatile("s_waitcnt vmcnt(0)" ::: "memory");
    __syncthreads();
    if (threadIdx.x == 0) {
        unsigned* bar = b.bar;
        __builtin_amdgcn_s_waitcnt(0);
        unsigned nloc = b.st[0], nx = b.st[1];
        if (nloc == 0u) { xcd_barrier_complete(bar, b.x, nloc, nx); b.st[0] = nloc; b.st[1] = nx; }
        const unsigned old = xb_add(&bar[XB_XSUB(b.x)], 1u);
        const unsigned gen = old / nloc;
        if (old + 1u == (gen + 1u) * nloc) {
            __builtin_amdgcn_fence(__ATOMIC_RELEASE, "agent");
            asm volatile("s_waitcnt vmcnt(0)" ::: "memory");
            const unsigned og = xb_add(&bar[XB_TOP], 1u);
            const unsigned tg = og / nx;
            if (og + 1u == (tg + 1u) * nx) xb_add(&bar[XB_TOPGEN], 1u);
            else XB_SPIN(xb_ld(&bar[XB_TOPGEN]) == tg, bar);
            __builtin_amdgcn_fence(__ATOMIC_ACQUIRE, "agent");
            xb_add(&bar[XB_XGEN(b.x)], 1u);
            asm volatile("s_waitcnt vmcnt(0)" ::: "memory");
        } else {
            XB_SPIN(xb_ld(&bar[XB_XGEN(b.x)]) == gen, bar);
            __builtin_amdgcn_fence(__ATOMIC_ACQUIRE, "agent");
            asm volatile("s_waitcnt vmcnt(0)" ::: "memory");
        }
    }
    __syncthreads();
}


__device__ __forceinline__ unsigned f2bf(float f) { unsigned u = __builtin_bit_cast(unsigned, f); return (u + 0x7fffu + ((u >> 16) & 1u)) >> 16; }
__device__ __forceinline__ unsigned pk2(float lo, float hi) { return f2bf(lo) | (f2bf(hi) << 16); }
template <int MAP> __device__ __forceinline__ int rowmap(int n) {
    if (MAP == 1) { if (n < 1536 || n >= 2176) return n; const int e = n - 1536, hh = e >> 6, d = e & 63, dd = d & 31, Gq = dd >> 2, i = dd & 3; return 1536 + 64 * hh + 8 * Gq + (d >= 32 ? 4 : 0) + i; }
    if (MAP == 2) { const int g = (n >= DFF) ? 1 : 0, ff = n - g * DFF; return 256 * (ff >> 7) + 128 * g + (ff & 127); }
    return n;
}
template <int MAP> __device__ __forceinline__ void transpose_item(const float* __restrict__ W, int K, int N, bf16_t* __restrict__ WT, const float* __restrict__ kscale, LAS float* scr, int item, int lane) {
    const int nblk = N / 32, kb = item / nblk, nb = item % nblk, k0 = 64 * kb, n0 = 32 * nb;
#pragma unroll
    for (int i = 0; i < 32; ++i) { const int kk = 2 * i + (lane >> 5); float v = W[(size_t)(k0 + kk) * N + n0 + (lane & 31)]; if (kscale) v *= kscale[k0 + kk]; scr[kk * 33 + (lane & 31)] = v; }
    asm volatile("s_waitcnt lgkmcnt(0)" ::: "memory");
    const int c = lane & 7;
#pragma unroll
    for (int j = 0; j < 4; ++j) { const int n = (lane >> 3) + 8 * j; const LAS float* s = scr + (8 * c) * 33 + n;
        u32x4 o; o.x = pk2(s[0 * 33], s[1 * 33]); o.y = pk2(s[2 * 33], s[3 * 33]); o.z = pk2(s[4 * 33], s[5 * 33]); o.w = pk2(s[6 * 33], s[7 * 33]);
        *(u32x4*)(WT + (size_t)rowmap<MAP>(n0 + n) * K + k0 + 8 * c) = o; }
    asm volatile("s_waitcnt lgkmcnt(0)" ::: "memory");
}
struct CvItem { const float* W; bf16_t* WT; const float* ks; int K, N, map, item; };
__device__ __forceinline__ void cv_load(float (&v)[32], const CvItem& c, int lane) {
    const int nblk = c.N / 32, kb = c.item / nblk, nb = c.item - kb * nblk, k0 = 64 * kb, n0 = 32 * nb;
    const float* p = c.W + (size_t)(k0 + (lane >> 5)) * c.N + n0 + (lane & 31);
#pragma unroll
    for (int i = 0; i < 32; ++i) v[i] = p[(size_t)(2 * i) * c.N];
}
__device__ __forceinline__ void cv_finish(const float (&v)[32], const CvItem& c, LAS float* scr, int lane) {
    const int nblk = c.N / 32, kb = c.item / nblk, nb = c.item - kb * nblk, k0 = 64 * kb, n0 = 32 * nb;
    if (c.ks) {
#pragma unroll
        for (int i = 0; i < 32; ++i) { const int kk = 2 * i + (lane >> 5); scr[kk * 33 + (lane & 31)] = v[i] * c.ks[k0 + kk]; } }
    else {
#pragma unroll
        for (int i = 0; i < 32; ++i) { const int kk = 2 * i + (lane >> 5); scr[kk * 33 + (lane & 31)] = v[i]; } }
    asm volatile("s_waitcnt lgkmcnt(0)" ::: "memory");
    const int cc = lane & 7;
#pragma unroll
    for (int j = 0; j < 4; ++j) { const int n = (lane >> 3) + 8 * j; const LAS float* sp = scr + (8 * cc) * 33 + n;
        u32x4 o; o.x = pk2(sp[0 * 33], sp[1 * 33]); o.y = pk2(sp[2 * 33], sp[3 * 33]); o.z = pk2(sp[4 * 33], sp[5 * 33]); o.w = pk2(sp[6 * 33], sp[7 * 33]);
        const int nn = n0 + n, row = (c.map == 1) ? rowmap<1>(nn) : ((c.map == 2) ? rowmap<2>(nn) : nn);
        *(u32x4*)(c.WT + (size_t)row * c.K + k0 + 8 * cc) = o; }
    asm volatile("s_waitcnt lgkmcnt(0)" ::: "memory");
}
template <int MODE> __device__ __forceinline__ void row_phase(const float* src, bf16_t* dst, float* io, const float* __restrict__ g, const float* __restrict__ mod, int shift_off, int scale_off) {
    const int lane = threadIdx.x & 63, gw = blockIdx.x * 8 + (threadIdx.x >> 6), NGW = gridDim.x * 8, rpw = MTOK / NGW, m_beg = gw * rpw, m_end = (gw == NGW - 1) ? MTOK : m_beg + rpw;
    const float* base = (MODE == 0) ? src : io;
    for (int m0 = m_beg; m0 < m_end; m0 += 4) {
        f32x4 cur[4][4];
#pragma unroll
        for (int r = 0; r < 4; ++r)
#pragma unroll
            for (int j = 0; j < 4; ++j) cur[r][j] = ((const f32x4*)(base + (size_t)min(m0 + r, MTOK - 1) * DM) + lane)[64 * j];
        const int b = m0 >> 11;
        f32x4 gv[4], sc[4], sh[4];
#pragma unroll
        for (int j = 0; j < 4; ++j) { const int c = 4 * lane + 256 * j; gv[j] = *(const f32x4*)(g + c);
            if (MODE == 0) { sc[j] = *(const f32x4*)(mod + b * 6144 + scale_off + c) + 1.f; sh[j] = *(const f32x4*)(mod + b * 6144 + shift_off + c); } }
        float ss[4];
#pragma unroll
        for (int r = 0; r < 4; ++r) { ss[r] = 0.f;
#pragma unroll
            for (int j = 0; j < 4; ++j) { const f32x4 v = cur[r][j]; ss[r] += (v.x * v.x + v.y * v.y) + (v.z * v.z + v.w * v.w); } }
#pragma unroll
        for (int o = 1; o < 64; o <<= 1) {
#pragma unroll
            for (int r = 0; r < 4; ++r) ss[r] += __shfl_xor(ss[r], o); }
#pragma unroll
        for (int r = 0; r < 4; ++r) {
            const int m = m0 + r; if (m >= m_end) break;
            const float rstd = 1.f / sqrtf(ss[r] * (1.f / DM) + EPS);
            if (MODE == 0) { unsigned long long* o8 = (unsigned long long*)(dst + (size_t)m * DM) + lane;
#pragma unroll
                for (int j = 0; j < 4; ++j) { const f32x4 y = cur[r][j] * rstd * gv[j] * sc[j] + sh[j]; o8[64 * j] = (unsigned long long)(cvt_pk_bf16(y.x, y.y)) | ((unsigned long long)cvt_pk_bf16(y.z, y.w) << 32); } }
            else { f32x4* xr = (f32x4*)(io + (size_t)m * DM) + lane;
#pragma unroll
                for (int j = 0; j < 4; ++j) xr[64 * j] = cur[r][j] * rstd * gv[j]; }
        }
    }
}
template <int MODE> __device__ __forceinline__ void row_phase_b16(const bf16_t* src, bf16_t* dst, float* outf, const float* __restrict__ g, const float* __restrict__ mod, int shift_off, int scale_off) {
    const int lane = threadIdx.x & 63, gw = blockIdx.x * 8 + (threadIdx.x >> 6), NGW = gridDim.x * 8, rpw = MTOK / NGW, m_beg = gw * rpw, m_end = (gw == NGW - 1) ? MTOK : m_beg + rpw;
    for (int m0 = m_beg; m0 < m_end; m0 += 4) {
        u32x4 raw[4][2];
#pragma unroll
        for (int r = 0; r < 4; ++r) { const bf16_t* p = src + (size_t)min(m0 + r, MTOK - 1) * DM + 8 * lane; raw[r][0] = *(const u32x4*)p; raw[r][1] = *(const u32x4*)(p + 512); }
        const int b = m0 >> 11;
        f32x4 gv[4], sc[4], sh[4];
#pragma unroll
        for (int j = 0; j < 4; ++j) { const int c = (j >> 1) * 512 + 8 * lane + 4 * (j & 1); gv[j] = *(const f32x4*)(g + c);
            if (MODE == 0) { sc[j] = *(const f32x4*)(mod + b * 6144 + scale_off + c) + 1.f; sh[j] = *(const f32x4*)(mod + b * 6144 + shift_off + c); } }
        f32x4 cur[4][4]; float ss[4];
#pragma unroll
        for (int r = 0; r < 4; ++r) { ss[r] = 0.f;
#pragma unroll
            for (int j = 0; j < 4; ++j) { const unsigned w0 = raw[r][j >> 1][2 * (j & 1)], w1 = raw[r][j >> 1][2 * (j & 1) + 1];
                const f32x4 v = (f32x4){__builtin_bit_cast(float, w0 << 16), __builtin_bit_cast(float, w0 & 0xffff0000u), __builtin_bit_cast(float, w1 << 16), __builtin_bit_cast(float, w1 & 0xffff0000u)};
                cur[r][j] = v; ss[r] += (v.x * v.x + v.y * v.y) + (v.z * v.z + v.w * v.w); } }
#pragma unroll
        for (int o = 1; o < 64; o <<= 1) {
#pragma unroll
            for (int r = 0; r < 4; ++r) ss[r] += __shfl_xor(ss[r], o); }
#pragma unroll
        for (int r = 0; r < 4; ++r) {
            const int m = m0 + r; if (m >= m_end) break;
            const float rstd = 1.f / sqrtf(ss[r] * (1.f / DM) + EPS);
            if (MODE == 0) {
#pragma unroll
                for (int hf = 0; hf < 2; ++hf) { const f32x4 y0 = cur[r][2 * hf] * rstd * gv[2 * hf] * sc[2 * hf] + sh[2 * hf], y1 = cur[r][2 * hf + 1] * rstd * gv[2 * hf + 1] * sc[2 * hf + 1] + sh[2 * hf + 1];
                    u32x4 w; w.x = cvt_pk_bf16(y0.x, y0.y); w.y = cvt_pk_bf16(y0.z, y0.w); w.z = cvt_pk_bf16(y1.x, y1.y); w.w = cvt_pk_bf16(y1.z, y1.w);
                    *(u32x4*)(dst + (size_t)m * DM + hf * 512 + 8 * lane) = w; } }
            else {
#pragma unroll
                for (int j = 0; j < 4; ++j) *(f32x4*)(outf + (size_t)m * DM + (j >> 1) * 512 + 8 * lane + 4 * (j & 1)) = cur[r][j] * rstd * gv[j]; }
        }
    }
}
__device__ __forceinline__ void fixup_panel(int pm, const float* __restrict__ SB, bf16_t* ACT, const float* __restrict__ cw) {
    constexpr int NITEM = 8 * (DFF / 4);
#pragma unroll 1
    for (int e0 = threadIdx.x; e0 < NITEM; e0 += 4 * 512) {
        f32x4 gc[4], val[4], nbr[4], wv[4];
#pragma unroll
        for (int q = 0; q < 4; ++q) {
            const int e = min(e0 + q * 512, NITEM - 1), rr = e / (DFF / 4), c4 = (e % (DFF / 4)) * 4, chunk = 4 * pm + (rr >> 1), which = rr & 1;
            const float* sb = SB + ((size_t)(chunk * 2 + which) * 3) * DFF + c4;
            gc[q] = *(const f32x4*)sb; val[q] = *(const f32x4*)(sb + DFF);
            const bool has = which == 0 ? ((chunk & 31) != 0) : ((chunk & 31) != 31);
            const int nchunk = has ? (which == 0 ? chunk - 1 : chunk + 1) : chunk;
            nbr[q] = *(const f32x4*)(SB + ((size_t)(nchunk * 2 + (which ^ 1)) * 3 + 2) * DFF + c4);
            wv[q] = *(const f32x4*)(cw + (which == 0 ? 0 : 2 * DFF) + c4);
            if (!has) wv[q] = (f32x4){0.f, 0.f, 0.f, 0.f};
        }
#pragma unroll
        for (int q = 0; q < 4; ++q) {
            const int e = e0 + q * 512; if (e >= NITEM) break;
            const int rr = e / (DFF / 4), c4 = (e % (DFF / 4)) * 4, chunk = 4 * pm + (rr >> 1), which = rr & 1;
            const f32x4 g2 = gc[q] + wv[q] * nbr[q];
            float a[4];
#pragma unroll
            for (int j = 0; j < 4; ++j) a[j] = g2[j] * val[q][j] * __builtin_amdgcn_rcpf(1.f + __builtin_amdgcn_exp2f(-LOG2E * g2[j]));
            u32x2 w; w.x = cvt_pk_bf16(a[0], a[1]); w.y = cvt_pk_bf16(a[2], a[3]);
            *(u32x2*)(ACT + (size_t)(chunk * 64 + which * 63) * DFF + c4) = w;
        }
    }
}

struct Args { const float* in[17]; float* out; unsigned char* ws; int ph_lo, ph_hi; };
static_assert(sizeof(Args) == 17 * 8 + 8 + 8 + 8, "Args has no padding");

__global__ void __launch_bounds__(512, 2) fwd_megakernel(Args args) {
    extern __shared__ __attribute__((aligned(16))) unsigned char lds_raw[];
    LAS unsigned char* lds = (LAS unsigned char*)lds_raw;
    cg::grid_group grid = cg::this_grid();
    const int tid = threadIdx.x, wave = __builtin_amdgcn_readfirstlane(tid >> 6), lane = tid & 63, G = gridDim.x, bid = blockIdx.x;
    const float* x = args.in[0]; const float* cvec = args.in[1]; const float* w_ada = args.in[2]; const float* b_ada = args.in[3]; const float* g_attn = args.in[4];
    const float* w_in = args.in[5]; const float* rpb = args.in[6]; const float* sink = args.in[7]; const float* g_na = args.in[8]; const float* g_sw = args.in[9];
    const float* w_out = args.in[10]; const float* g_ffn = args.in[11]; const float* w_up = args.in[12]; const float* conv_w = args.in[13]; const float* conv_b = args.in[14];
    const float* w_down = args.in[15]; const float* g_final = args.in[16];
    unsigned char* ws = args.ws; float* out = args.out;
    float* mod = (float*)(ws + WS_MOD); float* costab = (float*)(ws + WS_COS); float* sintab = (float*)(ws + WS_SIN);
    bf16_t* Win = (bf16_t*)(ws + WS_WIN); bf16_t* Wout = (bf16_t*)(ws + WS_WOUT); bf16_t* Wup = (bf16_t*)(ws + WS_WUP); bf16_t* Wdn = (bf16_t*)(ws + WS_WDN);
    bf16_t* H = (bf16_t*)(ws + WS_H); bf16_t* PROJ = (bf16_t*)(ws + WS_PROJ); bf16_t* AO = (bf16_t*)(ws + WS_AO); bf16_t* ACT = (bf16_t*)(ws + WS_ACT); float* SB = (float*)(ws + WS_SB); bf16_t* X1B = (bf16_t*)(ws + WS_X1B);
    const int lo = args.ph_lo, hi = args.ph_hi;
    volatile LAS unsigned* barst = (volatile LAS unsigned*)(lds + LDS_BARST_OFF);
    if (tid < 2) barst[tid] = 0u;
    __syncthreads();
    XcdBarrier xbar = xcd_barrier_post((unsigned*)(ws + WS_BAR), barst);
#define IN(k) (lo <= (k) && (k) < hi)
#define SEAM(k) do { if (IN(k) && IN((k) + 1)) { if (args.ph_hi > 1000) grid.sync(); else xcd_barrier(xbar); } } while (0)

    if (IN(0)) {
        {
            const int gi = bid * 512 + tid;
            for (int e = gi; e < SEQ * 32; e += G * 512) { const int pos = e >> 5, f = e & 31;
                const float inv = powf(10000.f, -(float)f / 32.f); const float ang = (float)pos * inv;
                costab[e] = cosf(ang); sintab[e] = sinf(ang); }
        }
        if (bid < 192) {
            LAS float* sc = (LAS float*)lds; LAS float* red = (LAS float*)(lds + 65536);
#pragma unroll 8
            for (int i = tid; i < NB * DM; i += 512) { const float v = cvec[i]; sc[i] = v / (1.f + __expf(-v)); }
            __syncthreads();
            const int n0 = 32 * bid, col = lane & 31, par = lane >> 5;
            float acc[16];
#pragma unroll
            for (int b = 0; b < 16; ++b) acc[b] = 0.f;
            const float* wp = w_ada + n0 + col;
#pragma unroll 8
            for (int kk = 0; kk < 64; ++kk) { const int k = wave * 128 + kk * 2 + par; const float w = wp[(size_t)k * 6144];
#pragma unroll
                for (int b = 0; b < 16; ++b) acc[b] += sc[b * DM + k] * w; }
#pragma unroll
            for (int b = 0; b < 16; ++b) red[((wave * 2 + par) * 16 + b) * 32 + col] = acc[b];
            __syncthreads();
            { const int b = tid >> 5, cc = tid & 31; float s = b_ada[n0 + cc];
#pragma unroll
              for (int g = 0; g < 16; ++g) s += red[(g * 16 + b) * 32 + cc];
              mod[b * 6144 + n0 + cc] = s; }
            __syncthreads();
        }
        {
            LAS float* scr = (LAS float*)(lds + wave * 16384);
            constexpr int I_IN = (DM / 64) * (NIN / 32), I_OUT = (DM / 64) * (DM / 32), I_UP = (DM / 64) * (NUP / 32), I_DN = (DFF / 64) * (DM / 32);
            const bool late_up = (G == 256);
            const int nit = I_IN + I_OUT + I_DN + (late_up ? 0 : I_UP);
            int first, step, lim;
            if (late_up) { if (bid >= 192) { first = (bid - 192) * 8 + wave; step = 512; lim = nit; } else { first = 0; step = 1; lim = 0; } }
            else { first = bid * 8 + wave; step = G * 8; lim = nit; }
            auto mk = [&](int it) { CvItem c; int r = it;
                if (r < I_IN) { c.W = w_in; c.WT = Win; c.ks = nullptr; c.K = DM; c.N = NIN; c.map = 1; c.item = r; return c; } r -= I_IN;
                if (r < I_OUT) { const int kb = r / (DM / 32); c.W = w_out; c.WT = Wout; c.ks = (kb < 8) ? g_na : (g_sw - 512); c.K = DM; c.N = DM; c.map = 0; c.item = r; return c; } r -= I_OUT;
                if (r < I_DN) { c.W = w_down; c.WT = Wdn; c.ks = nullptr; c.K = DFF; c.N = DM; c.map = 0; c.item = r; return c; } r -= I_DN;
                c.W = w_up; c.WT = Wup; c.ks = nullptr; c.K = DM; c.N = NUP; c.map = 2; c.item = r; return c; };
            if (first < lim) {
                float va[32], vb[32];
                CvItem ca = mk(first), cb = ca; cv_load(va, ca, lane);
#pragma unroll 1
                for (int it = first;;) {
                    const int i1 = it + step; const bool m1 = i1 < lim;
                    if (m1) { cb = mk(i1); cv_load(vb, cb, lane); }
                    cv_finish(va, ca, scr, lane);
                    if (!m1) break;
                    const int i2 = i1 + step; const bool m2 = i2 < lim;
                    if (m2) { ca = mk(i2); cv_load(va, ca, lane); }
                    cv_finish(vb, cb, scr, lane);
                    if (!m2) break;
                    it = i2;
                }
            }
        }
    }
    SEAM(0);
    if (IN(1)) row_phase<0>(x, H, nullptr, g_attn, mod, 0, 1024);
    SEAM(1);
    if (IN(2)) {
        Gemm g{H, Win, MTOK, NIN, DM}; StaticOrder S; S.init(MTOK, NIN, G, bid);
        EpiIn E{PROJ, costab, sintab};
        gemm_phase<EpiIn, StaticOrder, true, true>(lds, g, S, E);
        if (G == 256 && bid >= 128) {
            __syncthreads();
            LAS float* scr = (LAS float*)(lds + wave * 16384);
            constexpr int I_UPc = (DM / 64) * (NUP / 32);
            float va[32], vb[32];
            CvItem ca{w_up, Wup, nullptr, DM, NUP, 2, (bid - 128) * 8 + wave}, cb = ca;
            cv_load(va, ca, lane);
#pragma unroll 1
            for (;;) {
                const bool m1 = ca.item + 1024 < I_UPc;
                if (m1) { cb.item = ca.item + 1024; cv_load(vb, cb, lane); }
                cv_finish(va, ca, scr, lane);
                if (!m1) break;
                const bool m2 = cb.item + 1024 < I_UPc;
                if (m2) { ca.item = cb.item + 1024; cv_load(va, ca, lane); }
                cv_finish(vb, cb, scr, lane);
                if (!m2) break;
            }
        }
    }
    SEAM(2);
    if (IN(3)) attn_phase(lds, PROJ, AO, rpb, sink);
    SEAM(3);
    if (IN(4)) {
        Gemm g{AO, Wout, MTOK, DM, DM}; StaticOrder S; S.init(MTOK, DM, G, bid);
        EpiResB<false> E{x, X1B, mod + 2048};
        gemm_phase<EpiResB<false>, StaticOrder, true, true>(lds, g, S, E);
    }
    SEAM(4);
    if (IN(5)) row_phase_b16<0>(X1B, H, nullptr, g_ffn, mod, 3072, 4096);
    SEAM(5);
    if (IN(6)) {
        Gemm g{H, Wup, MTOK, NUP, DM}; StaticOrder S; S.init(MTOK, NUP, G, bid);
        EpiUp E{ACT, SB, conv_w, conv_b};
        gemm_phase<EpiUp, StaticOrder, true, true, true>(lds, g, S, E);
    }
    SEAM(6);
    if (IN(7)) {
        StaticOrder S; S.init(MTOK, DM, G, bid);
        { Unit u; for (int i = 0; S.next(i, u); ++i) fixup_panel(u.pm, SB, ACT, conv_w); }
        asm volatile("s_waitcnt vmcnt(0)" ::: "memory"); __syncthreads();
        Gemm g{ACT, Wdn, MTOK, DM, DFF};
        EpiResB<true> E{X1B, X1B, mod + 5120};
        gemm_phase<EpiResB<true>, StaticOrder, true, true>(lds, g, S, E);
    }
    SEAM(7);
    if (IN(8)) row_phase_b16<1>(X1B, nullptr, out, g_final, nullptr, 0, 0);
#undef IN
#undef SEAM
}

#ifndef N_LAUNCH_SPLIT
#define N_LAUNCH_SPLIT 0
#endif
extern "C" void kernel_launch(void* const* d_in, const int* in_sizes, int n_in, void* d_out, int out_size, void* d_ws, size_t ws_size, hipStream_t stream) {
    static int grid_blocks = 0;
    if (grid_blocks == 0) {
        if (n_in != 17 || out_size != MTOK * DM || ws_size < WS_END) { fprintf(stderr, "kernel_launch: unexpected shapes (n_in %d out %d ws %zu)\n", n_in, out_size, ws_size); grid_blocks = -1; return; }
        int dev = 0, cus = 0, per_cu = 0;
        hipGetDevice(&dev); hipDeviceGetAttribute(&cus, hipDeviceAttributeMultiprocessorCount, dev);
        if (hipFuncSetAttribute((const void*)fwd_megakernel, hipFuncAttributeMaxDynamicSharedMemorySize, LDS_BYTES) != hipSuccess) { fprintf(stderr, "kernel_launch: hipFuncSetAttribute failed\n"); grid_blocks = -1; return; }
        if (hipOccupancyMaxActiveBlocksPerMultiprocessor(&per_cu, (const void*)fwd_megakernel, 512, LDS_BYTES) != hipSuccess || per_cu < 1) { fprintf(stderr, "kernel_launch: occupancy query failed (%d)\n", per_cu); per_cu = 1; (void)hipGetLastError(); }
        grid_blocks = cus * per_cu; if (grid_blocks > 256) grid_blocks = 256;
        fprintf(stderr, "kernel_launch: %d CUs x %d blocks -> grid %d\n", cus, per_cu, grid_blocks);
    }
    if (grid_blocks < 0) return;
    if (hipMemsetAsync((char*)d_ws + WS_BAR, 0, BAR_ZERO_BYTES, stream) != hipSuccess) { fprintf(stderr, "kernel_launch: memset failed\n"); return; }
    Args a{};
    for (int i = 0; i < 17; ++i) a.in[i] = (const float*)d_in[i];
    a.out = (float*)d_out; a.ws = (unsigned char*)d_ws;
#if N_LAUNCH_SPLIT
    for (int p = 0; p < 9; ++p) { a.ph_lo = p; a.ph_hi = p + 1; void* kargs[] = {&a};
        hipError_t e = hipLaunchCooperativeKernel((const void*)fwd_megakernel, dim3(grid_blocks), dim3(512), kargs, LDS_BYTES, stream);
        if (e != hipSuccess) { fprintf(stderr, "cooperative launch (phase %d) failed: %s\n", p, hipGetErrorString(e)); return; } }
#else
    a.ph_lo = 0; a.ph_hi = 9; void* kargs[] = {&a};
    hipError_t e = hipLaunchCooperativeKernel((const void*)fwd_megakernel, dim3(grid_blocks), dim3(512), kargs, LDS_BYTES, stream);
    if (e != hipSuccess) fprintf(stderr, "cooperative launch failed: %s (grid %d)\n", hipGetErrorString(e), grid_blocks);
#endif
}
```
